# Optimizing an MI355X kernel written in HIP

```python
import math
import jax, jax.numpy as jnp
from jax import lax
import numpy as np

D_MODEL = 1024
BATCH = 8
SEQ = 4096
DEPTH = 4

GRID_W = 64
NA_HEADS = 8
NA_HEAD_DIM = 64
NA_WIDTH = NA_HEADS * NA_HEAD_DIM
NA_WIN_ROWS = 8
NA_WIN_COLS = 16
NA_COL_BLOCK = NA_WIN_COLS
NA_KEY_COL_BLOCK = 2 * NA_WIN_COLS
DIFF_HEADS = 4
DIFF_HEAD_DIM = 64
DIFF_QK_WIDTH = DIFF_HEADS * 2 * DIFF_HEAD_DIM
DIFF_V_WIDTH = DIFF_HEADS * 2 * DIFF_HEAD_DIM
MLA_HEADS = 8
MLA_NOPE_DIM = 64
MLA_ROPE_DIM = 32
MLA_V_DIM = 64
MLA_Q_RANK = 384
MLA_KV_RANK = 256
MLA_WIDTH = MLA_HEADS * MLA_V_DIM
N_BRANCH = 3
BRANCH_WIDTH = 512
D_IN = 3 * NA_WIDTH + 2 * DIFF_QK_WIDTH + DIFF_V_WIDTH + MLA_Q_RANK + MLA_KV_RANK + MLA_ROPE_DIM + N_BRANCH * D_MODEL
D_FF = -(-8 * D_MODEL // (3 * 256)) * 256
ROPE_THETA = 500000.0
DIFF_ROT_DIM = DIFF_HEAD_DIM // 4
Q_BLOCK = 128
DN_ALPHA = (2 * DEPTH) ** 0.25
DN_BETA = (8 * DEPTH) ** -0.25
LN_EPS = 1e-5
RMS_EPS = 1e-6

kernel_name = "hybrid_na_diff_mla_gated_deepnorm_encoder"


def layer_norm(x, g, b):
    xf = x.astype(jnp.float32)
    mu = jnp.mean(xf, -1, keepdims=True)
    var = jnp.mean(jnp.square(xf - mu), -1, keepdims=True)
    return ((xf - mu) * lax.rsqrt(var + LN_EPS) * g.astype(jnp.float32) + b.astype(jnp.float32)).astype(x.dtype)


def rms_norm(x, g):
    xf = x.astype(jnp.float32)
    return (xf * lax.rsqrt(jnp.mean(xf * xf, -1, keepdims=True) + RMS_EPS) * g.astype(jnp.float32)).astype(x.dtype)


def rope(x, rot_dim):
    s = x.shape[1]
    half = rot_dim // 2
    inv_freq = jnp.exp(-math.log(ROPE_THETA) * jnp.arange(half, dtype=jnp.float32) / half)
    ang = jnp.arange(s, dtype=jnp.float32)[:, None] * inv_freq[None, :]
    cos = jnp.cos(ang)[None, :, None, :]
    sin = jnp.sin(ang)[None, :, None, :]
    xr = x[..., :rot_dim].astype(jnp.float32)
    x1, x2 = xr[..., :half], xr[..., half:]
    rot = jnp.concatenate([x1 * cos - x2 * sin, x2 * cos + x1 * sin], -1).astype(x.dtype)
    return jnp.concatenate([rot, x[..., rot_dim:]], -1)


def blocked_attention(q, k, v, scale):
    b, s, h, dq = q.shape
    nb = s // Q_BLOCK
    qb = q.reshape(b, nb, Q_BLOCK, h, dq).transpose(1, 0, 2, 3, 4)

    def one_block(qi):
        sc = jnp.einsum('bqhd,bkhd->bhqk', qi, k, preferred_element_type=jnp.float32) * scale
        p = jax.nn.softmax(sc, axis=-1).astype(v.dtype)
        return jnp.einsum('bhqk,bkhd->bqhd', p, v)

    out = lax.map(one_block, qb)
    return out.transpose(1, 0, 2, 3, 4).reshape(b, s, h, v.shape[-1])


def neighbourhood_attention(q, k, v, rpb):
    b, s, h, d = q.shape
    rows = s // GRID_W
    kr = min(NA_WIN_ROWS, rows)
    kc = NA_WIN_COLS
    ncb = GRID_W // NA_COL_BLOCK
    qg = q.reshape(b, rows, GRID_W, h, d)
    kg = k.reshape(b, rows, GRID_W, h, d)
    vg = v.reshape(b, rows, GRID_W, h, d)
    qcol = jnp.arange(GRID_W).reshape(ncb, NA_COL_BLOCK)
    kstart = jnp.clip(jnp.arange(ncb) * NA_COL_BLOCK - kc // 2, 0, GRID_W - NA_KEY_COL_BLOCK)
    kcol = kstart[:, None] + jnp.arange(NA_KEY_COL_BLOCK)[None, :]
    wstart = jnp.clip(qcol - kc // 2, 0, GRID_W - kc)
    col_valid = (kcol[:, None, :] >= wstart[:, :, None]) & (kcol[:, None, :] < wstart[:, :, None] + kc)
    dcol_idx = jnp.clip(kcol[:, None, :] - qcol[:, :, None], -(kc - 1), kc - 1) + (kc - 1)
    row_center = NA_WIN_ROWS - 1
    scale = d ** -0.5

    def one_row(r):
        rs = jnp.clip(r - kr // 2, 0, rows - kr)
        qr = lax.dynamic_index_in_dim(qg, r, axis=1, keepdims=False)
        k_rows = lax.dynamic_slice_in_dim(kg, rs, kr, axis=1)
        v_rows = lax.dynamic_slice_in_dim(vg, rs, kr, axis=1)
        kb = jnp.take(k_rows, kcol, axis=2)
        vb = jnp.take(v_rows, kcol, axis=2)
        qb = qr.reshape(b, ncb, NA_COL_BLOCK, h, d)
        sc = jnp.einsum('bnqhd,banchd->bhnqac', qb, kb, preferred_element_type=jnp.float32) * scale
        drow = rs + jnp.arange(kr) - r + row_center
        bias = rpb[:, drow][:, :, dcol_idx].transpose(0, 2, 3, 1, 4)
        sc = sc + bias[None].astype(jnp.float32)
        sc = jnp.where(col_valid[None, None, :, :, None, :], sc, -jnp.inf)
        p = jax.nn.softmax(sc, axis=(-2, -1)).astype(v.dtype)
        o = jnp.einsum('bhnqac,banchd->bnqhd', p, vb)
        return o.reshape(b, GRID_W, h, d)

    out = lax.map(one_row, jnp.arange(rows))
    return out.transpose(1, 0, 2, 3, 4).reshape(b, s, h * d)


def diff_attention(q, k, v, lam_vecs, subln_g, lam_init):
    b, s, _ = q.shape
    q = q.reshape(b, s, DIFF_HEADS, 2, DIFF_HEAD_DIM)
    k = k.reshape(b, s, DIFF_HEADS, 2, DIFF_HEAD_DIM)
    v = v.reshape(b, s, DIFF_HEADS, 2 * DIFF_HEAD_DIM)
    q1, q2 = rope(q[:, :, :, 0], DIFF_ROT_DIM), rope(q[:, :, :, 1], DIFF_ROT_DIM)
    k1, k2 = rope(k[:, :, :, 0], DIFF_ROT_DIM), rope(k[:, :, :, 1], DIFF_ROT_DIM)
    lv = lam_vecs.astype(jnp.float32)
    lam = jnp.exp(jnp.sum(lv[0] * lv[1])) - jnp.exp(jnp.sum(lv[2] * lv[3])) + lam_init
    scale = DIFF_HEAD_DIM ** -0.5
    a1 = blocked_attention(q1, k1, v, scale)
    a2 = blocked_attention(q2, k2, v, scale)
    o = a1 - lam.astype(a1.dtype) * a2
    o = rms_norm(o, subln_g) * (1.0 - lam_init)
    return o.reshape(b, s, DIFF_V_WIDTH)


def latent_attention(c_q, c_kv, k_rope, w_qb, w_kvb, q_norm_g, kv_norm_g):
    b, s, _ = c_q.shape
    q = jnp.einsum('bsr,re->bse', rms_norm(c_q, q_norm_g), w_qb).reshape(b, s, MLA_HEADS, MLA_NOPE_DIM + MLA_ROPE_DIM)
    q = jnp.concatenate([q[..., :MLA_NOPE_DIM], rope(q[..., MLA_NOPE_DIM:], MLA_ROPE_DIM)], -1)
    kv = jnp.einsum('bsr,re->bse', rms_norm(c_kv, kv_norm_g), w_kvb).reshape(b, s, MLA_HEADS, MLA_NOPE_DIM + MLA_V_DIM)
    k_nope, v = kv[..., :MLA_NOPE_DIM], kv[..., MLA_NOPE_DIM:]
    k_r = rope(k_rope[:, :, None, :], MLA_ROPE_DIM)
    k = jnp.concatenate([k_nope, jnp.broadcast_to(k_r, (b, s, MLA_HEADS, MLA_ROPE_DIM))], -1)
    o = blocked_attention(q, k, v, (MLA_NOPE_DIM + MLA_ROPE_DIM) ** -0.5)
    return o.reshape(b, s, MLA_WIDTH)


def setup_inputs(seed: int = 0) -> dict:
    key = jax.random.key(seed)
    ks = jax.random.split(key, 20)

    def nrm(k, shape, s):
        return jax.random.normal(k, shape, jnp.float32) * s

    return {
        "x": nrm(ks[0], (BATCH, SEQ, D_MODEL), 1.0),
        "ln_in_g": 1.0 + nrm(ks[1], (D_MODEL,), 0.02),
        "ln_in_b": nrm(ks[2], (D_MODEL,), 0.02),
        "w_in": nrm(ks[3], (DEPTH, D_MODEL, D_IN), D_MODEL ** -0.5),
        "b_gate": nrm(ks[4], (DEPTH, N_BRANCH * D_MODEL), 0.02),
        "na_rpb": nrm(ks[5], (DEPTH, NA_HEADS, 2 * NA_WIN_ROWS - 1, 2 * NA_WIN_COLS - 1), 0.02),
        "diff_lambda": nrm(ks[6], (DEPTH, 4, DIFF_HEAD_DIM), 0.1),
        "diff_subln_g": 1.0 + nrm(ks[7], (DEPTH, 2 * DIFF_HEAD_DIM), 0.02),
        "mla_q_norm_g": 1.0 + nrm(ks[8], (DEPTH, MLA_Q_RANK), 0.02),
        "mla_kv_norm_g": 1.0 + nrm(ks[9], (DEPTH, MLA_KV_RANK), 0.02),
        "w_mla_qb": nrm(ks[10], (DEPTH, MLA_Q_RANK, MLA_HEADS * (MLA_NOPE_DIM + MLA_ROPE_DIM)), MLA_Q_RANK ** -0.5),
        "w_mla_kvb": nrm(ks[11], (DEPTH, MLA_KV_RANK, MLA_HEADS * (MLA_NOPE_DIM + MLA_V_DIM)), MLA_KV_RANK ** -0.5),
        "w_branch": nrm(ks[12], (DEPTH, N_BRANCH, BRANCH_WIDTH, D_MODEL), BRANCH_WIDTH ** -0.5 * DN_BETA),
        "w_out": nrm(ks[13], (DEPTH, D_MODEL, D_MODEL), D_MODEL ** -0.5 * DN_BETA),
        "ln1_g": 1.0 + nrm(ks[14], (DEPTH, D_MODEL), 0.02),
        "ln1_b": nrm(ks[15], (DEPTH, D_MODEL), 0.02),
        "w_ffn_in": nrm(ks[16], (DEPTH, D_MODEL, 2 * D_FF), D_MODEL ** -0.5),
        "w_ffn_out": nrm(ks[17], (DEPTH, D_FF, D_MODEL), D_FF ** -0.5 * DN_BETA),
        "ln2_g": 1.0 + nrm(ks[18], (DEPTH, D_MODEL), 0.02),
        "ln2_b": nrm(ks[19], (DEPTH, D_MODEL), 0.02),
    }


def reference(x, ln_in_g, ln_in_b, w_in, b_gate, na_rpb, diff_lambda, diff_subln_g,
              mla_q_norm_g, mla_kv_norm_g, w_mla_qb, w_mla_kvb, w_branch, w_out,
              ln1_g, ln1_b, w_ffn_in, w_ffn_out, ln2_g, ln2_b):
    b, s, _ = x.shape
    sizes = (NA_WIDTH, NA_WIDTH, NA_WIDTH, DIFF_QK_WIDTH, DIFF_QK_WIDTH, DIFF_V_WIDTH,
             MLA_Q_RANK, MLA_KV_RANK, MLA_ROPE_DIM, N_BRANCH * D_MODEL)
    split_points = np.cumsum(sizes)[:-1].tolist()

    x = layer_norm(x, ln_in_g, ln_in_b)
    for l in range(DEPTH):
        lam_init = 0.8 - 0.6 * math.exp(-0.3 * l)
        proj = jnp.einsum('bsd,de->bse', x, w_in[l])
        (na_q, na_k, na_v, df_q, df_k, df_v, m_cq, m_ckv, m_kr, gate_pre) = jnp.split(proj, split_points, axis=-1)

        na_out = neighbourhood_attention(
            na_q.reshape(b, s, NA_HEADS, NA_HEAD_DIM), na_k.reshape(b, s, NA_HEADS, NA_HEAD_DIM),
            na_v.reshape(b, s, NA_HEADS, NA_HEAD_DIM), na_rpb[l])
        df_out = diff_attention(df_q, df_k, df_v, diff_lambda[l], diff_subln_g[l], lam_init)
        mla_out = latent_attention(m_cq, m_ckv, m_kr, w_mla_qb[l], w_mla_kvb[l],
                                   mla_q_norm_g[l], mla_kv_norm_g[l])

        gates = jax.nn.sigmoid((gate_pre + b_gate[l]).astype(jnp.float32)).astype(x.dtype)
        gates = gates.reshape(b, s, N_BRANCH, D_MODEL)
        merged = (gates[:, :, 0] * jnp.einsum('bse,ed->bsd', na_out, w_branch[l, 0])
                  + gates[:, :, 1] * jnp.einsum('bse,ed->bsd', df_out, w_branch[l, 1])
                  + gates[:, :, 2] * jnp.einsum('bse,ed->bsd', mla_out, w_branch[l, 2]))
        mix = jnp.einsum('bsd,de->bse', merged, w_out[l])
        x = layer_norm(DN_ALPHA * x + mix, ln1_g[l], ln1_b[l])

        gu = jnp.einsum('bsd,df->bsf', x, w_ffn_in[l])
        hidden = jax.nn.silu(gu[..., :D_FF]) * gu[..., D_FF:]
        ffn = jnp.einsum('bsf,fd->bsd', hidden, w_ffn_out[l])
        x = layer_norm(DN_ALPHA * x + ffn, ln2_g[l], ln2_b[l])
    return x
```

```cpp
#include <hip/hip_runtime.h>
#include <hip/hip_cooperative_groups.h>
#include <cstdio>
#include <cstdint>
namespace cg = cooperative_groups;

#define LAS __attribute__((address_space(3)))
#define GAS __attribute__((address_space(1)))
typedef unsigned short bf16_t;
typedef short bf16x8 __attribute__((ext_vector_type(8)));
typedef short s16x4 __attribute__((ext_vector_type(4)));
typedef float f32x4 __attribute__((ext_vector_type(4)));
typedef float f32x16 __attribute__((ext_vector_type(16)));
typedef unsigned u32x4 __attribute__((ext_vector_type(4)));
typedef unsigned u32x2 __attribute__((ext_vector_type(2)));

constexpr int T_ALL = 32768, TC = 16384, DM = 1024, SEQ = 4096, NIN = 6912, DFF = 2816, DEPTH = 4, NCHUNK = 2;
constexpr size_t SZ_WIN = (size_t)DEPTH * NIN * 1024 * 2, SZ_WQB = (size_t)DEPTH * 768 * 384 * 2, SZ_WKVB = (size_t)DEPTH * 1024 * 256 * 2,
                 SZ_WBR = (size_t)DEPTH * 3 * 1024 * 512 * 2, SZ_WOUT = (size_t)DEPTH * 1024 * 3072 * 2, SZ_WF1 = (size_t)DEPTH * 5632 * 1024 * 2,
                 SZ_WF2 = (size_t)DEPTH * 1024 * 2816 * 2, SZ_XB = (size_t)T_ALL * 1024 * 2, SZ_PA = (size_t)TC * 1536 * 2, SZ_PD = SZ_PA,
                 SZ_MC = (size_t)TC * 768 * 2, SZ_GT = (size_t)TC * 3072 * 2, SZ_MQ = (size_t)TC * 768 * 2, SZ_MKV = (size_t)TC * 1024 * 2,
                 SZ_SSQ = (size_t)TC * 24 * 4, SZ_TD = (size_t)SEQ * 8 * 4 * 2, SZ_TM = (size_t)SEQ * 16 * 4 * 2;
constexpr size_t OFF_WIN = 0, OFF_WQB = OFF_WIN + SZ_WIN, OFF_WKVB = OFF_WQB + SZ_WQB, OFF_WBR = OFF_WKVB + SZ_WKVB, OFF_WOUT = OFF_WBR + SZ_WBR,
                 OFF_WF1 = OFF_WOUT + SZ_WOUT, OFF_WF2 = OFF_WF1 + SZ_WF1, OFF_XB = OFF_WF2 + SZ_WF2, OFF_PA = OFF_XB + SZ_XB, OFF_PD = OFF_PA + SZ_PA,
                 OFF_MC = OFF_PD + SZ_PD, OFF_GT = OFF_MC + SZ_MC, OFF_MQ = OFF_GT + SZ_GT, OFF_MKV = OFF_MQ + SZ_MQ, OFF_SSQ = OFF_MKV + SZ_MKV,
                 OFF_TD = OFF_SSQ + SZ_SSQ, OFF_TM = OFF_TD + SZ_TD, WS_END = OFF_TM + SZ_TM;
constexpr int LDS_BYTES = 132 * 1024;
constexpr float DN_ALPHA = 1.681792830507429f;

struct Params { const float* in[20]; float* out; unsigned char* ws; float lam_init[4]; };

typedef __bf16 bf2_t __attribute__((ext_vector_type(2)));
typedef float f32x2 __attribute__((ext_vector_type(2)));
__device__ __forceinline__ unsigned cvtpk(float lo, float hi) { f32x2 v = {lo, hi}; bf2_t b = __builtin_convertvector(v, bf2_t); return __builtin_bit_cast(unsigned, b); }
__device__ __forceinline__ int otid() { int t = threadIdx.x; asm volatile("" : "+v"(t)); return t; }
__device__ __forceinline__ float bf2f(unsigned short b) { return __uint_as_float(((unsigned)b) << 16); }
__device__ __forceinline__ void st_bf4(bf16_t* p, f32x4 v) { u32x2 w; w.x = cvtpk(v[0], v[1]); w.y = cvtpk(v[2], v[3]); *(GAS u32x2*)p = w; }

constexpr int BM = 256, BK = 64, HALF = 128, HTB = HALF * BK * 2, NXCD = 8, WGM = 8;
__device__ __forceinline__ int lds_byte(int r, int c) { const int st = (r >> 4) * 2 + (c >> 5), rr = r & 15, cc = c & 31, ob = rr * 64 + cc * 2; return st * 1024 + (ob ^ (((ob >> 9) & 1) << 5)); }
__device__ __forceinline__ void stage_rc(int b, int& R, int& C) { const int st = b / 1024, sb = b % 1024, swz = sb ^ (((sb >> 9) & 1) << 5); R = (st >> 1) * 16 + swz / 64; C = (st & 1) * 32 + (swz % 64) / 2; }
struct Unit { int pm, pn; };
struct StaticOrder {
    int nM, nN, nwg, G, c;
    __device__ void init(int M, int N, int G_, int c_) { nM = M / BM; nN = N / BM; nwg = nM * nN; G = G_; c = c_; }
    __device__ bool next(int i, Unit& u) const {
        const long L = (long)i * G + c; if (L >= nwg) return false;
        int wgid = (int)L; { const int q = nwg / NXCD, r = nwg % NXCD, xcd = wgid % NXCD, off = wgid / NXCD; wgid = (xcd < r ? xcd * (q + 1) : r * (q + 1) + (xcd - r) * q) + off; }
        const int nig = WGM * nN, gid = wgid / nig, fm = gid * WGM, gsz = (nM - fm) < WGM ? (nM - fm) : WGM;
        u.pm = __builtin_amdgcn_readfirstlane(fm + ((wgid % nig) % gsz)); u.pn = __builtin_amdgcn_readfirstlane((wgid % nig) / gsz); return true;
    }
};

template <class Epi>
__device__ __forceinline__ void gemm_phase(LAS unsigned char* lds, const bf16_t* A, int lda, const bf16_t* Bt, int ldb, int M, int N, int K, const Epi& E) {
    const int tid = otid(), wid = __builtin_amdgcn_readfirstlane(tid >> 6), lane = tid & 63, wr = wid >> 2, wc = wid & 3, fr = lane & 15, fq = lane >> 4;
    int ntv_ = K / BK; asm volatile("" : "+v"(ntv_)); const int nt = __builtin_amdgcn_readfirstlane(ntv_);
    StaticOrder S; S.init(M, N, (int)gridDim.x, (int)blockIdx.x);
    unsigned voffA[2], voffB[2];
#pragma unroll
    for (int i = 0; i < 2; ++i) { int R, C; stage_rc(tid * 16 + i * 8192, R, C); voffA[i] = (unsigned)(R * lda + C) * 2u; voffB[i] = (unsigned)(R * ldb + C) * 2u; }
    const size_t kstep = (size_t)(BK * 2);
    const size_t hstepA = (size_t)HALF * lda * 2, tstepA = 2 * hstepA, hstepB = (size_t)HALF * ldb * 2, tstepB = 2 * hstepB;
    const unsigned ldsw = (unsigned)wid * 1024u;
    const int aoff = lds_byte(wr * 64 + fr, fq * 8), boff = lds_byte(wc * 32 + fr, fq * 8);
#define PG8_SA(b, h) (((b) * 2 + (h)) * HTB)
#define PG8_SB(b, h) ((4 + (b) * 2 + (h)) * HTB)
#define PG8_STAGE(bufoff, gbase, voff) do { _Pragma("unroll") for (int _i = 0; _i < 2; ++_i) \
        __builtin_amdgcn_global_load_lds((const unsigned*)((const char*)(gbase) + (voff)[_i]), (LAS unsigned*)(lds + (bufoff) + ldsw + _i * 8192), 16, 0, 0); } while (0)
#define PG8_LDA(dst, b, h) do { _Pragma("unroll") for (int m = 0; m < 4; ++m) _Pragma("unroll") for (int k = 0; k < 2; ++k) dst[m][k] = *(const LAS bf16x8*)(lds + PG8_SA(b, h) + aoff + m * 2048 + k * 1024); } while (0)
#define PG8_LDB(dst, b, h) do { _Pragma("unroll") for (int n = 0; n < 2; ++n) _Pragma("unroll") for (int k = 0; k < 2; ++k) dst[n][k] = *(const LAS bf16x8*)(lds + PG8_SB(b, h) + boff + n * 2048 + k * 1024); } while (0)
#define PG8_MMA(ai, bj, At, Bt_) do { __builtin_amdgcn_s_setprio(1); _Pragma("unroll") for (int m = 0; m < 4; ++m) _Pragma("unroll") for (int n = 0; n < 2; ++n) _Pragma("unroll") for (int k = 0; k < 2; ++k) \
        acc[ai][bj][m][n] = __builtin_amdgcn_mfma_f32_16x16x32_bf16(Bt_[n][k], At[m][k], acc[ai][bj][m][n], 0, 0, 0); __builtin_amdgcn_s_setprio(0); } while (0)
#define PG8_WAIT_V(n) asm volatile("s_waitcnt vmcnt(" #n ")" ::: "memory")
#define PG8_WAIT_L(n) asm volatile("s_waitcnt lgkmcnt(" #n ")" ::: "memory")
#define PG8_BAR __builtin_amdgcn_s_barrier()
#define PG8_SCHED __builtin_amdgcn_sched_barrier(0)
    Unit cur, nxt; int ui = 0;
    if (!S.next(0, cur)) return;
    f32x4 acc[2][2][4][2];
#pragma unroll
    for (int a = 0; a < 2; ++a)
#pragma unroll
        for (int b = 0; b < 2; ++b)
#pragma unroll
            for (int m = 0; m < 4; ++m)
#pragma unroll
                for (int n = 0; n < 2; ++n) acc[a][b][m][n] = (f32x4){0.f, 0.f, 0.f, 0.f};
    bf16x8 At[4][2], B0[2][2], B1[2][2];
    const char* cA = (const char*)A + (size_t)cur.pm * tstepA; const char* cB = (const char*)Bt + (size_t)cur.pn * tstepB;
    PG8_STAGE(PG8_SB(0, 0), cB, voffB); PG8_STAGE(PG8_SA(0, 0), cA, voffA); PG8_STAGE(PG8_SB(0, 1), cB + hstepB, voffB); PG8_STAGE(PG8_SA(0, 1), cA + hstepA, voffA);
    if (wr == 1) PG8_BAR;
    PG8_WAIT_V(4); PG8_BAR;
    PG8_STAGE(PG8_SB(1, 0), cB + kstep, voffB); PG8_STAGE(PG8_SA(1, 0), cA + kstep, voffA); PG8_STAGE(PG8_SB(1, 1), cB + hstepB + kstep, voffB);
    PG8_WAIT_V(6); PG8_BAR;
    for (;;) {
        const bool has_next = S.next(ui + 1, nxt);
        const char* nA = has_next ? (const char*)A + (size_t)nxt.pm * tstepA : cA; const char* nB = has_next ? (const char*)Bt + (size_t)nxt.pn * tstepB : cB;
#pragma unroll 1
        for (int t = 0; t < nt; t += 2) {
            const bool last = (t == nt - 2);
            const char* a1 = cA + (size_t)(t + 1) * kstep;
            const char* a2 = last ? nA : cA + (size_t)(t + 2) * kstep; const char* b2 = last ? nB : cB + (size_t)(t + 2) * kstep;
            const char* a3 = a2 + kstep; const char* b3 = b2 + kstep;
            PG8_LDB(B0, 0, 0); PG8_SCHED; PG8_LDA(At, 0, 0); PG8_STAGE(PG8_SA(1, 1), a1 + hstepA, voffA);
            PG8_WAIT_L(8); PG8_BAR; PG8_WAIT_L(0); PG8_MMA(0, 0, At, B0); PG8_BAR; PG8_SCHED;
            PG8_LDB(B1, 0, 1); PG8_STAGE(PG8_SB(0, 0), b2, voffB);
            PG8_BAR; PG8_WAIT_L(0); PG8_MMA(0, 1, At, B1); PG8_BAR;
            PG8_LDA(At, 0, 1); PG8_STAGE(PG8_SA(0, 0), a2, voffA);
            PG8_BAR; PG8_WAIT_L(0); PG8_MMA(1, 0, At, B0); PG8_BAR; PG8_SCHED;
            PG8_STAGE(PG8_SB(0, 1), b2 + hstepB, voffB);
            PG8_WAIT_V(6); PG8_BAR; PG8_MMA(1, 1, At, B1); PG8_BAR;
            PG8_LDB(B0, 1, 0); PG8_SCHED; PG8_LDA(At, 1, 0); PG8_STAGE(PG8_SA(0, 1), a2 + hstepA, voffA);
            PG8_WAIT_L(8); PG8_BAR; PG8_WAIT_L(0); PG8_MMA(0, 0, At, B0); PG8_BAR; PG8_SCHED;
            PG8_LDB(B1, 1, 1); PG8_STAGE(PG8_SB(1, 0), b3, voffB);
            PG8_BAR; PG8_WAIT_L(0); PG8_MMA(0, 1, At, B1); PG8_BAR;
            PG8_LDA(At, 1, 1); PG8_STAGE(PG8_SA(1, 0), a3, voffA);
            PG8_BAR; PG8_WAIT_L(0); PG8_MMA(1, 0, At, B0); PG8_BAR; PG8_SCHED;
            PG8_STAGE(PG8_SB(1, 1), b3 + hstepB, voffB);
            PG8_WAIT_V(6); PG8_BAR; PG8_MMA(1, 1, At, B1); PG8_BAR;
        }
        E(acc, cur, wr, wc, fr, fq);
        if (!has_next) break;
#pragma unroll
        for (int a = 0; a < 2; ++a)
#pragma unroll
            for (int b = 0; b < 2; ++b)
#pragma unroll
                for (int m = 0; m < 4; ++m)
#pragma unroll
                    for (int n = 0; n < 2; ++n) acc[a][b][m][n] = (f32x4){0.f, 0.f, 0.f, 0.f};
        cur = nxt; cA = nA; cB = nB; ++ui;
    }
    PG8_WAIT_V(0);
    if (wr == 0) PG8_BAR;
    PG8_BAR;
#undef PG8_SA
#undef PG8_SB
#undef PG8_STAGE
#undef PG8_LDA
#undef PG8_LDB
#undef PG8_MMA
#undef PG8_WAIT_V
#undef PG8_WAIT_L
#undef PG8_BAR
#undef PG8_SCHED
}

struct EpiIn {
    bf16_t *pa, *pd, *mc, *gt; float* ssq; const float* bg; const float *cd, *sd, *cm, *sm;
    __device__ __forceinline__ void operator()(const f32x4 (&acc)[2][2][4][2], const Unit& u, int wr, int wc, int fr, int fq) const {
        int row0 = u.pm * BM + wr * 64 + fr; asm volatile("" : "+v"(row0) :: "memory"); const int pn = u.pn, cw = wc * 32 + 4 * fq;
        if (pn < 6) {
#pragma unroll
            for (int ai = 0; ai < 2; ++ai)
#pragma unroll
                for (int m = 0; m < 4; ++m) { __builtin_amdgcn_sched_barrier(0); bf16_t* rp = pa + (size_t)(row0 + ai * HALF + m * 16) * 1536 + pn * 256 + cw;
#pragma unroll
                    for (int bj = 0; bj < 2; ++bj)
#pragma unroll
                        for (int n = 0; n < 2; ++n) st_bf4(rp + bj * HALF + n * 16, acc[ai][bj][m][n]); }
        } else if (pn < 12) {
            const bool rope = (pn < 10) && !(wc & 1);
#pragma unroll
            for (int ai = 0; ai < 2; ++ai)
#pragma unroll
                for (int m = 0; m < 4; ++m) { __builtin_amdgcn_sched_barrier(0); const int row = row0 + ai * HALF + m * 16; bf16_t* rp = pd + (size_t)row * 1536 + (pn - 6) * 256 + cw;
                    f32x4 c4 = {1.f, 1.f, 1.f, 1.f}, s4 = {0.f, 0.f, 0.f, 0.f};
                    if (rope) { const int pos = row & (SEQ - 1); c4 = *(const GAS f32x4*)(cd + pos * 8 + (fq & 1) * 4); s4 = *(const GAS f32x4*)(sd + pos * 8 + (fq & 1) * 4); }
#pragma unroll
                    for (int bj = 0; bj < 2; ++bj) { f32x4 v0 = acc[ai][bj][m][0];
                        if (rope) { f32x4 pr;
#pragma unroll
                            for (int j = 0; j < 4; ++j) pr[j] = __shfl_xor(v0[j], 32);
                            v0 = (fq < 2) ? (v0 * c4 - pr * s4) : (v0 * c4 + pr * s4); }
                        st_bf4(rp + bj * HALF, v0); st_bf4(rp + bj * HALF + 16, acc[ai][bj][m][1]); } }
        } else if (pn < 15) {
            const int t = pn - 12;
#pragma unroll
            for (int ai = 0; ai < 2; ++ai)
#pragma unroll
                for (int m = 0; m < 4; ++m) { __builtin_amdgcn_sched_barrier(0); const int row = row0 + ai * HALF + m * 16; bf16_t* rp = mc + (size_t)row * 768 + t * 256 + cw;
#pragma unroll
                    for (int bj = 0; bj < 2; ++bj) { f32x4 v0 = acc[ai][bj][m][0], v1 = acc[ai][bj][m][1];
                        float s = (v0[0] * v0[0] + v0[1] * v0[1]) + (v0[2] * v0[2] + v0[3] * v0[3]) + (v1[0] * v1[0] + v1[1] * v1[1]) + (v1[2] * v1[2] + v1[3] * v1[3]);
                        s += __shfl_xor(s, 16); s += __shfl_xor(s, 32);
                        if (fq == 0) *(GAS float*)(ssq + (size_t)row * 24 + t * 8 + bj * 4 + wc) = s;
                        if (t == 2 && bj == 1 && wc == 0) { const int pos = row & (SEQ - 1); const f32x4 c4 = *(const GAS f32x4*)(cm + pos * 16 + fq * 4), s4 = *(const GAS f32x4*)(sm + pos * 16 + fq * 4);
                            const f32x4 n0 = v0 * c4 - v1 * s4, n1 = v1 * c4 + v0 * s4; v0 = n0; v1 = n1; }
                        st_bf4(rp + bj * HALF, v0); st_bf4(rp + bj * HALF + 16, v1); } }
        } else {
            const int t = pn - 15;
            f32x4 bv[2][2];
#pragma unroll
            for (int bj = 0; bj < 2; ++bj)
#pragma unroll
                for (int n = 0; n < 2; ++n) bv[bj][n] = *(const GAS f32x4*)(bg + t * 256 + bj * HALF + n * 16 + cw);
#pragma unroll
            for (int ai = 0; ai < 2; ++ai)
#pragma unroll
                for (int m = 0; m < 4; ++m) { __builtin_amdgcn_sched_barrier(0); bf16_t* rp = gt + (size_t)(row0 + ai * HALF + m * 16) * 3072 + t * 256 + cw;
#pragma unroll
                    for (int bj = 0; bj < 2; ++bj)
#pragma unroll
                        for (int n = 0; n < 2; ++n) { f32x4 v = acc[ai][bj][m][n] + bv[bj][n];
#pragma unroll
                            for (int j = 0; j < 4; ++j) v[j] = __builtin_amdgcn_rcpf(1.0f + __expf(-v[j]));
                            st_bf4(rp + bj * HALF + n * 16, v); } }
        }
    }
};
struct EpiQ {
    bf16_t* mq; const float* ssq; const float *cm, *sm;
    __device__ __forceinline__ void operator()(const f32x4 (&acc)[2][2][4][2], const Unit& u, int wr, int wc, int fr, int fq) const {
        int row0 = u.pm * BM + wr * 64 + fr; asm volatile("" : "+v"(row0) :: "memory"); const int cw = wc * 32 + 4 * fq;
        float rr8[8];
#pragma unroll
        for (int i = 0; i < 8; ++i) { const float* sp = ssq + (size_t)(row0 + (i >> 2) * HALF + (i & 3) * 16) * 24 + fq * 4;
            const f32x4 a = *(const GAS f32x4*)sp;
            float ss = fq < 3 ? ((a[0] + a[1]) + (a[2] + a[3])) : 0.f;
            ss += __shfl_xor(ss, 16); ss += __shfl_xor(ss, 32);
            rr8[i] = rsqrtf(ss * (1.0f / 384.0f) + 1e-6f); }
#pragma unroll
        for (int ai = 0; ai < 2; ++ai)
#pragma unroll
            for (int m = 0; m < 4; ++m) { __builtin_amdgcn_sched_barrier(0); const int row = row0 + ai * HALF + m * 16; const float r = rr8[ai * 4 + m];
                bf16_t* rp = mq + (size_t)row * 768 + u.pn * 256 + cw;
#pragma unroll
                for (int bj = 0; bj < 2; ++bj) { const int G = u.pn * 8 + bj * 4 + wc; f32x4 v0 = acc[ai][bj][m][0] * r, v1 = acc[ai][bj][m][1] * r;
                    if (G % 3 == 2) { const int pos = row & (SEQ - 1); const f32x4 c4 = *(const GAS f32x4*)(cm + pos * 16 + fq * 4), s4 = *(const GAS f32x4*)(sm + pos * 16 + fq * 4);
                        const f32x4 n0 = v0 * c4 - v1 * s4, n1 = v1 * c4 + v0 * s4; v0 = n0; v1 = n1; }
                    st_bf4(rp + bj * HALF, v0); st_bf4(rp + bj * HALF + 16, v1); } }
    }
};
struct EpiKV {
    bf16_t* mkv; const float* ssq;
    __device__ __forceinline__ void operator()(const f32x4 (&acc)[2][2][4][2], const Unit& u, int wr, int wc, int fr, int fq) const {
        int row0 = u.pm * BM + wr * 64 + fr; asm volatile("" : "+v"(row0) :: "memory"); const int cw = wc * 32 + 4 * fq;
        float rr8[8];
#pragma unroll
        for (int i = 0; i < 8; ++i) { const float* sp = ssq + (size_t)(row0 + (i >> 2) * HALF + (i & 3) * 16) * 24 + 12 + (fq & 1) * 4;
            const f32x4 a = *(const GAS f32x4*)sp;
            float ss = fq < 2 ? ((a[0] + a[1]) + (a[2] + a[3])) : 0.f;
            ss += __shfl_xor(ss, 16); ss += __shfl_xor(ss, 32);
            rr8[i] = rsqrtf(ss * (1.0f / 256.0f) + 1e-6f); }
#pragma unroll
        for (int ai = 0; ai < 2; ++ai)
#pragma unroll
            for (int m = 0; m < 4; ++m) { __builtin_amdgcn_sched_barrier(0); const int row = row0 + ai * HALF + m * 16; const float r = rr8[ai * 4 + m];
                bf16_t* rp = mkv + (size_t)row * 1024 + u.pn * 256 + cw;
#pragma unroll
                for (int bj = 0; bj < 2; ++bj)
#pragma unroll
                    for (int n = 0; n < 2; ++n) st_bf4(rp + bj * HALF + n * 16, acc[ai][bj][m][n] * r); }
    }
};
struct EpiBr {
    bf16_t* gt;
    __device__ __forceinline__ void operator()(const f32x4 (&acc)[2][2][4][2], const Unit& u, int wr, int wc, int fr, int fq) const {
        int row0 = u.pm * BM + wr * 64 + fr; asm volatile("" : "+v"(row0) :: "memory"); const int cw = wc * 32 + 4 * fq;
#pragma unroll
        for (int ai = 0; ai < 2; ++ai)
#pragma unroll
            for (int m = 0; m < 4; ++m) { __builtin_amdgcn_sched_barrier(0); bf16_t* rp = gt + (size_t)(row0 + ai * HALF + m * 16) * 3072 + u.pn * 256 + cw;
#pragma unroll
                for (int bj = 0; bj < 2; ++bj)
#pragma unroll
                    for (int n = 0; n < 2; ++n) { bf16_t* p = rp + bj * HALF + n * 16; const u32x2 g = *(const GAS u32x2*)p; const f32x4 a = acc[ai][bj][m][n];
                        f32x4 v; v[0] = a[0] * __uint_as_float(g.x << 16); v[1] = a[1] * __uint_as_float(g.x & 0xffff0000u); v[2] = a[2] * __uint_as_float(g.y << 16); v[3] = a[3] * __uint_as_float(g.y & 0xffff0000u);
                        st_bf4(p, v); } }
    }
};
struct EpiRes {
    float* x;
    __device__ __forceinline__ void operator()(const f32x4 (&acc)[2][2][4][2], const Unit& u, int wr, int wc, int fr, int fq) const {
        int row0 = u.pm * BM + wr * 64 + fr; asm volatile("" : "+v"(row0) :: "memory"); const int cw = wc * 32 + 4 * fq;
#pragma unroll
        for (int ai = 0; ai < 2; ++ai)
#pragma unroll
            for (int m = 0; m < 4; ++m) { __builtin_amdgcn_sched_barrier(0); float* rp = x + (size_t)(row0 + ai * HALF + m * 16) * 1024 + u.pn * 256 + cw;
#pragma unroll
                for (int bj = 0; bj < 2; ++bj)
#pragma unroll
                    for (int n = 0; n < 2; ++n) { float* p = rp + bj * HALF + n * 16; const f32x4 xv = *(const GAS f32x4*)p; *(GAS f32x4*)p = xv * DN_ALPHA + acc[ai][bj][m][n]; } }
    }
};
struct EpiF1 {
    bf16_t* hd;
    __device__ __forceinline__ void operator()(const f32x4 (&acc)[2][2][4][2], const Unit& u, int wr, int wc, int fr, int fq) const {
        int row0 = u.pm * BM + wr * 64 + fr; asm volatile("" : "+v"(row0) :: "memory"); const int cw = wc * 32 + 4 * fq;
#pragma unroll
        for (int ai = 0; ai < 2; ++ai)
#pragma unroll
            for (int m = 0; m < 4; ++m) { __builtin_amdgcn_sched_barrier(0); bf16_t* rp = hd + (size_t)(row0 + ai * HALF + m * 16) * DFF + u.pn * 128 + cw;
#pragma unroll
                for (int n = 0; n < 2; ++n) { const f32x4 g = acc[ai][0][m][n], uu = acc[ai][1][m][n]; f32x4 v;
#pragma unroll
                    for (int j = 0; j < 4; ++j) v[j] = g[j] * __builtin_amdgcn_rcpf(1.0f + __expf(-g[j])) * uu[j];
                    st_bf4(rp + n * 16, v); } }
    }
};

constexpr int SHM_V = 64 * 128 * 2, SHM_K = 64 * 128 * 2;
#define KSWZ(row, colB) ((row) * 256 + ((colB) ^ (((row) & 7) << 4)))
#define SBAR() __builtin_amdgcn_sched_barrier(0)
__device__ __forceinline__ int crow(int r, int hi) { return (r & 3) + 8 * (r >> 2) + 4 * hi; }
struct NaCtx { int vlo, vhi, wstart, qc, drow0; const LAS float* tab; };

template <int MODE>
__device__ __forceinline__ void partialSM(f32x16& p0, f32x16& p1, float& m_reg, float& mn, float& alpha, const NaCtx& na, int t, int hi) {
    constexpr float SCALE = MODE == 2 ? 0.10206207261596575f : 0.125f;
    constexpr float C = SCALE * 1.4426950408889634f;
    constexpr float THRS = 8.f / SCALE;
    if (MODE == 0) {
        const float NINF = -__builtin_inff();
        if (t < na.vlo || t >= na.vhi) {
#pragma unroll
            for (int r = 0; r < 16; ++r) { p0[r] = NINF; p1[r] = NINF; }
        } else {
            const LAS float* trow = na.tab + (na.drow0 + t) * 31 + (15 - na.qc);
#pragma unroll
            for (int q4 = 0; q4 < 4; ++q4) {
#pragma unroll
                for (int r = q4 * 4; r < q4 * 4 + 4; ++r) { const int kc = crow(r, hi); const bool ok0 = (unsigned)(kc - na.wstart) < 16u, ok1 = (unsigned)(kc + 32 - na.wstart) < 16u;
                    const float b0 = trow[ok0 ? kc : na.wstart], b1 = trow[ok1 ? kc + 32 : na.wstart];
                    p0[r] = ok0 ? p0[r] + b0 : NINF; p1[r] = ok1 ? p1[r] + b1 : NINF; }
                __builtin_amdgcn_sched_barrier(0); }
        }
    }
    float pmax = p0[0];
#pragma unroll
    for (int r = 1; r < 16; ++r) pmax = fmaxf(pmax, p0[r]);
#pragma unroll
    for (int r = 0; r < 16; ++r) pmax = fmaxf(pmax, p1[r]);
    { auto rr = __builtin_amdgcn_permlane32_swap(__float_as_uint(pmax), __float_as_uint(pmax), false, false);
      pmax = fmaxf(__uint_as_float(rr[0]), __uint_as_float(rr[1])); }
    if (__builtin_expect(__all(pmax - m_reg <= THRS), 1)) { mn = m_reg; alpha = 1.f; }
    else { mn = fmaxf(m_reg, pmax); alpha = __builtin_amdgcn_exp2f((m_reg - mn) * C); m_reg = mn; }
    const float mnC = -mn * C;
#pragma unroll
    for (int r = 0; r < 16; ++r) p0[r] = fmaf(p0[r], C, mnC);
#pragma unroll
    for (int r = 0; r < 16; ++r) p1[r] = fmaf(p1[r], C, mnC);
#pragma unroll
    for (int r = 0; r < 16; ++r) p0[r] = __builtin_amdgcn_exp2f(p0[r]);
}
__device__ __forceinline__ void finishSM(f32x16& p0, f32x16& p1, float alpha, float& l_reg, bf16x8& pa0, bf16x8& pa1, bf16x8& pa2, bf16x8& pa3) {
#pragma unroll
    for (int r = 0; r < 16; ++r) p1[r] = __builtin_amdgcn_exp2f(p1[r]);
    float ps = 0;
#pragma unroll
    for (int r = 0; r < 16; ++r) ps += p0[r];
#pragma unroll
    for (int r = 0; r < 16; ++r) ps += p1[r];
    { auto rr = __builtin_amdgcn_permlane32_swap(__float_as_uint(ps), __float_as_uint(ps), false, false);
      ps = __uint_as_float(rr[0]) + __uint_as_float(rr[1]); }
    l_reg = l_reg * alpha + ps;
#define PK4(P, BASE, OUT) do { unsigned a0 = cvtpk(P[BASE + 0], P[BASE + 1]), a1 = cvtpk(P[BASE + 2], P[BASE + 3]);   \
    unsigned b0 = cvtpk(P[BASE + 4], P[BASE + 5]), b1 = cvtpk(P[BASE + 6], P[BASE + 7]);                              \
    auto r0 = __builtin_amdgcn_permlane32_swap(a0, b0, false, false); auto r1 = __builtin_amdgcn_permlane32_swap(a1, b1, false, false); \
    u32x4 w = {r0[0], r1[0], r0[1], r1[1]}; OUT = *reinterpret_cast<bf16x8*>(&w); } while (0)
    PK4(p0, 0, pa0); PK4(p0, 8, pa1); PK4(p1, 0, pa2); PK4(p1, 8, pa3);
#undef PK4
}
template <int ND>
__device__ __forceinline__ void qkt(f32x16& p0, f32x16& p1, const char* Ks, const bf16x8* qr, int r32, int hi) {
    p0 = f32x16{}; p1 = f32x16{};
#pragma unroll
    for (int d0 = 0; d0 < ND; ++d0) { const int cb = (d0 * 16 + hi * 8) * 2;
        const bf16x8 b0 = *reinterpret_cast<const bf16x8*>(Ks + KSWZ(r32, cb));
        const bf16x8 b1 = *reinterpret_cast<const bf16x8*>(Ks + KSWZ(32 + r32, cb));
        p0 = __builtin_amdgcn_mfma_f32_32x32x16_bf16(b0, qr[d0], p0, 0, 0, 0);
        p1 = __builtin_amdgcn_mfma_f32_32x32x16_bf16(b1, qr[d0], p1, 0, 0, 0); }
}
__device__ __forceinline__ int v_st(int k, int c) { const int kk = (k & ~0xC) | ((k & 4) << 1) | ((k & 8) >> 1); return ((kk >> 3) * 4 + (c >> 5)) * 512 + ((kk & 7) * 32 + (c & 31)) * 2; }
__device__ __forceinline__ int v_rd_base(int lane) { return ((lane & 3) << 3) | (((lane >> 2) & 3) << 6) | (((lane >> 4) & 1) << 5) | (((lane >> 5) & 1) << 8); }
constexpr int v_rd_off(int d0, int ks, int half) { return d0 * 512 + ks * 4096 + half * 2048; }
template <int OFF> __device__ __forceinline__ s16x4 tr_read(int vb) {
    s16x4 r; asm volatile("ds_read_b64_tr_b16 %0, %1 offset:%2" : "=&v"(r) : "v"(vb), "i"(OFF) : "memory"); return r;
}
template <int D0> __device__ __forceinline__ void pv_one(f32x16& od, int vb, bf16x8 pa0, bf16x8 pa1, bf16x8 pa2, bf16x8 pa3) {
    const s16x4 l0 = tr_read<v_rd_off(D0, 0, 0)>(vb), h0 = tr_read<v_rd_off(D0, 0, 1)>(vb), l1 = tr_read<v_rd_off(D0, 1, 0)>(vb), h1 = tr_read<v_rd_off(D0, 1, 1)>(vb);
    const s16x4 l2 = tr_read<v_rd_off(D0, 2, 0)>(vb), h2 = tr_read<v_rd_off(D0, 2, 1)>(vb), l3 = tr_read<v_rd_off(D0, 3, 0)>(vb), h3 = tr_read<v_rd_off(D0, 3, 1)>(vb);
    asm volatile("s_waitcnt lgkmcnt(0)" ::: "memory"); SBAR();
#define PKV(L, H) (bf16x8){L[0], L[1], L[2], L[3], H[0], H[1], H[2], H[3]}
    od = __builtin_amdgcn_mfma_f32_32x32x16_bf16(pa0, PKV(l0, h0), od, 0, 0, 0);
    od = __builtin_amdgcn_mfma_f32_32x32x16_bf16(pa1, PKV(l1, h1), od, 0, 0, 0);
    od = __builtin_amdgcn_mfma_f32_32x32x16_bf16(pa2, PKV(l2, h2), od, 0, 0, 0);
    od = __builtin_amdgcn_mfma_f32_32x32x16_bf16(pa3, PKV(l3, h3), od, 0, 0, 0);
#undef PKV
}
template <int NO> __device__ __forceinline__ void pv_d0(f32x16* o, int vb, bf16x8 pa0, bf16x8 pa1, bf16x8 pa2, bf16x8 pa3) {
    pv_one<0>(o[0], vb, pa0, pa1, pa2, pa3); pv_one<1>(o[1], vb, pa0, pa1, pa2, pa3);
    if constexpr (NO == 4) { pv_one<2>(o[2], vb, pa0, pa1, pa2, pa3); pv_one<3>(o[3], vb, pa0, pa1, pa2, pa3); }
}

template <int DQ, int DV, int MODE, int ldq, int ldk, int ldk2, int ldv, int SD>
__device__ __forceinline__ void attn_core(const bf16_t* __restrict__ Qb, const bf16_t* __restrict__ K1, const bf16_t* __restrict__ K2,
                                          const bf16_t* __restrict__ Vh, int NT, char* lds, f32x16 (&o)[DV / 32], float (&rli)[16], const NaCtx& na) {
    constexpr int ND = DQ / 16, NO = DV / 32;
    const int tid = otid(), wid = tid >> 6, lane = tid & 63, r32 = lane & 31, hi = lane >> 5;
    char* V_lds = lds; char* K_lds = lds + 2 * SHM_V;
    float* ws = (float*)(lds + 2 * SHM_V + 2 * SHM_K) + wid * 64; float* li_l = ws; float* al_l = ws + 32;
    float m_reg = -1e30f, l_reg = 0;
#pragma unroll
    for (int d = 0; d < NO; ++d) o[d] = f32x16{};
    bf16x8 qr[ND];
    const bf16_t* Qw = Qb + (long)(wid * 32 + r32) * ldq + hi * 8;
#pragma unroll
    for (int d0 = 0; d0 < ND; ++d0) qr[d0] = *(const GAS bf16x8*)(Qw + d0 * 16);
    const int sr = tid >> 4, sc = (tid & 15) * 8, vst0 = v_st(sr, sc), vst1 = v_st(32 + sr, sc);
    const int vb0 = (int)(uintptr_t)V_lds + v_rd_base(lane);
    const bool ldV = sc < DV, ldK = sc < DQ;
    const bf16_t* kp; long kld;
    if (DQ > 64 && sc >= 64) { kp = K2 + (sc - 64); kld = ldk2; } else { kp = K1 + sc; kld = ldk; }
    const bf16_t* vp = Vh + sc;
    struct Slot { bf16x8 vs0, vs1, ks0, ks1; };
    Slot sA, sB; sA.vs0 = sA.vs1 = sA.ks0 = sA.ks1 = bf16x8{}; sB = sA;
    Slot& sO = (SD == 2) ? sB : sA;
#define SLOAD(S_, k0) do { if (ldV) { S_.vs0 = *(const GAS bf16x8*)(vp + (long)((k0) + sr) * ldv); S_.vs1 = *(const GAS bf16x8*)(vp + (long)((k0) + 32 + sr) * ldv); } \
    if (ldK) { S_.ks0 = *(const GAS bf16x8*)(kp + (long)((k0) + sr) * kld); S_.ks1 = *(const GAS bf16x8*)(kp + (long)((k0) + 32 + sr) * kld); } } while (0)
#define SWRITE(b, S_) do { if (ldV) { *(bf16x8*)(V_lds + (b) * SHM_V + vst0) = S_.vs0; *(bf16x8*)(V_lds + (b) * SHM_V + vst1) = S_.vs1; } \
    if (ldK) { const int kc = sc * 2; *(bf16x8*)(K_lds + (b) * SHM_K + KSWZ(sr, kc)) = S_.ks0; *(bf16x8*)(K_lds + (b) * SHM_K + KSWZ(32 + sr, kc)) = S_.ks1; } } while (0)
#define SWAIT() do { if (SD == 2) asm volatile("s_waitcnt vmcnt(4)" ::: "memory"); else asm volatile("s_waitcnt vmcnt(0)" ::: "memory"); } while (0)
#define RESC(a) do { if (__any((a) < 1.f)) { if (hi == 0) al_l[r32] = (a); asm volatile("s_waitcnt lgkmcnt(0)" ::: "memory"); \
    _Pragma("unroll") for (int d = 0; d < NO; ++d) _Pragma("unroll") for (int r = 0; r < 16; ++r) o[d][r] *= al_l[crow(r, hi)]; } } while (0)
    f32x16 pA0, pA1, pB0, pB1; float mnA, mnB, alA, alB; bf16x8 pa0, pa1, pa2, pa3;
    SLOAD(sA, 0); asm volatile("s_waitcnt vmcnt(0)" ::: "memory"); SWRITE(0, sA); __syncthreads();
    qkt<ND>(pA0, pA1, K_lds, qr, r32, hi); partialSM<MODE>(pA0, pA1, m_reg, mnA, alA, na, 0, hi);
    SLOAD(sO, 64); if (SD == 2 && 2 < NT) SLOAD(sA, 128);
    SWAIT(); SWRITE(1, sO); __syncthreads();
    for (int j = 1; j + 1 < NT; j += 2) {
        SBAR(); qkt<ND>(pB0, pB1, K_lds + SHM_K, qr, r32, hi);
        finishSM(pA0, pA1, alA, l_reg, pa0, pa1, pa2, pa3); SBAR();
        SLOAD(sO, (j + SD) * 64); SBAR();
        pv_d0<NO>(o, vb0, pa0, pa1, pa2, pa3); partialSM<MODE>(pB0, pB1, m_reg, mnB, alB, na, j, hi);
        __syncthreads(); SWAIT(); SWRITE(0, sA);
        RESC(alB); __syncthreads();
        SBAR(); qkt<ND>(pA0, pA1, K_lds, qr, r32, hi);
        finishSM(pB0, pB1, alB, l_reg, pa0, pa1, pa2, pa3); SBAR();
        if (SD == 1 || j + 3 < NT) SLOAD(sA, (j + 1 + SD) * 64); SBAR();
        pv_d0<NO>(o, vb0 + SHM_V, pa0, pa1, pa2, pa3); partialSM<MODE>(pA0, pA1, m_reg, mnA, alA, na, j + 1, hi);
        __syncthreads(); SWAIT(); SWRITE(1, sO);
        RESC(alA); __syncthreads();
    }
    SBAR(); qkt<ND>(pB0, pB1, K_lds + SHM_K, qr, r32, hi);
    finishSM(pA0, pA1, alA, l_reg, pa0, pa1, pa2, pa3); SBAR();
    pv_d0<NO>(o, vb0, pa0, pa1, pa2, pa3); partialSM<MODE>(pB0, pB1, m_reg, mnB, alB, na, NT - 1, hi);
    __syncthreads(); RESC(alB);
    finishSM(pB0, pB1, alB, l_reg, pa0, pa1, pa2, pa3); SBAR();
    pv_d0<NO>(o, vb0 + SHM_V, pa0, pa1, pa2, pa3);
    if (hi == 0) li_l[r32] = l_reg;
    asm volatile("s_waitcnt lgkmcnt(0)" ::: "memory");
#pragma unroll
    for (int r = 0; r < 16; ++r) rli[r] = __builtin_amdgcn_rcpf(li_l[crow(r, hi)]);
#undef SLOAD
#undef SWRITE
#undef SWAIT
#undef RESC
}

__device__ __forceinline__ void na_item(const Params& p, int l, int item, char* lds) {
    const int xcd = item & 7, slot = item >> 3;
    const int pair = xcd * 4 + (slot >> 4), rb = slot & 15, b = pair >> 3, h = pair & 7;
    bf16_t* pa = (bf16_t*)(p.ws + OFF_PA);
    const int r0 = rb * 4, lo = min(max(r0 - 4, 0), 52);
    const int tid = otid(), wid = tid >> 6, lane = tid & 63, r32 = lane & 31, hi = lane >> 5;
    LAS float* tab = (LAS float*)((LAS unsigned char*)(uintptr_t)(unsigned)(uintptr_t)lds + 130 * 1024);
    const float* rpb = p.in[5] + ((size_t)l * 8 + h) * 465;
    if (tid < 465) tab[tid] = ((const GAS float*)rpb)[tid] * 8.0f;
    NaCtx na; const int wu = __builtin_amdgcn_readfirstlane(wid); const int r = r0 + (wu >> 1), qc = 32 * (wu & 1) + r32, rs = min(max(r - 4, 0), 56);
    na.vlo = rs - lo; na.vhi = na.vlo + 8; na.wstart = min(max(qc - 8, 0), 48); na.qc = qc; na.drow0 = lo - r + 7; na.tab = tab;
    const size_t tb = (size_t)b * SEQ;
    bf16_t* Q = pa + (tb + (size_t)r0 * 64) * 1536 + h * 64;
    const bf16_t* K = pa + (tb + (size_t)lo * 64) * 1536 + 512 + h * 64;
    const bf16_t* V = K + 512;
    f32x16 o[2]; float rli[16];
    attn_core<64, 64, 0, 1536, 1536, 1536, 1536, 1>(Q, K, K, V, 12, lds, o, rli, na);
    bf16_t* Ow = Q + (size_t)(wid * 32) * 1536;
#pragma unroll
    for (int rr = 0; rr < 16; ++rr) { const int orow = crow(rr, hi);
#pragma unroll
        for (int d = 0; d < 2; ++d) { const float v = o[d][rr] * rli[rr]; ((GAS bf16_t*)Ow)[(size_t)orow * 1536 + d * 32 + r32] = (bf16_t)(cvtpk(v, v) & 0xffffu); } }
    __syncthreads();
}
__device__ __forceinline__ void diff_item(const Params& p, int l, int item, char* lds) {
    const int xcd = item & 7, slot = item >> 3;
    const int pair = xcd * 2 + (slot >> 4), qb = slot & 15, b = pair >> 2, h = pair & 3;
    bf16_t* pd = (bf16_t*)(p.ws + OFF_PD);
    const int tid = otid(), wid = tid >> 6, lane = tid & 63, r32 = lane & 31, hi = lane >> 5;
    const float* lv = p.in[6] + (size_t)l * 256;
    float s1 = 0.f, s2 = 0.f;
    for (int i = 0; i < 64; ++i) { s1 += ((const GAS float*)lv)[i] * ((const GAS float*)lv)[64 + i]; s2 += ((const GAS float*)lv)[128 + i] * ((const GAS float*)lv)[192 + i]; }
    const float lam_init = p.lam_init[l], lam = __expf(s1) - __expf(s2) + lam_init;
    const size_t tb = (size_t)b * SEQ;
    bf16_t* Q = pd + (tb + (size_t)qb * 256) * 1536 + h * 128;
    const bf16_t* K = pd + tb * 1536 + 512 + h * 128;
    const bf16_t* V = pd + tb * 1536 + 1024 + h * 128;
    NaCtx na{};
    unsigned short* stash = (unsigned short*)(lds + 66 * 1024) + (size_t)wid * 64 * 64 + lane;
    f32x16 o[4]; float rli[16];
    attn_core<64, 128, 1, 1536, 1536, 1536, 1536, 2>(Q, K, K, V, 64, lds, o, rli, na);
#pragma unroll
    for (int d = 0; d < 4; ++d)
#pragma unroll
        for (int rr = 0; rr < 16; ++rr) { const float v = o[d][rr] * rli[rr]; stash[(d * 16 + rr) * 64] = (unsigned short)(cvtpk(v, v) & 0xffffu); }
    __syncthreads();
    attn_core<64, 128, 1, 1536, 1536, 1536, 1536, 2>(Q + 64, K + 64, K, V, 64, lds, o, rli, na);
    const float* sg = p.in[7] + (size_t)l * 128;
    float gcol[4];
#pragma unroll
    for (int d = 0; d < 4; ++d) gcol[d] = ((const GAS float*)sg)[d * 32 + r32] * (1.0f - lam_init);
    bf16_t* Ow = Q + (size_t)(wid * 32) * 1536;
#pragma unroll
    for (int rr = 0; rr < 16; ++rr) {
        float v[4]; float ss = 0.f;
#pragma unroll
        for (int d = 0; d < 4; ++d) { v[d] = bf2f(stash[(d * 16 + rr) * 64]) - lam * (o[d][rr] * rli[rr]); ss += v[d] * v[d]; }
        ss += __shfl_xor(ss, 1); ss += __shfl_xor(ss, 2); ss += __shfl_xor(ss, 4); ss += __shfl_xor(ss, 8); ss += __shfl_xor(ss, 16);
        const float rn = rsqrtf(ss * (1.0f / 128.0f) + 1e-6f);
        const int orow = crow(rr, hi);
#pragma unroll
        for (int d = 0; d < 4; ++d) { const float y = v[d] * rn * gcol[d]; ((GAS bf16_t*)Ow)[(size_t)orow * 1536 + d * 32 + r32] = (bf16_t)(cvtpk(y, y) & 0xffffu); }
    }
    __syncthreads();
}
__device__ __forceinline__ void mla_item(const Params& p, int item, char* lds) {
    const int xcd = item & 7, slot = item >> 3;
    const int pair = xcd * 4 + (slot >> 4), qb = slot & 15, b = pair >> 3, h = pair & 7;
    const int tid = otid(), wid = tid >> 6, lane = tid & 63, r32 = lane & 31, hi = lane >> 5;
    bf16_t* mc = (bf16_t*)(p.ws + OFF_MC); const bf16_t* mq = (const bf16_t*)(p.ws + OFF_MQ); const bf16_t* mkv = (const bf16_t*)(p.ws + OFF_MKV);
    const size_t tb = (size_t)b * SEQ;
    const bf16_t* Q = mq + (tb + (size_t)qb * 256) * 768 + h * 96;
    const bf16_t* K1 = mkv + tb * 1024 + h * 128;
    const bf16_t* K2 = mc + tb * 768 + 640;
    const bf16_t* V = K1 + 64;
    NaCtx na{};
    f32x16 o[2]; float rli[16];
    attn_core<96, 64, 2, 768, 1024, 768, 1024, 2>(Q, K1, K2, V, 64, lds, o, rli, na);
    bf16_t* Ow = mc + (tb + (size_t)qb * 256 + wid * 32) * 768 + h * 64;
#pragma unroll
    for (int rr = 0; rr < 16; ++rr) { const int orow = crow(rr, hi);
#pragma unroll
        for (int d = 0; d < 2; ++d) { const float v = o[d][rr] * rli[rr]; ((GAS bf16_t*)Ow)[(size_t)orow * 768 + d * 32 + r32] = (bf16_t)(cvtpk(v, v) & 0xffffu); } }
    __syncthreads();
}

struct MapId { __device__ __forceinline__ int operator()(int n) const { return n; } };
struct MapIn { __device__ __forceinline__ int operator()(int n) const { return n < 3744 ? n : (n < 3840 ? -1 : n - 96); } };
struct MapF1 { __device__ __forceinline__ int operator()(int n) const { const int pt = n >> 8, r = n & 255; return r < 128 ? pt * 128 + r : DFF + pt * 128 + (r - 128); } };
template <class Map>
__device__ __forceinline__ void prep_w(const float* __restrict__ src, int Ks, int Ns, bf16_t* __restrict__ dst, int Nd, int Kd, const float* __restrict__ kscale, Map map, float* tile) {
    const int tid = otid(), tx = tid & 63, ty = tid >> 6, nk = Kd / 64, ntile = (Nd / 64) * nk;
    for (int t = blockIdx.x; t < ntile; t += gridDim.x) {
        const int n0 = (t / nk) * 64, k0 = (t % nk) * 64;
        const int ns = map(n0 + tx);
#pragma unroll
        for (int j = 0; j < 8; ++j) { const int kl = ty + 8 * j, ks = (k0 + kl) % Ks; float v = 0.f;
            if (ns >= 0) { v = ((const GAS float*)src)[(size_t)ks * Ns + ns]; if (kscale) v *= ((const GAS float*)kscale)[ks]; }
            tile[kl * 65 + tx] = v; }
        __syncthreads();
        const int kx = (tid & 31) * 2, ny = tid >> 5;
#pragma unroll
        for (int j = 0; j < 4; ++j) { const int nl = ny + 16 * j;
            *(GAS unsigned*)(dst + (size_t)(n0 + nl) * Kd + k0 + kx) = cvtpk(tile[kx * 65 + nl], tile[(kx + 1) * 65 + nl]); }
        __syncthreads();
    }
}
__device__ __forceinline__ void ln_rows(const float* src, float* dstf, bf16_t* dstb, const float* __restrict__ g, const float* __restrict__ bta, int row0, int nrows) {
    const int tid_ = otid(); const int lane = tid_ & 63, wv = blockIdx.x * 8 + (tid_ >> 6), nw = gridDim.x * 8;
    f32x4 gv[4], bv[4];
#pragma unroll
    for (int i = 0; i < 4; ++i) { gv[i] = *(const GAS f32x4*)(g + i * 256 + lane * 4); bv[i] = *(const GAS f32x4*)(bta + i * 256 + lane * 4); }
    for (int r = wv; r < nrows; r += nw) {
        const size_t ro = (size_t)(row0 + r) * 1024;
        f32x4 v[4]; float s = 0.f;
#pragma unroll
        for (int i = 0; i < 4; ++i) { v[i] = *(const GAS f32x4*)(src + ro + i * 256 + lane * 4); s += (v[i][0] + v[i][1]) + (v[i][2] + v[i][3]); }
#pragma unroll
        for (int k = 1; k < 64; k <<= 1) s += __shfl_xor(s, k);
        const float mu = s * (1.0f / 1024.0f); float q = 0.f;
#pragma unroll
        for (int i = 0; i < 4; ++i) { v[i] = v[i] - mu; q += (v[i][0] * v[i][0] + v[i][1] * v[i][1]) + (v[i][2] * v[i][2] + v[i][3] * v[i][3]); }
#pragma unroll
        for (int k = 1; k < 64; k <<= 1) q += __shfl_xor(q, k);
        const float rstd = rsqrtf(q * (1.0f / 1024.0f) + 1e-5f);
#pragma unroll
        for (int i = 0; i < 4; ++i) { const f32x4 y = v[i] * rstd * gv[i] + bv[i]; *(GAS f32x4*)(dstf + ro + i * 256 + lane * 4) = y;
            if (dstb) st_bf4(dstb + ro + i * 256 + lane * 4, y); }
    }
}

#ifndef PHMASK
#define PHMASK 0xffff
#endif
#define WSP(T_, off) ((T_*)(wsb + (off)))
__device__ __forceinline__ void gsync(cg::grid_group& g) { __threadfence(); g.sync(); __threadfence(); }
__global__ __launch_bounds__(512, 2) void fwd_megakernel(Params p) {
    extern __shared__ __attribute__((aligned(16))) unsigned char shm[];
    cg::grid_group grid = cg::this_grid();
    LAS unsigned char* ldsg = (LAS unsigned char*)shm;
    char* lds = (char*)shm;
    if (PHMASK & 512) {
        unsigned char* wsb = p.ws;
        float* tile = (float*)shm;
        for (int l = 0; l < DEPTH; ++l) {
            prep_w(p.in[3] + (size_t)l * 1024 * 6816, 1024, 6816, WSP(bf16_t, OFF_WIN) + (size_t)l * NIN * 1024, NIN, 1024, nullptr, MapIn(), tile);
            prep_w(p.in[10] + (size_t)l * 384 * 768, 384, 768, WSP(bf16_t, OFF_WQB) + (size_t)l * 768 * 384, 768, 384, p.in[8] + l * 384, MapId(), tile);
            prep_w(p.in[11] + (size_t)l * 256 * 1024, 256, 1024, WSP(bf16_t, OFF_WKVB) + (size_t)l * 1024 * 256, 1024, 256, p.in[9] + l * 256, MapId(), tile);
            for (int i = 0; i < 3; ++i)
                prep_w(p.in[12] + ((size_t)l * 3 + i) * 512 * 1024, 512, 1024, WSP(bf16_t, OFF_WBR) + ((size_t)l * 3 + i) * 1024 * 512, 1024, 512, nullptr, MapId(), tile);
            prep_w(p.in[13] + (size_t)l * 1024 * 1024, 1024, 1024, WSP(bf16_t, OFF_WOUT) + (size_t)l * 1024 * 3072, 1024, 3072, nullptr, MapId(), tile);
            prep_w(p.in[16] + (size_t)l * 1024 * 5632, 1024, 5632, WSP(bf16_t, OFF_WF1) + (size_t)l * 5632 * 1024, 5632, 1024, nullptr, MapF1(), tile);
            prep_w(p.in[17] + (size_t)l * 2816 * 1024, 2816, 1024, WSP(bf16_t, OFF_WF2) + (size_t)l * 1024 * 2816, 1024, 2816, nullptr, MapId(), tile);
        }
        const int gtid = blockIdx.x * 512 + otid(), gn = gridDim.x * 512;
        const float nlt = -13.122363377404328f;
        float* cd = WSP(float, OFF_TD); float* sd = cd + SEQ * 8; float* cm = WSP(float, OFF_TM); float* sm = cm + SEQ * 16;
        for (int i = gtid; i < SEQ * 8; i += gn) { const int pos = i >> 3, f = i & 7; const float inv = expf(nlt * (float)f / 8.0f), ang = (float)pos * inv; ((GAS float*)cd)[i] = cosf(ang); ((GAS float*)sd)[i] = sinf(ang); }
        for (int i = gtid; i < SEQ * 16; i += gn) { const int pos = i >> 4, f = i & 15; const float inv = expf(nlt * (float)f / 16.0f), ang = (float)pos * inv; ((GAS float*)cm)[i] = cosf(ang); ((GAS float*)sm)[i] = sinf(ang); }
        ln_rows(p.in[0], p.out, WSP(bf16_t, OFF_XB), p.in[1], p.in[2], 0, T_ALL);
    }
    gsync(grid);
    for (int step = 0; step < NCHUNK * DEPTH * 9; ++step) {
        const int ck = step / (DEPTH * 9), l = (step % (DEPTH * 9)) / 9, ph = step % 9;
        const size_t tok0 = (size_t)ck * TC;
        unsigned wlo_ = (unsigned)(uintptr_t)p.ws, whi_ = (unsigned)((uintptr_t)p.ws >> 32); asm volatile("" : "+v"(wlo_), "+v"(whi_));
        unsigned char* wsb = (unsigned char*)(((uintptr_t)(unsigned)__builtin_amdgcn_readfirstlane((int)whi_) << 32) | (uintptr_t)(unsigned)__builtin_amdgcn_readfirstlane((int)wlo_));
        switch (ph) {
        case 0: if (PHMASK & 1) {
            float* cd = WSP(float, OFF_TD); float* cm = WSP(float, OFF_TM);
            EpiIn E{WSP(bf16_t, OFF_PA), WSP(bf16_t, OFF_PD), WSP(bf16_t, OFF_MC), WSP(bf16_t, OFF_GT), WSP(float, OFF_SSQ), p.in[4] + (size_t)l * 3072, cd, cd + SEQ * 8, cm, cm + SEQ * 16};
            gemm_phase(ldsg, WSP(bf16_t, OFF_XB) + tok0 * 1024, 1024, WSP(bf16_t, OFF_WIN) + (size_t)l * NIN * 1024, 1024, TC, NIN, 1024, E);
        } break;
        case 1: if (PHMASK & 2) {
            if (PHMASK & 1024) { EpiKV E{WSP(bf16_t, OFF_MKV), WSP(float, OFF_SSQ)}; gemm_phase(ldsg, WSP(bf16_t, OFF_MC) + 384, 768, WSP(bf16_t, OFF_WKVB) + (size_t)l * 1024 * 256, 256, TC, 1024, 256, E); }
            if (PHMASK & 2048) { float* cm = WSP(float, OFF_TM); EpiQ E{WSP(bf16_t, OFF_MQ), WSP(float, OFF_SSQ), cm, cm + SEQ * 16}; gemm_phase(ldsg, WSP(bf16_t, OFF_MC), 768, WSP(bf16_t, OFF_WQB) + (size_t)l * 768 * 384, 384, TC, 768, 384, E); }
            __syncthreads();
            if (PHMASK & 4096) for (int it = blockIdx.x; it < 512; it += gridDim.x) na_item(p, l, it, lds);
        } break;
        case 2: if (PHMASK & 4) {
            if (PHMASK & 8192) for (int it = blockIdx.x; it < 256; it += gridDim.x) diff_item(p, l, it, lds);
            if (PHMASK & 16384) for (int it = blockIdx.x; it < 512; it += gridDim.x) mla_item(p, it, lds);
        } break;
        case 3: if (PHMASK & 8) {
            for (int i = 0; i < 3; ++i) {
                const bf16_t* A = i == 0 ? WSP(bf16_t, OFF_PA) : (i == 1 ? WSP(bf16_t, OFF_PD) : WSP(bf16_t, OFF_MC)); const int lda = i == 2 ? 768 : 1536;
                EpiBr E{WSP(bf16_t, OFF_GT) + i * 1024};
                gemm_phase(ldsg, A, lda, WSP(bf16_t, OFF_WBR) + ((size_t)l * 3 + i) * 1024 * 512, 512, TC, 1024, 512, E);
            }
        } break;
        case 4: case 7: if (PHMASK & 16) {
            EpiRes E{p.out + tok0 * 1024};
            const bf16_t* A = ph == 4 ? WSP(bf16_t, OFF_GT) : WSP(bf16_t, OFF_PA); const int kk = ph == 4 ? 3072 : DFF;
            const bf16_t* B = ph == 4 ? WSP(bf16_t, OFF_WOUT) + (size_t)l * 1024 * 3072 : WSP(bf16_t, OFF_WF2) + (size_t)l * 1024 * DFF;
            gemm_phase(ldsg, A, kk, B, kk, TC, 1024, kk, E);
        } break;
        case 5: case 8: if (PHMASK & 32) {
            const float* g = ph == 5 ? p.in[14] : p.in[18]; const float* bb = ph == 5 ? p.in[15] : p.in[19];
            ln_rows(p.out, p.out, WSP(bf16_t, OFF_XB), g + l * 1024, bb + l * 1024, (int)tok0, TC);
        } break;
        case 6: if (PHMASK & 64) {
            EpiF1 E{WSP(bf16_t, OFF_PA)};
            gemm_phase(ldsg, WSP(bf16_t, OFF_XB) + tok0 * 1024, 1024, WSP(bf16_t, OFF_WF1) + (size_t)l * 5632 * 1024, 1024, TC, 5632, 1024, E);
        } break;
        }
        gsync(grid);
    }
}

extern "C" void kernel_launch(void* const* d_in, const int* in_sizes, int n_in, void* d_out, int out_size, void* d_ws, size_t ws_size, hipStream_t stream) {
    static int grid = 0;
    if (grid == 0) {
        if (n_in != 20 || in_sizes[0] != T_ALL * DM || out_size != T_ALL * DM || ws_size < WS_END) {
            fprintf(stderr, "kernel_launch: unexpected shapes / workspace (n_in %d, ws %zu, need %zu)\n", n_in, ws_size, (size_t)WS_END); grid = -1; return; }
        int dev = 0, cus = 0, per_cu = 0;
        hipGetDevice(&dev); hipDeviceGetAttribute(&cus, hipDeviceAttributeMultiprocessorCount, dev);
        if (hipFuncSetAttribute((const void*)fwd_megakernel, hipFuncAttributeMaxDynamicSharedMemorySize, LDS_BYTES) != hipSuccess) { fprintf(stderr, "kernel_launch: hipFuncSetAttribute failed\n"); grid = -1; return; }
        if (hipOccupancyMaxActiveBlocksPerMultiprocessor(&per_cu, (const void*)fwd_megakernel, 512, LDS_BYTES) != hipSuccess || per_cu < 1) { fprintf(stderr, "kernel_launch: occupancy query gave %d\n", per_cu); per_cu = 1; }
        (void)hipGetLastError();
        grid = cus;
    }
    if (grid < 0) return;
    Params p{};
    for (int i = 0; i < 20; ++i) p.in[i] = (const float*)d_in[i];
    p.out = (float*)d_out; p.ws = (unsigned char*)d_ws;
    for (int l = 0; l < 4; ++l) p.lam_init[l] = (float)(0.8 - 0.6 * exp(-0.3 * (double)l));
    void* args[] = {&p};
    hipError_t e = hipLaunchCooperativeKernel((const void*)fwd_megakernel, dim3(grid), dim3(512), args, LDS_BYTES, stream);
    if (e != hipSuccess) fprintf(stderr, "kernel_launch: cooperative launch failed: %s (grid %d)\n", hipGetErrorString(e), grid);
}
```

```cpp
#include <hip/hip_runtime.h>
#include <hip/hip_cooperative_groups.h>
#include <cstdio>
#include <cstdint>
namespace cg = cooperative_groups;

#define LAS __attribute__((address_space(3)))
#define GAS __attribute__((address_space(1)))
typedef unsigned short bf16_t;
typedef short bf16x8 __attribute__((ext_vector_type(8)));
typedef short s16x4 __attribute__((ext_vector_type(4)));
typedef float f32x4 __attribute__((ext_vector_type(4)));
typedef float f32x16 __attribute__((ext_vector_type(16)));
typedef unsigned u32x4 __attribute__((ext_vector_type(4)));
typedef unsigned u32x2 __attribute__((ext_vector_type(2)));

constexpr int T_ALL = 32768, TC = 16384, DM = 1024, SEQ = 4096, NIN = 6912, DFF = 2816, DEPTH = 4, NCHUNK = 2;
constexpr size_t SZ_WIN = (size_t)DEPTH * NIN * 1024 * 2, SZ_WQB = (size_t)DEPTH * 768 * 384 * 2, SZ_WKVB = (size_t)DEPTH * 1024 * 256 * 2,
                 SZ_WBR = (size_t)DEPTH * 3 * 1024 * 512 * 2, SZ_WOUT = (size_t)DEPTH * 1024 * 3072 * 2, SZ_WF1 = (size_t)DEPTH * 5632 * 1024 * 2,
                 SZ_WF2 = (size_t)DEPTH * 1024 * 2816 * 2, SZ_XB = (size_t)T_ALL * 1024 * 2, SZ_PA = (size_t)TC * 1536 * 2, SZ_PD = SZ_PA,
                 SZ_MC = (size_t)TC * 768 * 2, SZ_GT = (size_t)TC * 3072 * 2, SZ_MQ = (size_t)TC * 768 * 2, SZ_MKV = (size_t)TC * 1024 * 2,
                 SZ_SSQ = (size_t)TC * 24 * 4, SZ_TD = (size_t)SEQ * 8 * 4 * 2, SZ_TM = (size_t)SEQ * 16 * 4 * 2;
constexpr size_t OFF_WIN = 0, OFF_WQB = OFF_WIN + SZ_WIN, OFF_WKVB = OFF_WQB + SZ_WQB, OFF_WBR = OFF_WKVB + SZ_WKVB, OFF_WOUT = OFF_WBR + SZ_WBR,
                 OFF_WF1 = OFF_WOUT + SZ_WOUT, OFF_WF2 = OFF_WF1 + SZ_WF1, OFF_XB = OFF_WF2 + SZ_WF2, OFF_PA = OFF_XB + SZ_XB, OFF_PD = OFF_PA + SZ_PA,
                 OFF_MC = OFF_PD + SZ_PD, OFF_GT = OFF_MC + SZ_MC, OFF_MQ = OFF_GT + SZ_GT, OFF_MKV = OFF_MQ + SZ_MQ, OFF_SSQ = OFF_MKV + SZ_MKV,
                 OFF_TD = OFF_SSQ + SZ_SSQ, OFF_TM = OFF_TD + SZ_TD, WS_END = OFF_TM + SZ_TM;
constexpr int LDS_BYTES = 132 * 1024;
constexpr float DN_ALPHA = 1.681792830507429f;

struct Params { const float* in[20]; float* out; unsigned char* ws; float lam_init[4]; };

typedef __bf16 bf2_t __attribute__((ext_vector_type(2)));
typedef float f32x2 __attribute__((ext_vector_type(2)));
__device__ __forceinline__ unsigned cvtpk(float lo, float hi) { f32x2 v = {lo, hi}; bf2_t b = __builtin_convertvector(v, bf2_t); return __builtin_bit_cast(unsigned, b); }
__device__ __forceinline__ int otid() { int t = threadIdx.x; asm volatile("" : "+v"(t)); return t; }
__device__ __forceinline__ float bf2f(unsigned short b) { return __uint_as_float(((unsigned)b) << 16); }
__device__ __forceinline__ void st_bf4(bf16_t* p, f32x4 v) { u32x2 w; w.x = cvtpk(v[0], v[1]); w.y = cvtpk(v[2], v[3]); *(GAS u32x2*)p = w; }

constexpr int BM = 256, BK = 64, HALF = 128, HTB = HALF * BK * 2, NXCD = 8, WGM = 8;
__device__ __forceinline__ int lds_byte(int r, int c) { const int st = (r >> 4) * 2 + (c >> 5), rr = r & 15, cc = c & 31, ob = rr * 64 + cc * 2; return st * 1024 + (ob ^ (((ob >> 9) & 1) << 5)); }
__device__ __forceinline__ void stage_rc(int b, int& R, int& C) { const int st = b / 1024, sb = b % 1024, swz = sb ^ (((sb >> 9) & 1) << 5); R = (st >> 1) * 16 + swz / 64; C = (st & 1) * 32 + (swz % 64) / 2; }
struct Unit { int pm, pn; };
struct StaticOrder {
    int nM, nN, nwg, G, c;
    __device__ void init(int M, int N, int G_, int c_) { nM = M / BM; nN = N / BM; nwg = nM * nN; G = G_; c = c_; }
    __device__ bool next(int i, Unit& u) const {
        const long L = (long)i * G + c; if (L >= nwg) return false;
        int wgid = (int)L; { const int q = nwg / NXCD, r = nwg % NXCD, xcd = wgid % NXCD, off = wgid / NXCD; wgid = (xcd < r ? xcd * (q + 1) : r * (q + 1) + (xcd - r) * q) + off; }
        const int nig = WGM * nN, gid = wgid / nig, fm = gid * WGM, gsz = (nM - fm) < WGM ? (nM - fm) : WGM;
        u.pm = __builtin_amdgcn_readfirstlane(fm + ((wgid % nig) % gsz)); u.pn = __builtin_amdgcn_readfirstlane((wgid % nig) / gsz); return true;
    }
};

template <class Epi>
__device__ __forceinline__ void gemm_phase(LAS unsigned char* lds, const bf16_t* A, int lda, const bf16_t* Bt, int ldb, int M, int N, int K, const Epi& E) {
    const int tid = otid(), wid = __builtin_amdgcn_readfirstlane(tid >> 6), lane = tid & 63, wr = wid >> 2, wc = wid & 3, fr = lane & 15, fq = lane >> 4;
    int ntv_ = K / BK; asm volatile("" : "+v"(ntv_)); const int nt = __builtin_amdgcn_readfirstlane(ntv_);
    StaticOrder S; S.init(M, N, (int)gridDim.x, (int)blockIdx.x);
    unsigned voffA[2], voffB[2];
#pragma unroll
    for (int i = 0; i < 2; ++i) { int R, C; stage_rc(tid * 16 + i * 8192, R, C); voffA[i] = (unsigned)(R * lda + C) * 2u; voffB[i] = (unsigned)(R * ldb + C) * 2u; }
    const size_t kstep = (size_t)(BK * 2);
    const size_t hstepA = (size_t)HALF * lda * 2, tstepA = 2 * hstepA, hstepB = (size_t)HALF * ldb * 2, tstepB = 2 * hstepB;
    const unsigned ldsw = (unsigned)wid * 1024u;
    const int aoff = lds_byte(wr * 64 + fr, fq * 8), boff = lds_byte(wc * 32 + fr, fq * 8);
#define PG8_SA(b, h) (((b) * 2 + (h)) * HTB)
#define PG8_SB(b, h) ((4 + (b) * 2 + (h)) * HTB)
#define PG8_STAGE(bufoff, gbase, voff) do { _Pragma("unroll") for (int _i = 0; _i < 2; ++_i) \
        __builtin_amdgcn_global_load_lds((const unsigned*)((const char*)(gbase) + (voff)[_i]), (LAS unsigned*)(lds + (bufoff) + ldsw + _i * 8192), 16, 0, 0); } while (0)
#define PG8_LDA(dst, b, h) do { _Pragma("unroll") for (int m = 0; m < 4; ++m) _Pragma("unroll") for (int k = 0; k < 2; ++k) dst[m][k] = *(const LAS bf16x8*)(lds + PG8_SA(b, h) + aoff + m * 2048 + k * 1024); } while (0)
#define PG8_LDB(dst, b, h) do { _Pragma("unroll") for (int n = 0; n < 2; ++n) _Pragma("unroll") for (int k = 0; k < 2; ++k) dst[n][k] = *(const LAS bf16x8*)(lds + PG8_SB(b, h) + boff + n * 2048 + k * 1024); } while (0)
#define PG8_MMA(ai, bj, At, Bt_) do { __builtin_amdgcn_s_setprio(1); _Pragma("unroll") for (int m = 0; m < 4; ++m) _Pragma("unroll") for (int n = 0; n < 2; ++n) _Pragma("unroll") for (int k = 0; k < 2; ++k) \
        acc[ai][bj][m][n] = __builtin_amdgcn_mfma_f32_16x16x32_bf16(Bt_[n][k], At[m][k], acc[ai][bj][m][n], 0, 0, 0); __builtin_amdgcn_s_setprio(0); } while (0)
#define PG8_WAIT_V(n) asm volatile("s_waitcnt vmcnt(" #n ")" ::: "memory")
#define PG8_WAIT_L(n) asm volatile("s_waitcnt lgkmcnt(" #n ")" ::: "memory")
#define PG8_BAR __builtin_amdgcn_s_barrier()
#define PG8_SCHED __builtin_amdgcn_sched_barrier(0)
    Unit cur, nxt; int ui = 0;
    if (!S.next(0, cur)) return;
    f32x4 acc[2][2][4][2];
#pragma unroll
    for (int a = 0; a < 2; ++a)
#pragma unroll
        for (int b = 0; b < 2; ++b)
#pragma unroll
            for (int m = 0; m < 4; ++m)
#pragma unroll
                for (int n = 0; n < 2; ++n) acc[a][b][m][n] = (f32x4){0.f, 0.f, 0.f, 0.f};
    bf16x8 At[4][2], B0[2][2], B1[2][2];
    const char* cA = (const char*)A + (size_t)cur.pm * tstepA; const char* cB = (const char*)Bt + (size_t)cur.pn * tstepB;
    PG8_STAGE(PG8_SB(0, 0), cB, voffB); PG8_STAGE(PG8_SA(0, 0), cA, voffA); PG8_STAGE(PG8_SB(0, 1), cB + hstepB, voffB); PG8_STAGE(PG8_SA(0, 1), cA + hstepA, voffA);
    if (wr == 1) PG8_BAR;
    PG8_WAIT_V(4); PG8_BAR;
    PG8_STAGE(PG8_SB(1, 0), cB + kstep, voffB); PG8_STAGE(PG8_SA(1, 0), cA + kstep, voffA); PG8_STAGE(PG8_SB(1, 1), cB + hstepB + kstep, voffB);
    PG8_WAIT_V(6); PG8_BAR;
    for (;;) {
        const bool has_next = S.next(ui + 1, nxt);
        const char* nA = has_next ? (const char*)A + (size_t)nxt.pm * tstepA : cA; const char* nB = has_next ? (const char*)Bt + (size_t)nxt.pn * tstepB : cB;
#pragma unroll 1
        for (int t = 0; t < nt; t += 2) {
            const bool last = (t == nt - 2);
            const char* a1 = cA + (size_t)(t + 1) * kstep;
            const char* a2 = last ? nA : cA + (size_t)(t + 2) * kstep; const char* b2 = last ? nB : cB + (size_t)(t + 2) * kstep;
            const char* a3 = a2 + kstep; const char* b3 = b2 + kstep;
            PG8_LDB(B0, 0, 0); PG8_SCHED; PG8_LDA(At, 0, 0); PG8_STAGE(PG8_SA(1, 1), a1 + hstepA, voffA);
            PG8_WAIT_L(8); PG8_BAR; PG8_WAIT_L(0); PG8_MMA(0, 0, At, B0); PG8_BAR; PG8_SCHED;
            PG8_LDB(B1, 0, 1); PG8_STAGE(PG8_SB(0, 0), b2, voffB);
            PG8_BAR; PG8_WAIT_L(0); PG8_MMA(0, 1, At, B1); PG8_BAR;
            PG8_LDA(At, 0, 1); PG8_STAGE(PG8_SA(0, 0), a2, voffA);
            PG8_BAR; PG8_WAIT_L(0); PG8_MMA(1, 0, At, B0); PG8_BAR; PG8_SCHED;
            PG8_STAGE(PG8_SB(0, 1), b2 + hstepB, voffB);
            PG8_WAIT_V(6); PG8_BAR; PG8_MMA(1, 1, At, B1); PG8_BAR;
            PG8_LDB(B0, 1, 0); PG8_SCHED; PG8_LDA(At, 1, 0); PG8_STAGE(PG8_SA(0, 1), a2 + hstepA, voffA);
            PG8_WAIT_L(8); PG8_BAR; PG8_WAIT_L(0); PG8_MMA(0, 0, At, B0); PG8_BAR; PG8_SCHED;
            PG8_LDB(B1, 1, 1); PG8_STAGE(PG8_SB(1, 0), b3, voffB);
            PG8_BAR; PG8_WAIT_L(0); PG8_MMA(0, 1, At, B1); PG8_BAR;
            PG8_LDA(At, 1, 1); PG8_STAGE(PG8_SA(1, 0), a3, voffA);
            PG8_BAR; PG8_WAIT_L(0); PG8_MMA(1, 0, At, B0); PG8_BAR; PG8_SCHED;
            PG8_STAGE(PG8_SB(1, 1), b3 + hstepB, voffB);
            PG8_WAIT_V(6); PG8_BAR; PG8_MMA(1, 1, At, B1); PG8_BAR;
        }
        E(acc, cur, wr, wc, fr, fq);
        if (!has_next) break;
#pragma unroll
        for (int a = 0; a < 2; ++a)
#pragma unroll
            for (int b = 0; b < 2; ++b)
#pragma unroll
                for (int m = 0; m < 4; ++m)
#pragma unroll
                    for (int n = 0; n < 2; ++n) acc[a][b][m][n] = (f32x4){0.f, 0.f, 0.f, 0.f};
        cur = nxt; cA = nA; cB = nB; ++ui;
    }
    PG8_WAIT_V(0);
    if (wr == 0) PG8_BAR;
    PG8_BAR;
#undef PG8_SA
#undef PG8_SB
#undef PG8_STAGE
#undef PG8_LDA
#undef PG8_LDB
#undef PG8_MMA
#undef PG8_WAIT_V
#undef PG8_WAIT_L
#undef PG8_BAR
#undef PG8_SCHED
}

struct EpiIn {
    bf16_t *pa, *pd, *mc, *gt; float* ssq; const float* bg; const float *cd, *sd, *cm, *sm;
    __device__ __forceinline__ void operator()(const f32x4 (&acc)[2][2][4][2], const Unit& u, int wr, int wc, int fr, int fq) const {
        int row0 = u.pm * BM + wr * 64 + fr; asm volatile("" : "+v"(row0) :: "memory"); const int pn = u.pn, cw = wc * 32 + 4 * fq;
        if (pn < 6) {
#pragma unroll
            for (int ai = 0; ai < 2; ++ai)
#pragma unroll
                for (int m = 0; m < 4; ++m) { __builtin_amdgcn_sched_barrier(0); bf16_t* rp = pa + (size_t)(row0 + ai * HALF + m * 16) * 1536 + pn * 256 + cw;
#pragma unroll
                    for (int bj = 0; bj < 2; ++bj)
#pragma unroll
                        for (int n = 0; n < 2; ++n) st_bf4(rp + bj * HALF + n * 16, acc[ai][bj][m][n]); }
        } else if (pn < 12) {
            const bool rope = (pn < 10) && !(wc & 1);
#pragma unroll
            for (int ai = 0; ai < 2; ++ai)
#pragma unroll
                for (int m = 0; m < 4; ++m) { __builtin_amdgcn_sched_barrier(0); const int row = row0 + ai * HALF + m * 16; bf16_t* rp = pd + (size_t)row * 1536 + (pn - 6) * 256 + cw;
                    f32x4 c4 = {1.f, 1.f, 1.f, 1.f}, s4 = {0.f, 0.f, 0.f, 0.f};
                    if (rope) { const int pos = row & (SEQ - 1); c4 = *(const GAS f32x4*)(cd + pos * 8 + (fq & 1) * 4); s4 = *(const GAS f32x4*)(sd + pos * 8 + (fq & 1) * 4); }
#pragma unroll
                    for (int bj = 0; bj < 2; ++bj) { f32x4 v0 = acc[ai][bj][m][0];
                        if (rope) { f32x4 pr;
#pragma unroll
                            for (int j = 0; j < 4; ++j) pr[j] = __shfl_xor(v0[j], 32);
                            v0 = (fq < 2) ? (v0 * c4 - pr * s4) : (v0 * c4 + pr * s4); }
                        st_bf4(rp + bj * HALF, v0); st_bf4(rp + bj * HALF + 16, acc[ai][bj][m][1]); } }
        } else if (pn < 15) {
            const int t = pn - 12;
#pragma unroll
            for (int ai = 0; ai < 2; ++ai)
#pragma unroll
                for (int m = 0; m < 4; ++m) { __builtin_amdgcn_sched_barrier(0); const int row = row0 + ai * HALF + m * 16; bf16_t* rp = mc + (size_t)row * 768 + t * 256 + cw;
#pragma unroll
                    for (int bj = 0; bj < 2; ++bj) { f32x4 v0 = acc[ai][bj][m][0], v1 = acc[ai][bj][m][1];
                        float s = (v0[0] * v0[0] + v0[1] * v0[1]) + (v0[2] * v0[2] + v0[3] * v0[3]) + (v1[0] * v1[0] + v1[1] * v1[1]) + (v1[2] * v1[2] + v1[3] * v1[3]);
                        s += __shfl_xor(s, 16); s += __shfl_xor(s, 32);
                        if (fq == 0) *(GAS float*)(ssq + (size_t)row * 24 + t * 8 + bj * 4 + wc) = s;
                        if (t == 2 && bj == 1 && wc == 0) { const int pos = row & (SEQ - 1); const f32x4 c4 = *(const GAS f32x4*)(cm + pos * 16 + fq * 4), s4 = *(const GAS f32x4*)(sm + pos * 16 + fq * 4);
                            const f32x4 n0 = v0 * c4 - v1 * s4, n1 = v1 * c4 + v0 * s4; v0 = n0; v1 = n1; }
                        st_bf4(rp + bj * HALF, v0); st_bf4(rp + bj * HALF + 16, v1); } }
        } else {
            const int t = pn - 15;
            f32x4 bv[2][2];
#pragma unroll
            for (int bj = 0; bj < 2; ++bj)
#pragma unroll
                for (int n = 0; n < 2; ++n) bv[bj][n] = *(const GAS f32x4*)(bg + t * 256 + bj * HALF + n * 16 + cw);
#pragma unroll
            for (int ai = 0; ai < 2; ++ai)
#pragma unroll
                for (int m = 0; m < 4; ++m) { __builtin_amdgcn_sched_barrier(0); bf16_t* rp = gt + (size_t)(row0 + ai * HALF + m * 16) * 3072 + t * 256 + cw;
#pragma unroll
                    for (int bj = 0; bj < 2; ++bj)
#pragma unroll
                        for (int n = 0; n < 2; ++n) { f32x4 v = acc[ai][bj][m][n] + bv[bj][n];
#pragma unroll
                            for (int j = 0; j < 4; ++j) v[j] = __builtin_amdgcn_rcpf(1.0f + __expf(-v[j]));
                            st_bf4(rp + bj * HALF + n * 16, v); } }
        }
    }
};
struct EpiQ {
    bf16_t* mq; const float* ssq; const float *cm, *sm;
    __device__ __forceinline__ void operator()(const f32x4 (&acc)[2][2][4][2], const Unit& u, int wr, int wc, int fr, int fq) const {
        int row0 = u.pm * BM + wr * 64 + fr; asm volatile("" : "+v"(row0) :: "memory"); const int cw = wc * 32 + 4 * fq;
        float rr8[8];
#pragma unroll
        for (int i = 0; i < 8; ++i) { const float* sp = ssq + (size_t)(row0 + (i >> 2) * HALF + (i & 3) * 16) * 24 + fq * 4;
            const f32x4 a = *(const GAS f32x4*)sp;
            float ss = fq < 3 ? ((a[0] + a[1]) + (a[2] + a[3])) : 0.f;
            ss += __shfl_xor(ss, 16); ss += __shfl_xor(ss, 32);
            rr8[i] = rsqrtf(ss * (1.0f / 384.0f) + 1e-6f); }
#pragma unroll
        for (int ai = 0; ai < 2; ++ai)
#pragma unroll
            for (int m = 0; m < 4; ++m) { __builtin_amdgcn_sched_barrier(0); const int row = row0 + ai * HALF + m * 16; const float r = rr8[ai * 4 + m];
                bf16_t* rp = mq + (size_t)row * 768 + u.pn * 256 + cw;
#pragma unroll
                for (int bj = 0; bj < 2; ++bj) { const int G = u.pn * 8 + bj * 4 + wc; f32x4 v0 = acc[ai][bj][m][0] * r, v1 = acc[ai][bj][m][1] * r;
                    if (G % 3 == 2) { const int pos = row & (SEQ - 1); const f32x4 c4 = *(const GAS f32x4*)(cm + pos * 16 + fq * 4), s4 = *(const GAS f32x4*)(sm + pos * 16 + fq * 4);
                        const f32x4 n0 = v0 * c4 - v1 * s4, n1 = v1 * c4 + v0 * s4; v0 = n0; v1 = n1; }
                    st_bf4(rp + bj * HALF, v0); st_bf4(rp + bj * HALF + 16, v1); } }
    }
};
struct EpiKV {
    bf16_t* mkv; const float* ssq;
    __device__ __forceinline__ void operator()(const f32x4 (&acc)[2][2][4][2], const Unit& u, int wr, int wc, int fr, int fq) const {
        int row0 = u.pm * BM + wr * 64 + fr; asm volatile("" : "+v"(row0) :: "memory"); const int cw = wc * 32 + 4 * fq;
        float rr8[8];
#pragma unroll
        for (int i = 0; i < 8; ++i) { const float* sp = ssq + (size_t)(row0 + (i >> 2) * HALF + (i & 3) * 16) * 24 + 12 + (fq & 1) * 4;
            const f32x4 a = *(const GAS f32x4*)sp;
            float ss = fq < 2 ? ((a[0] + a[1]) + (a[2] + a[3])) : 0.f;
            ss += __shfl_xor(ss, 16); ss += __shfl_xor(ss, 32);
            rr8[i] = rsqrtf(ss * (1.0f / 256.0f) + 1e-6f); }
#pragma unroll
        for (int ai = 0; ai < 2; ++ai)
#pragma unroll
            for (int m = 0; m < 4; ++m) { __builtin_amdgcn_sched_barrier(0); const int row = row0 + ai * HALF + m * 16; const float r = rr8[ai * 4 + m];
                bf16_t* rp = mkv + (size_t)row * 1024 + u.pn * 256 + cw;
#pragma unroll
                for (int bj = 0; bj < 2; ++bj)
#pragma unroll
                    for (int n = 0; n < 2; ++n) st_bf4(rp + bj * HALF + n * 16, acc[ai][bj][m][n] * r); }
    }
};
struct EpiBr {
    bf16_t* gt;
    __device__ __forceinline__ void operator()(const f32x4 (&acc)[2][2][4][2], const Unit& u, int wr, int wc, int fr, int fq) const {
        int row0 = u.pm * BM + wr * 64 + fr; asm volatile("" : "+v"(row0) :: "memory"); const int cw = wc * 32 + 4 * fq;
#pragma unroll
        for (int ai = 0; ai < 2; ++ai)
#pragma unroll
            for (int m = 0; m < 4; ++m) { __builtin_amdgcn_sched_barrier(0); bf16_t* rp = gt + (size_t)(row0 + ai * HALF + m * 16) * 3072 + u.pn * 256 + cw;
#pragma unroll
                for (int bj = 0; bj < 2; ++bj)
#pragma unroll
                    for (int n = 0; n < 2; ++n) { bf16_t* p = rp + bj * HALF + n * 16; const u32x2 g = *(const GAS u32x2*)p; const f32x4 a = acc[ai][bj][m][n];
                        f32x4 v; v[0] = a[0] * __uint_as_float(g.x << 16); v[1] = a[1] * __uint_as_float(g.x & 0xffff0000u); v[2] = a[2] * __uint_as_float(g.y << 16); v[3] = a[3] * __uint_as_float(g.y & 0xffff0000u);
                        st_bf4(p, v); } }
    }
};
struct EpiRes {
    float* x;
    __device__ __forceinline__ void operator()(const f32x4 (&acc)[2][2][4][2], const Unit& u, int wr, int wc, int fr, int fq) const {
        int row0 = u.pm * BM + wr * 64 + fr; asm volatile("" : "+v"(row0) :: "memory"); const int cw = wc * 32 + 4 * fq;
#pragma unroll
        for (int ai = 0; ai < 2; ++ai)
#pragma unroll
            for (int m = 0; m < 4; ++m) { __builtin_amdgcn_sched_barrier(0); float* rp = x + (size_t)(row0 + ai * HALF + m * 16) * 1024 + u.pn * 256 + cw;
#pragma unroll
                for (int bj = 0; bj < 2; ++bj)
#pragma unroll
                    for (int n = 0; n < 2; ++n) { float* p = rp + bj * HALF + n * 16; const f32x4 xv = *(const GAS f32x4*)p; *(GAS f32x4*)p = xv * DN_ALPHA + acc[ai][bj][m][n]; } }
    }
};
struct EpiF1 {
    bf16_t* hd;
    __device__ __forceinline__ void operator()(const f32x4 (&acc)[2][2][4][2], const Unit& u, int wr, int wc, int fr, int fq) const {
        int row0 = u.pm * BM + wr * 64 + fr; asm volatile("" : "+v"(row0) :: "memory"); const int cw = wc * 32 + 4 * fq;
#pragma unroll
        for (int ai = 0; ai < 2; ++ai)
#pragma unroll
            for (int m = 0; m < 4; ++m) { __builtin_amdgcn_sched_barrier(0); bf16_t* rp = hd + (size_t)(row0 + ai * HALF + m * 16) * DFF + u.pn * 128 + cw;
#pragma unroll
                for (int n = 0; n < 2; ++n) { const f32x4 g = acc[ai][0][m][n], uu = acc[ai][1][m][n]; f32x4 v;
#pragma unroll
                    for (int j = 0; j < 4; ++j) v[j] = g[j] * __builtin_amdgcn_rcpf(1.0f + __expf(-g[j])) * uu[j];
                    st_bf4(rp + n * 16, v); } }
    }
};

constexpr int SHM_V = 64 * 128 * 2, SHM_K = 64 * 128 * 2;
#define KSWZ(row, colB) ((row) * 256 + ((colB) ^ (((row) & 7) << 4)))
#define SBAR() __builtin_amdgcn_sched_barrier(0)
__device__ __forceinline__ int crow(int r, int hi) { return (r & 3) + 8 * (r >> 2) + 4 * hi; }
struct NaCtx { int vlo, vhi, wstart, qc, drow0; const LAS float* tab; };

template <int MODE>
__device__ __forceinline__ void partialSM(f32x16& p0, f32x16& p1, float& m_reg, float& mn, float& alpha, const NaCtx& na, int t, int hi) {
    constexpr float SCALE = MODE == 2 ? 0.10206207261596575f : 0.125f;
    constexpr float C = SCALE * 1.4426950408889634f;
    constexpr float THRS = 8.f / SCALE;
    if (MODE == 0) {
        const float NINF = -__builtin_inff();
        if (t < na.vlo || t >= na.vhi) {
#pragma unroll
            for (int r = 0; r < 16; ++r) { p0[r] = NINF; p1[r] = NINF; }
        } else {
            const LAS float* trow = na.tab + (na.drow0 + t) * 31 + (15 - na.qc);
#pragma unroll
            for (int q4 = 0; q4 < 4; ++q4) {
#pragma unroll
                for (int r = q4 * 4; r < q4 * 4 + 4; ++r) { const int kc = crow(r, hi); const bool ok0 = (unsigned)(kc - na.wstart) < 16u, ok1 = (unsigned)(kc + 32 - na.wstart) < 16u;
                    const float b0 = trow[ok0 ? kc : na.wstart], b1 = trow[ok1 ? kc + 32 : na.wstart];
                    p0[r] = ok0 ? p0[r] + b0 : NINF; p1[r] = ok1 ? p1[r] + b1 : NINF; }
                __builtin_amdgcn_sched_barrier(0); }
        }
    }
    float pmax = p0[0];
#pragma unroll
    for (int r = 1; r < 16; ++r) pmax = fmaxf(pmax, p0[r]);
#pragma unroll
    for (int r = 0; r < 16; ++r) pmax = fmaxf(pmax, p1[r]);
    { auto rr = __builtin_amdgcn_permlane32_swap(__float_as_uint(pmax), __float_as_uint(pmax), false, false);
      pmax = fmaxf(__uint_as_float(rr[0]), __uint_as_float(rr[1])); }
    if (__builtin_expect(__all(pmax - m_reg <= THRS), 1)) { mn = m_reg; alpha = 1.f; }
    else { mn = fmaxf(m_reg, pmax); alpha = __builtin_amdgcn_exp2f((m_reg - mn) * C); m_reg = mn; }
    const float mnC = -mn * C;
#pragma unroll
    for (int r = 0; r < 16; ++r) p0[r] = fmaf(p0[r], C, mnC);
#pragma unroll
    for (int r = 0; r < 16; ++r) p1[r] = fmaf(p1[r], C, mnC);
#pragma unroll
    for (int r = 0; r < 16; ++r) p0[r] = __builtin_amdgcn_exp2f(p0[r]);
}
__device__ __forceinline__ void finishSM(f32x16& p0, f32x16& p1, float alpha, float& l_reg, bf16x8& pa0, bf16x8& pa1, bf16x8& pa2, bf16x8& pa3) {
#pragma unroll
    for (int r = 0; r < 16; ++r) p1[r] = __builtin_amdgcn_exp2f(p1[r]);
    float ps = 0;
#pragma unroll
    for (int r = 0; r < 16; ++r) ps += p0[r];
#pragma unroll
    for (int r = 0; r < 16; ++r) ps += p1[r];
    { auto rr = __builtin_amdgcn_permlane32_swap(__float_as_uint(ps), __float_as_uint(ps), false, false);
      ps = __uint_as_float(rr[0]) + __uint_as_float(rr[1]); }
    l_reg = l_reg * alpha + ps;
#define PK4(P, BASE, OUT) do { unsigned a0 = cvtpk(P[BASE + 0], P[BASE + 1]), a1 = cvtpk(P[BASE + 2], P[BASE + 3]);   \
    unsigned b0 = cvtpk(P[BASE + 4], P[BASE + 5]), b1 = cvtpk(P[BASE + 6], P[BASE + 7]);                              \
    auto r0 = __builtin_amdgcn_permlane32_swap(a0, b0, false, false); auto r1 = __builtin_amdgcn_permlane32_swap(a1, b1, false, false); \
    u32x4 w = {r0[0], r1[0], r0[1], r1[1]}; OUT = *reinterpret_cast<bf16x8*>(&w); } while (0)
    PK4(p0, 0, pa0); PK4(p0, 8, pa1); PK4(p1, 0, pa2); PK4(p1, 8, pa3);
#undef PK4
}
template <int ND>
__device__ __forceinline__ void qkt(f32x16& p0, f32x16& p1, const char* Ks, const bf16x8* qr, int r32, int hi) {
    p0 = f32x16{}; p1 = f32x16{};
#pragma unroll
    for (int d0 = 0; d0 < ND; ++d0) { const int cb = (d0 * 16 + hi * 8) * 2;
        const bf16x8 b0 = *reinterpret_cast<const bf16x8*>(Ks + KSWZ(r32, cb));
        const bf16x8 b1 = *reinterpret_cast<const bf16x8*>(Ks + KSWZ(32 + r32, cb));
        p0 = __builtin_amdgcn_mfma_f32_32x32x16_bf16(b0, qr[d0], p0, 0, 0, 0);
        p1 = __builtin_amdgcn_mfma_f32_32x32x16_bf16(b1, qr[d0], p1, 0, 0, 0); }
}
__device__ __forceinline__ int v_st(int k, int c) { const int kk = (k & ~0xC) | ((k & 4) << 1) | ((k & 8) >> 1); return ((kk >> 3) * 4 + (c >> 5)) * 512 + ((kk & 7) * 32 + (c & 31)) * 2; }
__device__ __forceinline__ int v_rd_base(int lane) { return ((lane & 3) << 3) | (((lane >> 2) & 3) << 6) | (((lane >> 4) & 1) << 5) | (((lane >> 5) & 1) << 8); }
constexpr int v_rd_off(int d0, int ks, int half) { return d0 * 512 + ks * 4096 + half * 2048; }
template <int OFF> __device__ __forceinline__ s16x4 tr_read(int vb) {
    s16x4 r; asm volatile("ds_read_b64_tr_b16 %0, %1 offset:%2" : "=&v"(r) : "v"(vb), "i"(OFF) : "memory"); return r;
}
template <int D0> __device__ __forceinline__ void pv_one(f32x16& od, int vb, bf16x8 pa0, bf16x8 pa1, bf16x8 pa2, bf16x8 pa3) {
    const s16x4 l0 = tr_read<v_rd_off(D0, 0, 0)>(vb), h0 = tr_read<v_rd_off(D0, 0, 1)>(vb), l1 = tr_read<v_rd_off(D0, 1, 0)>(vb), h1 = tr_read<v_rd_off(D0, 1, 1)>(vb);
    const s16x4 l2 = tr_read<v_rd_off(D0, 2, 0)>(vb), h2 = tr_read<v_rd_off(D0, 2, 1)>(vb), l3 = tr_read<v_rd_off(D0, 3, 0)>(vb), h3 = tr_read<v_rd_off(D0, 3, 1)>(vb);
    asm volatile("s_waitcnt lgkmcnt(0)" ::: "memory"); SBAR();
#define PKV(L, H) (bf16x8){L[0], L[1], L[2], L[3], H[0], H[1], H[2], H[3]}
    od = __builtin_amdgcn_mfma_f32_32x32x16_bf16(pa0, PKV(l0, h0), od, 0, 0, 0);
    od = __builtin_amdgcn_mfma_f32_32x32x16_bf16(pa1, PKV(l1, h1), od, 0, 0, 0);
    od = __builtin_amdgcn_mfma_f32_32x32x16_bf16(pa2, PKV(l2, h2), od, 0, 0, 0);
    od = __builtin_amdgcn_mfma_f32_32x32x16_bf16(pa3, PKV(l3, h3), od, 0, 0, 0);
#undef PKV
}
template <int NO> __device__ __forceinline__ void pv_d0(f32x16* o, int vb, bf16x8 pa0, bf16x8 pa1, bf16x8 pa2, bf16x8 pa3) {
    pv_one<0>(o[0], vb, pa0, pa1, pa2, pa3); pv_one<1>(o[1], vb, pa0, pa1, pa2, pa3);
    if constexpr (NO == 4) { pv_one<2>(o[2], vb, pa0, pa1, pa2, pa3); pv_one<3>(o[3], vb, pa0, pa1, pa2, pa3); }
}

template <int DQ, int DV, int MODE, int ldq, int ldk, int ldk2, int ldv, int SD>
__device__ __forceinline__ void attn_core(const bf16_t* __restrict__ Qb, const bf16_t* __restrict__ K1, const bf16_t* __restrict__ K2,
                                          const bf16_t* __restrict__ Vh, int NT, char* lds, f32x16 (&o)[DV / 32], float (&rli)[16], const NaCtx& na) {
    constexpr int ND = DQ / 16, NO = DV / 32;
    const int tid = otid(), wid = tid >> 6, lane = tid & 63, r32 = lane & 31, hi = lane >> 5;
    char* V_lds = lds; char* K_lds = lds + 2 * SHM_V;
    float* ws = (float*)(lds + 2 * SHM_V + 2 * SHM_K) + wid * 64; float* li_l = ws; float* al_l = ws + 32;
    float m_reg = -1e30f, l_reg = 0;
#pragma unroll
    for (int d = 0; d < NO; ++d) o[d] = f32x16{};
    bf16x8 qr[ND];
    const bf16_t* Qw = Qb + (long)(wid * 32 + r32) * ldq + hi * 8;
#pragma unroll
    for (int d0 = 0; d0 < ND; ++d0) qr[d0] = *(const GAS bf16x8*)(Qw + d0 * 16);
    const int sr = tid >> 4, sc = (tid & 15) * 8, vst0 = v_st(sr, sc), vst1 = v_st(32 + sr, sc);
    const int vb0 = (int)(uintptr_t)V_lds + v_rd_base(lane);
    const bool ldV = sc < DV, ldK = sc < DQ;
    const bf16_t* kp; long kld;
    if (DQ > 64 && sc >= 64) { kp = K2 + (sc - 64); kld = ldk2; } else { kp = K1 + sc; kld = ldk; }
    const bf16_t* vp = Vh + sc;
    struct Slot { bf16x8 vs0, vs1, ks0, ks1; };
    Slot sA, sB; sA.vs0 = sA.vs1 = sA.ks0 = sA.ks1 = bf16x8{}; sB = sA;
    Slot& sO = (SD == 2) ? sB : sA;
#define SLOAD(S_, k0) do { if (ldV) { S_.vs0 = *(const GAS bf16x8*)(vp + (long)((k0) + sr) * ldv); S_.vs1 = *(const GAS bf16x8*)(vp + (long)((k0) + 32 + sr) * ldv); } \
    if (ldK) { S_.ks0 = *(const GAS bf16x8*)(kp + (long)((k0) + sr) * kld); S_.ks1 = *(const GAS bf16x8*)(kp + (long)((k0) + 32 + sr) * kld); } } while (0)
#define SWRITE(b, S_) do { if (ldV) { *(bf16x8*)(V_lds + (b) * SHM_V + vst0) = S_.vs0; *(bf16x8*)(V_lds + (b) * SHM_V + vst1) = S_.vs1; } \
    if (ldK) { const int kc = sc * 2; *(bf16x8*)(K_lds + (b) * SHM_K + KSWZ(sr, kc)) = S_.ks0; *(bf16x8*)(K_lds + (b) * SHM_K + KSWZ(32 + sr, kc)) = S_.ks1; } } while (0)
#define SWAIT() do { if (SD == 2) asm volatile("s_waitcnt vmcnt(4)" ::: "memory"); else asm volatile("s_waitcnt vmcnt(0)" ::: "memory"); } while (0)
#define RESC(a) do { if (__any((a) < 1.f)) { if (hi == 0) al_l[r32] = (a); asm volatile("s_waitcnt lgkmcnt(0)" ::: "memory"); \
    _Pragma("unroll") for (int d = 0; d < NO; ++d) _Pragma("unroll") for (int r = 0; r < 16; ++r) o[d][r] *= al_l[crow(r, hi)]; } } while (0)
    f32x16 pA0, pA1, pB0, pB1; float mnA, mnB, alA, alB; bf16x8 pa0, pa1, pa2, pa3;
    SLOAD(sA, 0); asm volatile("s_waitcnt vmcnt(0)" ::: "memory"); SWRITE(0, sA); __syncthreads();
    qkt<ND>(pA0, pA1, K_lds, qr, r32, hi); partialSM<MODE>(pA0, pA1, m_reg, mnA, alA, na, 0, hi);
    SLOAD(sO, 64); if (SD == 2 && 2 < NT) SLOAD(sA, 128);
    SWAIT(); SWRITE(1, sO); __syncthreads();
    for (int j = 1; j + 1 < NT; j += 2) {
        SBAR(); qkt<ND>(pB0, pB1, K_lds + SHM_K, qr, r32, hi);
        finishSM(pA0, pA1, alA, l_reg, pa0, pa1, pa2, pa3); SBAR();
        SLOAD(sO, (j + SD) * 64); SBAR();
        pv_d0<NO>(o, vb0, pa0, pa1, pa2, pa3); partialSM<MODE>(pB0, pB1, m_reg, mnB, alB, na, j, hi);
        __syncthreads(); SWAIT(); SWRITE(0, sA);
        RESC(alB); __syncthreads();
        SBAR(); qkt<ND>(pA0, pA1, K_lds, qr, r32, hi);
        finishSM(pB0, pB1, alB, l_reg, pa0, pa1, pa2, pa3); SBAR();
        if (SD == 1 || j + 3 < NT) SLOAD(sA, (j + 1 + SD) * 64); SBAR();
        pv_d0<NO>(o, vb0 + SHM_V, pa0, pa1, pa2, pa3); partialSM<MODE>(pA0, pA1, m_reg, mnA, alA, na, j + 1, hi);
        __syncthreads(); SWAIT(); SWRITE(1, sO);
        RESC(alA); __syncthreads();
    }
    SBAR(); qkt<ND>(pB0, pB1, K_lds + SHM_K, qr, r32, hi);
    finishSM(pA0, pA1, alA, l_reg, pa0, pa1, pa2, pa3); SBAR();
    pv_d0<NO>(o, vb0, pa0, pa1, pa2, pa3); partialSM<MODE>(pB0, pB1, m_reg, mnB, alB, na, NT - 1, hi);
    __syncthreads(); RESC(alB);
    finishSM(pB0, pB1, alB, l_reg, pa0, pa1, pa2, pa3); SBAR();
    pv_d0<NO>(o, vb0 + SHM_V, pa0, pa1, pa2, pa3);
    if (hi == 0) li_l[r32] = l_reg;
    asm volatile("s_waitcnt lgkmcnt(0)" ::: "memory");
#pragma unroll
    for (int r = 0; r < 16; ++r) rli[r] = __builtin_amdgcn_rcpf(li_l[crow(r, hi)]);
#undef SLOAD
#undef SWRITE
#undef SWAIT
#undef RESC
}

__device__ __forceinline__ void na_item(const Params& p, int l, int item, char* lds) {
    const int xcd = item & 7, slot = item >> 3;
    const int pair = xcd * 4 + (slot >> 4), rb = slot & 15, b = pair >> 3, h = pair & 7;
    bf16_t* pa = (bf16_t*)(p.ws + OFF_PA);
    const int r0 = rb * 4, lo = min(max(r0 - 4, 0), 52);
    const int tid = otid(), wid = tid >> 6, lane = tid & 63, r32 = lane & 31, hi = lane >> 5;
    LAS float* tab = (LAS float*)((LAS unsigned char*)(uintptr_t)(unsigned)(uintptr_t)lds + 130 * 1024);
    const float* rpb = p.in[5] + ((size_t)l * 8 + h) * 465;
    if (tid < 465) tab[tid] = ((const GAS float*)rpb)[tid] * 8.0f;
    NaCtx na; const int wu = __builtin_amdgcn_readfirstlane(wid); const int r = r0 + (wu >> 1), qc = 32 * (wu & 1) + r32, rs = min(max(r - 4, 0), 56);
    na.vlo = rs - lo; na.vhi = na.vlo + 8; na.wstart = min(max(qc - 8, 0), 48); na.qc = qc; na.drow0 = lo - r + 7; na.tab = tab;
    const size_t tb = (size_t)b * SEQ;
    bf16_t* Q = pa + (tb + (size_t)r0 * 64) * 1536 + h * 64;
    const bf16_t* K = pa + (tb + (size_t)lo * 64) * 1536 + 512 + h * 64;
    const bf16_t* V = K + 512;
    f32x16 o[2]; float rli[16];
    attn_core<64, 64, 0, 1536, 1536, 1536, 1536, 1>(Q, K, K, V, 12, lds, o, rli, na);
    bf16_t* Ow = Q + (size_t)(wid * 32) * 1536;
#pragma unroll
    for (int rr = 0; rr < 16; ++rr) { const int orow = crow(rr, hi);
#pragma unroll
        for (int d = 0; d < 2; ++d) { const float v = o[d][rr] * rli[rr]; ((GAS bf16_t*)Ow)[(size_t)orow * 1536 + d * 32 + r32] = (bf16_t)(cvtpk(v, v) & 0xffffu); } }
    __syncthreads();
}
__device__ __forceinline__ void diff_item(const Params& p, int l, int item, char* lds) {
    const int xcd = item & 7, slot = item >> 3;
    const int pair = xcd * 2 + (slot >> 4), qb = slot & 15, b = pair >> 2, h = pair & 3;
    bf16_t* pd = (bf16_t*)(p.ws + OFF_PD);
    const int tid = otid(), wid = tid >> 6, lane = tid & 63, r32 = lane & 31, hi = lane >> 5;
    const float* lv = p.in[6] + (size_t)l * 256;
    float s1 = 0.f, s2 = 0.f;
    for (int i = 0; i < 64; ++i) { s1 += ((const GAS float*)lv)[i] * ((const GAS float*)lv)[64 + i]; s2 += ((const GAS float*)lv)[128 + i] * ((const GAS float*)lv)[192 + i]; }
    const float lam_init = p.lam_init[l], lam = __expf(s1) - __expf(s2) + lam_init;
    const size_t tb = (size_t)b * SEQ;
    bf16_t* Q = pd + (tb + (size_t)qb * 256) * 1536 + h * 128;
    const bf16_t* K = pd + tb * 1536 + 512 + h * 128;
    const bf16_t* V = pd + tb * 1536 + 1024 + h * 128;
    NaCtx na{};
    unsigned short* stash = (unsigned short*)(lds + 66 * 1024) + (size_t)wid * 64 * 64 + lane;
    f32x16 o[4]; float rli[16];
    attn_core<64, 128, 1, 1536, 1536, 1536, 1536, 2>(Q, K, K, V, 64, lds, o, rli, na);
#pragma unroll
    for (int d = 0; d < 4; ++d)
#pragma unroll
        for (int rr = 0; rr < 16; ++rr) { const float v = o[d][rr] * rli[rr]; stash[(d * 16 + rr) * 64] = (unsigned short)(cvtpk(v, v) & 0xffffu); }
    __syncthreads();
    attn_core<64, 128, 1, 1536, 1536, 1536, 1536, 2>(Q + 64, K + 64, K, V, 64, lds, o, rli, na);
    const float* sg = p.in[7] + (size_t)l * 128;
    float gcol[4];
#pragma unroll
    for (int d = 0; d < 4; ++d) gcol[d] = ((const GAS float*)sg)[d * 32 + r32] * (1.0f - lam_init);
    bf16_t* Ow = Q + (size_t)(wid * 32) * 1536;
#pragma unroll
    for (int rr = 0; rr < 16; ++rr) {
        float v[4]; float ss = 0.f;
#pragma unroll
        for (int d = 0; d < 4; ++d) { v[d] = bf2f(stash[(d * 16 + rr) * 64]) - lam * (o[d][rr] * rli[rr]); ss += v[d] * v[d]; }
        ss += __shfl_xor(ss, 1); ss += __shfl_xor(ss, 2); ss += __shfl_xor(ss, 4); ss += __shfl_xor(ss, 8); ss += __shfl_xor(ss, 16);
        const float rn = rsqrtf(ss * (1.0f / 128.0f) + 1e-6f);
        const int orow = crow(rr, hi);
#pragma unroll
        for (int d = 0; d < 4; ++d) { const float y = v[d] * rn * gcol[d]; ((GAS bf16_t*)Ow)[(size_t)orow * 1536 + d * 32 + r32] = (bf16_t)(cvtpk(y, y) & 0xffffu); }
    }
    __syncthreads();
}
__device__ __forceinline__ void mla_item(const Params& p, int item, char* lds) {
    const int xcd = item & 7, slot = item >> 3;
    const int pair = xcd * 4 + (slot >> 4), qb = slot & 15, b = pair >> 3, h = pair & 7;
    const int tid = otid(), wid = tid >> 6, lane = tid & 63, r32 = lane & 31, hi = lane >> 5;
    bf16_t* mc = (bf16_t*)(p.ws + OFF_MC); const bf16_t* mq = (const bf16_t*)(p.ws + OFF_MQ); const bf16_t* mkv = (const bf16_t*)(p.ws + OFF_MKV);
    const size_t tb = (size_t)b * SEQ;
    const bf16_t* Q = mq + (tb + (size_t)qb * 256) * 768 + h * 96;
    const bf16_t* K1 = mkv + tb * 1024 + h * 128;
    const bf16_t* K2 = mc + tb * 768 + 640;
    const bf16_t* V = K1 + 64;
    NaCtx na{};
    f32x16 o[2]; float rli[16];
    attn_core<96, 64, 2, 768, 1024, 768, 1024, 2>(Q, K1, K2, V, 64, lds, o, rli, na);
    bf16_t* Ow = mc + (tb + (size_t)qb * 256 + wid * 32) * 768 + h * 64;
#pragma unroll
    for (int rr = 0; rr < 16; ++rr) { const int orow = crow(rr, hi);
#pragma unroll
        for (int d = 0; d < 2; ++d) { const float v = o[d][rr] * rli[rr]; ((GAS bf16_t*)Ow)[(size_t)orow * 768 + d * 32 + r32] = (bf16_t)(cvtpk(v, v) & 0xffffu); } }
    __syncthreads();
}

struct MapId { __device__ __forceinline__ int operator()(int n) const { return n; } };
struct MapIn { __device__ __forceinline__ int operator()(int n) const { return n < 3744 ? n : (n < 3840 ? -1 : n - 96); } };
struct MapF1 { __device__ __forceinline__ int operator()(int n) const { const int pt = n >> 8, r = n & 255; return r < 128 ? pt * 128 + r : DFF + pt * 128 + (r - 128); } };
template <class Map>
__device__ __forceinline__ void prep_w(const float* __restrict__ src, int Ks, int Ns, bf16_t* __restrict__ dst, int Nd, int Kd, const float* __restrict__ kscale, Map map, float* tile) {
    const int tid = otid(), tx = tid & 63, ty = tid >> 6, nk = Kd / 64, ntile = (Nd / 64) * nk;
    for (int t = blockIdx.x; t < ntile; t += gridDim.x) {
        const int n0 = (t / nk) * 64, k0 = (t % nk) * 64;
        const int ns = map(n0 + tx);
#pragma unroll
        for (int j = 0; j < 8; ++j) { const int kl = ty + 8 * j, ks = (k0 + kl) % Ks; float v = 0.f;
            if (ns >= 0) { v = ((const GAS float*)src)[(size_t)ks * Ns + ns]; if (kscale) v *= ((const GAS float*)kscale)[ks]; }
            tile[kl * 65 + tx] = v; }
        __syncthreads();
        const int kx = (tid & 31) * 2, ny = tid >> 5;
#pragma unroll
        for (int j = 0; j < 4; ++j) { const int nl = ny + 16 * j;
            *(GAS unsigned*)(dst + (size_t)(n0 + nl) * Kd + k0 + kx) = cvtpk(tile[kx * 65 + nl], tile[(kx + 1) * 65 + nl]); }
        __syncthreads();
    }
}
__device__ __forceinline__ void ln_rows(const float* src, float* dstf, bf16_t* dstb, const float* __restrict__ g, const float* __restrict__ bta, int row0, int nrows) {
    const int tid_ = otid(); const int lane = tid_ & 63, wv = blockIdx.x * 8 + (tid_ >> 6), nw = gridDim.x * 8;
    f32x4 gv[4], bv[4];
#pragma unroll
    for (int i = 0; i < 4; ++i) { gv[i] = *(const GAS f32x4*)(g + i * 256 + lane * 4); bv[i] = *(const GAS f32x4*)(bta + i * 256 + lane * 4); }
    for (int r = wv; r < nrows; r += nw) {
        const size_t ro = (size_t)(row0 + r) * 1024;
        f32x4 v[4]; float s = 0.f;
#pragma unroll
        for (int i = 0; i < 4; ++i) { v[i] = *(const GAS f32x4*)(src + ro + i * 256 + lane * 4); s += (v[i][0] + v[i][1]) + (v[i][2] + v[i][3]); }
#pragma unroll
        for (int k = 1; k < 64; k <<= 1) s += __shfl_xor(s, k);
        const float mu = s * (1.0f / 1024.0f); float q = 0.f;
#pragma unroll
        for (int i = 0; i < 4; ++i) { v[i] = v[i] - mu; q += (v[i][0] * v[i][0] + v[i][1] * v[i][1]) + (v[i][2] * v[i][2] + v[i][3] * v[i][3]); }
#pragma unroll
        for (int k = 1; k < 64; k <<= 1) q += __shfl_xor(q, k);
        const float rstd = rsqrtf(q * (1.0f / 1024.0f) + 1e-5f);
#pragma unroll
        for (int i = 0; i < 4; ++i) { const f32x4 y = v[i] * rstd * gv[i] + bv[i]; *(GAS f32x4*)(dstf + ro + i * 256 + lane * 4) = y;
            if (dstb) st_bf4(dstb + ro + i * 256 + lane * 4, y); }
    }
}

#ifndef PHMASK
#define PHMASK 0xffff
#endif
#define WSP(T_, off) ((T_*)(wsb + (off)))
__device__ __forceinline__ void gsync(cg::grid_group& g) { asm volatile("s_waitcnt vmcnt(0)" ::: "memory"); g.sync(); __builtin_amdgcn_fence(__ATOMIC_ACQUIRE, "agent"); }
__global__ __launch_bounds__(512, 2) void fwd_megakernel(Params p) {
    extern __shared__ __attribute__((aligned(16))) unsigned char shm[];
    cg::grid_group grid = cg::this_grid();
    LAS unsigned char* ldsg = (LAS unsigned char*)shm;
    char* lds = (char*)shm;
    if (PHMASK & 512) {
        unsigned char* wsb = p.ws;
        float* tile = (float*)shm;
        for (int l = 0; l < DEPTH; ++l) {
            prep_w(p.in[3] + (size_t)l * 1024 * 6816, 1024, 6816, WSP(bf16_t, OFF_WIN) + (size_t)l * NIN * 1024, NIN, 1024, nullptr, MapIn(), tile);
            prep_w(p.in[10] + (size_t)l * 384 * 768, 384, 768, WSP(bf16_t, OFF_WQB) + (size_t)l * 768 * 384, 768, 384, p.in[8] + l * 384, MapId(), tile);
            prep_w(p.in[11] + (size_t)l * 256 * 1024, 256, 1024, WSP(bf16_t, OFF_WKVB) + (size_t)l * 1024 * 256, 1024, 256, p.in[9] + l * 256, MapId(), tile);
            for (int i = 0; i < 3; ++i)
                prep_w(p.in[12] + ((size_t)l * 3 + i) * 512 * 1024, 512, 1024, WSP(bf16_t, OFF_WBR) + ((size_t)l * 3 + i) * 1024 * 512, 1024, 512, nullptr, MapId(), tile);
            prep_w(p.in[13] + (size_t)l * 1024 * 1024, 1024, 1024, WSP(bf16_t, OFF_WOUT) + (size_t)l * 1024 * 3072, 1024, 3072, nullptr, MapId(), tile);
            prep_w(p.in[16] + (size_t)l * 1024 * 5632, 1024, 5632, WSP(bf16_t, OFF_WF1) + (size_t)l * 5632 * 1024, 5632, 1024, nullptr, MapF1(), tile);
            prep_w(p.in[17] + (size_t)l * 2816 * 1024, 2816, 1024, WSP(bf16_t, OFF_WF2) + (size_t)l * 1024 * 2816, 1024, 2816, nullptr, MapId(), tile);
        }
        const int gtid = blockIdx.x * 512 + otid(), gn = gridDim.x * 512;
        const float nlt = -13.122363377404328f;
        float* cd = WSP(float, OFF_TD); float* sd = cd + SEQ * 8; float* cm = WSP(float, OFF_TM); float* sm = cm + SEQ * 16;
        for (int i = gtid; i < SEQ * 8; i += gn) { const int pos = i >> 3, f = i & 7; const float inv = expf(nlt * (float)f / 8.0f), ang = (float)pos * inv; ((GAS float*)cd)[i] = cosf(ang); ((GAS float*)sd)[i] = sinf(ang); }
        for (int i = gtid; i < SEQ * 16; i += gn) { const int pos = i >> 4, f = i & 15; const float inv = expf(nlt * (float)f / 16.0f), ang = (float)pos * inv; ((GAS float*)cm)[i] = cosf(ang); ((GAS float*)sm)[i] = sinf(ang); }
        ln_rows(p.in[0], p.out, WSP(bf16_t, OFF_XB), p.in[1], p.in[2], 0, T_ALL);
    }
    gsync(grid);
    for (int step = 0; step < NCHUNK * DEPTH * 9; ++step) {
        const int ck = step / (DEPTH * 9), l = (step % (DEPTH * 9)) / 9, ph = step % 9;
        const size_t tok0 = (size_t)ck * TC;
        unsigned wlo_ = (unsigned)(uintptr_t)p.ws, whi_ = (unsigned)((uintptr_t)p.ws >> 32); asm volatile("" : "+v"(wlo_), "+v"(whi_));
        unsigned char* wsb = (unsigned char*)(((uintptr_t)(unsigned)__builtin_amdgcn_readfirstlane((int)whi_) << 32) | (uintptr_t)(unsigned)__builtin_amdgcn_readfirstlane((int)wlo_));
        switch (ph) {
        case 0: if (PHMASK & 1) {
            float* cd = WSP(float, OFF_TD); float* cm = WSP(float, OFF_TM);
            EpiIn E{WSP(bf16_t, OFF_PA), WSP(bf16_t, OFF_PD), WSP(bf16_t, OFF_MC), WSP(bf16_t, OFF_GT), WSP(float, OFF_SSQ), p.in[4] + (size_t)l * 3072, cd, cd + SEQ * 8, cm, cm + SEQ * 16};
            gemm_phase(ldsg, WSP(bf16_t, OFF_XB) + tok0 * 1024, 1024, WSP(bf16_t, OFF_WIN) + (size_t)l * NIN * 1024, 1024, TC, NIN, 1024, E);
        } break;
        case 1: if (PHMASK & 2) {
            if (PHMASK & 1024) { EpiKV E{WSP(bf16_t, OFF_MKV), WSP(float, OFF_SSQ)}; gemm_phase(ldsg, WSP(bf16_t, OFF_MC) + 384, 768, WSP(bf16_t, OFF_WKVB) + (size_t)l * 1024 * 256, 256, TC, 1024, 256, E); }
            if (PHMASK & 2048) { float* cm = WSP(float, OFF_TM); EpiQ E{WSP(bf16_t, OFF_MQ), WSP(float, OFF_SSQ), cm, cm + SEQ * 16}; gemm_phase(ldsg, WSP(bf16_t, OFF_MC), 768, WSP(bf16_t, OFF_WQB) + (size_t)l * 768 * 384, 384, TC, 768, 384, E); }
            __syncthreads();
            if (PHMASK & 4096) for (int it = blockIdx.x; it < 512; it += gridDim.x) na_item(p, l, it, lds);
        } break;
        case 2: if (PHMASK & 4) {
            if (PHMASK & 8192) for (int it = blockIdx.x; it < 256; it += gridDim.x) diff_item(p, l, it, lds);
            if (PHMASK & 16384) for (int it = blockIdx.x; it < 512; it += gridDim.x) mla_item(p, it, lds);
        } break;
        case 3: if (PHMASK & 8) {
            for (int i = 0; i < 3; ++i) {
                const bf16_t* A = i == 0 ? WSP(bf16_t, OFF_PA) : (i == 1 ? WSP(bf16_t, OFF_PD) : WSP(bf16_t, OFF_MC)); const int lda = i == 2 ? 768 : 1536;
                EpiBr E{WSP(bf16_t, OFF_GT) + i * 1024};
                gemm_phase(ldsg, A, lda, WSP(bf16_t, OFF_WBR) + ((size_t)l * 3 + i) * 1024 * 512, 512, TC, 1024, 512, E);
            }
        } break;
        case 4: case 7: if (PHMASK & 16) {
            EpiRes E{p.out + tok0 * 1024};
            const bf16_t* A = ph == 4 ? WSP(bf16_t, OFF_GT) : WSP(bf16_t, OFF_PA); const int kk = ph == 4 ? 3072 : DFF;
            const bf16_t* B = ph == 4 ? WSP(bf16_t, OFF_WOUT) + (size_t)l * 1024 * 3072 : WSP(bf16_t, OFF_WF2) + (size_t)l * 1024 * DFF;
            gemm_phase(ldsg, A, kk, B, kk, TC, 1024, kk, E);
        } break;
        case 5: case 8: if (PHMASK & 32) {
            const float* g = ph == 5 ? p.in[14] : p.in[18]; const float* bb = ph == 5 ? p.in[15] : p.in[19];
            ln_rows(p.out, p.out, WSP(bf16_t, OFF_XB), g + l * 1024, bb + l * 1024, (int)tok0, TC);
        } break;
        case 6: if (PHMASK & 64) {
            EpiF1 E{WSP(bf16_t, OFF_PA)};
            gemm_phase(ldsg, WSP(bf16_t, OFF_XB) + tok0 * 1024, 1024, WSP(bf16_t, OFF_WF1) + (size_t)l * 5632 * 1024, 1024, TC, 5632, 1024, E);
        } break;
        }
        gsync(grid);
    }
}

extern "C" void kernel_launch(void* const* d_in, const int* in_sizes, int n_in, void* d_out, int out_size, void* d_ws, size_t ws_size, hipStream_t stream) {
    static int grid = 0;
    if (grid == 0) {
        if (n_in != 20 || in_sizes[0] != T_ALL * DM || out_size != T_ALL * DM || ws_size < WS_END) {
            fprintf(stderr, "kernel_launch: unexpected shapes / workspace (n_in %d, ws %zu, need %zu)\n", n_in, ws_size, (size_t)WS_END); grid = -1; return; }
        int dev = 0, cus = 0, per_cu = 0;
        hipGetDevice(&dev); hipDeviceGetAttribute(&cus, hipDeviceAttributeMultiprocessorCount, dev);
        if (hipFuncSetAttribute((const void*)fwd_megakernel, hipFuncAttributeMaxDynamicSharedMemorySize, LDS_BYTES) != hipSuccess) { fprintf(stderr, "kernel_launch: hipFuncSetAttribute failed\n"); grid = -1; return; }
        if (hipOccupancyMaxActiveBlocksPerMultiprocessor(&per_cu, (const void*)fwd_megakernel, 512, LDS_BYTES) != hipSuccess || per_cu < 1) { fprintf(stderr, "kernel_launch: occupancy query gave %d\n", per_cu); per_cu = 1; }
        (void)hipGetLastError();
        grid = cus;
    }
    if (grid < 0) return;
    Params p{};
    for (int i = 0; i < 20; ++i) p.in[i] = (const float*)d_in[i];
    p.out = (float*)d_out; p.ws = (unsigned char*)d_ws;
    for (int l = 0; l < 4; ++l) p.lam_init[l] = (float)(0.8 - 0.6 * exp(-0.3 * (double)l));
    void* args[] = {&p};
    hipError_t e = hipLaunchCooperativeKernel((const void*)fwd_megakernel, dim3(grid), dim3(512), args, LDS_BYTES, stream);
    if (e != hipSuccess) fprintf(stderr, "kernel_launch: cooperative launch failed: %s (grid %d)\n", hipGetErrorString(e), grid);
}
```

```cpp
#include <hip/hip_runtime.h>
#include <hip/hip_cooperative_groups.h>
#include <cstdio>
#include <cstdint>
namespace cg = cooperative_groups;

#define LAS __attribute__((address_space(3)))
#define GAS __attribute__((address_space(1)))
typedef unsigned short bf16_t;
typedef short bf16x8 __attribute__((ext_vector_type(8)));
typedef short s16x4 __attribute__((ext_vector_type(4)));
typedef float f32x4 __attribute__((ext_vector_type(4)));
typedef float f32x16 __attribute__((ext_vector_type(16)));
typedef unsigned u32x4 __attribute__((ext_vector_type(4)));
typedef unsigned u32x2 __attribute__((ext_vector_type(2)));

constexpr int T_ALL = 32768, TC = 16384, DM = 1024, SEQ = 4096, NIN = 6912, DFF = 2816, DEPTH = 4, NCHUNK = 2;
constexpr size_t SZ_WIN = (size_t)DEPTH * NIN * 1024 * 2, SZ_WQB = (size_t)DEPTH * 768 * 384 * 2, SZ_WKVB = (size_t)DEPTH * 1024 * 256 * 2,
                 SZ_WBR = (size_t)DEPTH * 3 * 1024 * 512 * 2, SZ_WOUT = (size_t)DEPTH * 1024 * 3072 * 2, SZ_WF1 = (size_t)DEPTH * 5632 * 1024 * 2,
                 SZ_WF2 = (size_t)DEPTH * 1024 * 2816 * 2, SZ_XB = (size_t)T_ALL * 1024 * 2, SZ_PA = (size_t)TC * 1536 * 2, SZ_PD = SZ_PA,
                 SZ_MC = (size_t)TC * 768 * 2, SZ_GT = (size_t)TC * 3072 * 2, SZ_MQ = (size_t)TC * 768 * 2, SZ_MKV = (size_t)TC * 1024 * 2,
                 SZ_SSQ = (size_t)TC * 24 * 4, SZ_TD = (size_t)SEQ * 8 * 4 * 2, SZ_TM = (size_t)SEQ * 16 * 4 * 2;
constexpr size_t OFF_WIN = 0, OFF_WQB = OFF_WIN + SZ_WIN, OFF_WKVB = OFF_WQB + SZ_WQB, OFF_WBR = OFF_WKVB + SZ_WKVB, OFF_WOUT = OFF_WBR + SZ_WBR,
                 OFF_WF1 = OFF_WOUT + SZ_WOUT, OFF_WF2 = OFF_WF1 + SZ_WF1, OFF_XB = OFF_WF2 + SZ_WF2, OFF_PA = OFF_XB + SZ_XB, OFF_PD = OFF_PA + SZ_PA,
                 OFF_MC = OFF_PD + SZ_PD, OFF_GT = OFF_MC + SZ_MC, OFF_MQ = OFF_GT + SZ_GT, OFF_MKV = OFF_MQ + SZ_MQ, OFF_SSQ = OFF_MKV + SZ_MKV,
                 OFF_TD = OFF_SSQ + SZ_SSQ, OFF_TM = OFF_TD + SZ_TD, WS_END = OFF_TM + SZ_TM;
constexpr int LDS_BYTES = 132 * 1024;
static_assert((size_t)T_ALL * DFF * 2 <= SZ_PA + SZ_PD + SZ_MC + SZ_GT, "SwiGLU hidden of all tokens aliases projA|projD|mla_c|gates");
constexpr float DN_ALPHA = 1.681792830507429f;

struct Params { const float* in[20]; float* out; unsigned char* ws; float lam_init[4]; };

typedef __bf16 bf2_t __attribute__((ext_vector_type(2)));
typedef float f32x2 __attribute__((ext_vector_type(2)));
__device__ __forceinline__ unsigned cvtpk(float lo, float hi) { f32x2 v = {lo, hi}; bf2_t b = __builtin_convertvector(v, bf2_t); return __builtin_bit_cast(unsigned, b); }
__device__ __forceinline__ int otid() { int t = threadIdx.x; asm volatile("" : "+v"(t)); return t; }
__device__ __forceinline__ float bf2f(unsigned short b) { return __uint_as_float(((unsigned)b) << 16); }
__device__ __forceinline__ void st_bf4(bf16_t* p, f32x4 v) { u32x2 w; w.x = cvtpk(v[0], v[1]); w.y = cvtpk(v[2], v[3]); *(GAS u32x2*)p = w; }

constexpr int BM = 256, BK = 64, HALF = 128, HTB = HALF * BK * 2, NXCD = 8, WGM = 8;
__device__ __forceinline__ int lds_byte(int r, int c) { const int st = (r >> 4) * 2 + (c >> 5), rr = r & 15, cc = c & 31, ob = rr * 64 + cc * 2; return st * 1024 + (ob ^ (((ob >> 9) & 1) << 5)); }
__device__ __forceinline__ void stage_rc(int b, int& R, int& C) { const int st = b / 1024, sb = b % 1024, swz = sb ^ (((sb >> 9) & 1) << 5); R = (st >> 1) * 16 + swz / 64; C = (st & 1) * 32 + (swz % 64) / 2; }
struct Unit { int pm, pn; };
struct StaticOrder {
    int nM, nN, nwg, G, c;
    __device__ void init(int M, int N, int G_, int c_) { nM = M / BM; nN = N / BM; nwg = nM * nN; G = G_; c = c_; }
    __device__ bool next(int i, Unit& u) const {
        const long L = (long)i * G + c; if (L >= nwg) return false;
        int wgid = (int)L; { const int q = nwg / NXCD, r = nwg % NXCD, xcd = wgid % NXCD, off = wgid / NXCD; wgid = (xcd < r ? xcd * (q + 1) : r * (q + 1) + (xcd - r) * q) + off; }
        const int nig = WGM * nN, gid = wgid / nig, fm = gid * WGM, gsz = (nM - fm) < WGM ? (nM - fm) : WGM;
        u.pm = __builtin_amdgcn_readfirstlane(fm + ((wgid % nig) % gsz)); u.pn = __builtin_amdgcn_readfirstlane((wgid % nig) / gsz); return true;
    }
};

template <class Epi>
__device__ __forceinline__ void gemm_phase(LAS unsigned char* lds, const bf16_t* A, int lda, const bf16_t* Bt, int ldb, int M, int N, int K, const Epi& E) {
    const int tid = otid(), wid = __builtin_amdgcn_readfirstlane(tid >> 6), lane = tid & 63, wr = wid >> 2, wc = wid & 3, fr = lane & 15, fq = lane >> 4;
    int ntv_ = K / BK; asm volatile("" : "+v"(ntv_)); const int nt = __builtin_amdgcn_readfirstlane(ntv_);
    StaticOrder S; S.init(M, N, (int)gridDim.x, (int)blockIdx.x);
    unsigned voffA[2], voffB[2];
#pragma unroll
    for (int i = 0; i < 2; ++i) { int R, C; stage_rc(tid * 16 + i * 8192, R, C); voffA[i] = (unsigned)(R * lda + C) * 2u; voffB[i] = (unsigned)(R * ldb + C) * 2u; }
    const size_t kstep = (size_t)(BK * 2);
    const size_t hstepA = (size_t)HALF * lda * 2, tstepA = 2 * hstepA, hstepB = (size_t)HALF * ldb * 2, tstepB = 2 * hstepB;
    const unsigned ldsw = (unsigned)wid * 1024u;
    const int aoff = lds_byte(wr * 64 + fr, fq * 8), boff = lds_byte(wc * 32 + fr, fq * 8);
#define PG8_SA(b, h) (((b) * 2 + (h)) * HTB)
#define PG8_SB(b, h) ((4 + (b) * 2 + (h)) * HTB)
#define PG8_STAGE(bufoff, gbase, voff) do { _Pragma("unroll") for (int _i = 0; _i < 2; ++_i) \
        __builtin_amdgcn_global_load_lds((const unsigned*)((const char*)(gbase) + (voff)[_i]), (LAS unsigned*)(lds + (bufoff) + ldsw + _i * 8192), 16, 0, 0); } while (0)
#define PG8_LDA(dst, b, h) do { _Pragma("unroll") for (int m = 0; m < 4; ++m) _Pragma("unroll") for (int k = 0; k < 2; ++k) dst[m][k] = *(const LAS bf16x8*)(lds + PG8_SA(b, h) + aoff + m * 2048 + k * 1024); } while (0)
#define PG8_LDB(dst, b, h) do { _Pragma("unroll") for (int n = 0; n < 2; ++n) _Pragma("unroll") for (int k = 0; k < 2; ++k) dst[n][k] = *(const LAS bf16x8*)(lds + PG8_SB(b, h) + boff + n * 2048 + k * 1024); } while (0)
#define PG8_MMA(ai, bj, At, Bt_) do { __builtin_amdgcn_s_setprio(1); _Pragma("unroll") for (int m = 0; m < 4; ++m) _Pragma("unroll") for (int n = 0; n < 2; ++n) _Pragma("unroll") for (int k = 0; k < 2; ++k) \
        acc[ai][bj][m][n] = __builtin_amdgcn_mfma_f32_16x16x32_bf16(Bt_[n][k], At[m][k], acc[ai][bj][m][n], 0, 0, 0); __builtin_amdgcn_s_setprio(0); } while (0)
#define PG8_WAIT_V(n) asm volatile("s_waitcnt vmcnt(" #n ")" ::: "memory")
#define PG8_WAIT_L(n) asm volatile("s_waitcnt lgkmcnt(" #n ")" ::: "memory")
#define PG8_BAR __builtin_amdgcn_s_barrier()
#define PG8_SCHED __builtin_amdgcn_sched_barrier(0)
    Unit cur, nxt; int ui = 0;
    if (!S.next(0, cur)) return;
    f32x4 acc[2][2][4][2];
#pragma unroll
    for (int a = 0; a < 2; ++a)
#pragma unroll
        for (int b = 0; b < 2; ++b)
#pragma unroll
            for (int m = 0; m < 4; ++m)
#pragma unroll
                for (int n = 0; n < 2; ++n) acc[a][b][m][n] = (f32x4){0.f, 0.f, 0.f, 0.f};
    bf16x8 At[4][2], B0[2][2], B1[2][2];
    const char* cA = (const char*)A + (size_t)cur.pm * tstepA; const char* cB = (const char*)Bt + (size_t)cur.pn * tstepB;
    PG8_STAGE(PG8_SB(0, 0), cB, voffB); PG8_STAGE(PG8_SA(0, 0), cA, voffA); PG8_STAGE(PG8_SB(0, 1), cB + hstepB, voffB); PG8_STAGE(PG8_SA(0, 1), cA + hstepA, voffA);
    if (wr == 1) PG8_BAR;
    PG8_WAIT_V(4); PG8_BAR;
    PG8_STAGE(PG8_SB(1, 0), cB + kstep, voffB); PG8_STAGE(PG8_SA(1, 0), cA + kstep, voffA); PG8_STAGE(PG8_SB(1, 1), cB + hstepB + kstep, voffB);
    PG8_WAIT_V(6); PG8_BAR;
    for (;;) {
        const bool has_next = S.next(ui + 1, nxt);
        const char* nA = has_next ? (const char*)A + (size_t)nxt.pm * tstepA : cA; const char* nB = has_next ? (const char*)Bt + (size_t)nxt.pn * tstepB : cB;
#pragma unroll 1
        for (int t = 0; t < nt; t += 2) {
            const bool last = (t == nt - 2);
            const char* a1 = cA + (size_t)(t + 1) * kstep;
            const char* a2 = last ? nA : cA + (size_t)(t + 2) * kstep; const char* b2 = last ? nB : cB + (size_t)(t + 2) * kstep;
            const char* a3 = a2 + kstep; const char* b3 = b2 + kstep;
            PG8_LDB(B0, 0, 0); PG8_SCHED; PG8_LDA(At, 0, 0); PG8_STAGE(PG8_SA(1, 1), a1 + hstepA, voffA);
            PG8_WAIT_L(8); PG8_BAR; PG8_WAIT_L(0); PG8_MMA(0, 0, At, B0); PG8_BAR; PG8_SCHED;
            PG8_LDB(B1, 0, 1); PG8_STAGE(PG8_SB(0, 0), b2, voffB);
            PG8_BAR; PG8_WAIT_L(0); PG8_MMA(0, 1, At, B1); PG8_BAR;
            PG8_LDA(At, 0, 1); PG8_STAGE(PG8_SA(0, 0), a2, voffA);
            PG8_BAR; PG8_WAIT_L(0); PG8_MMA(1, 0, At, B0); PG8_BAR; PG8_SCHED;
            PG8_STAGE(PG8_SB(0, 1), b2 + hstepB, voffB);
            PG8_WAIT_V(6); PG8_BAR; PG8_MMA(1, 1, At, B1); PG8_BAR;
            PG8_LDB(B0, 1, 0); PG8_SCHED; PG8_LDA(At, 1, 0); PG8_STAGE(PG8_SA(0, 1), a2 + hstepA, voffA);
            PG8_WAIT_L(8); PG8_BAR; PG8_WAIT_L(0); PG8_MMA(0, 0, At, B0); PG8_BAR; PG8_SCHED;
            PG8_LDB(B1, 1, 1); PG8_STAGE(PG8_SB(1, 0), b3, voffB);
            PG8_BAR; PG8_WAIT_L(0); PG8_MMA(0, 1, At, B1); PG8_BAR;
            PG8_LDA(At, 1, 1); PG8_STAGE(PG8_SA(1, 0), a3, voffA);
            PG8_BAR; PG8_WAIT_L(0); PG8_MMA(1, 0, At, B0); PG8_BAR; PG8_SCHED;
            PG8_STAGE(PG8_SB(1, 1), b3 + hstepB, voffB);
            PG8_WAIT_V(6); PG8_BAR; PG8_MMA(1, 1, At, B1); PG8_BAR;
        }
        E(acc, cur, wr, wc, fr, fq);
        if (!has_next) break;
#pragma unroll
        for (int a = 0; a < 2; ++a)
#pragma unroll
            for (int b = 0; b < 2; ++b)
#pragma unroll
                for (int m = 0; m < 4; ++m)
#pragma unroll
                    for (int n = 0; n < 2; ++n) acc[a][b][m][n] = (f32x4){0.f, 0.f, 0.f, 0.f};
        cur = nxt; cA = nA; cB = nB; ++ui;
    }
    PG8_WAIT_V(0);
    if (wr == 0) PG8_BAR;
    PG8_BAR;
#undef PG8_SA
#undef PG8_SB
#undef PG8_STAGE
#undef PG8_LDA
#undef PG8_LDB
#undef PG8_MMA
#undef PG8_WAIT_V
#undef PG8_WAIT_L
#undef PG8_BAR
#undef PG8_SCHED
}

struct EpiIn {
    bf16_t *pa, *pd, *mc, *gt; float* ssq; const float* bg; const float *cd, *sd, *cm, *sm;
    __device__ __forceinline__ void operator()(const f32x4 (&acc)[2][2][4][2], const Unit& u, int wr, int wc, int fr, int fq) const {
        int row0 = u.pm * BM + wr * 64 + fr; asm volatile("" : "+v"(row0) :: "memory"); const int pn = u.pn, cw = wc * 32 + 4 * fq;
        if (pn < 6) {
#pragma unroll
            for (int ai = 0; ai < 2; ++ai)
#pragma unroll
                for (int m = 0; m < 4; ++m) { __builtin_amdgcn_sched_barrier(0); bf16_t* rp = pa + (size_t)(row0 + ai * HALF + m * 16) * 1536 + pn * 256 + cw;
#pragma unroll
                    for (int bj = 0; bj < 2; ++bj)
#pragma unroll
                        for (int n = 0; n < 2; ++n) st_bf4(rp + bj * HALF + n * 16, acc[ai][bj][m][n]); }
        } else if (pn < 12) {
            const bool rope = (pn < 10) && !(wc & 1);
#pragma unroll
            for (int ai = 0; ai < 2; ++ai)
#pragma unroll
                for (int m = 0; m < 4; ++m) { __builtin_amdgcn_sched_barrier(0); const int row = row0 + ai * HALF + m * 16; bf16_t* rp = pd + (size_t)row * 1536 + (pn - 6) * 256 + cw;
                    f32x4 c4 = {1.f, 1.f, 1.f, 1.f}, s4 = {0.f, 0.f, 0.f, 0.f};
                    if (rope) { const int pos = row & (SEQ - 1); c4 = *(const GAS f32x4*)(cd + pos * 8 + (fq & 1) * 4); s4 = *(const GAS f32x4*)(sd + pos * 8 + (fq & 1) * 4); }
#pragma unroll
                    for (int bj = 0; bj < 2; ++bj) { f32x4 v0 = acc[ai][bj][m][0];
                        if (rope) { f32x4 pr;
#pragma unroll
                            for (int j = 0; j < 4; ++j) pr[j] = __shfl_xor(v0[j], 32);
                            v0 = (fq < 2) ? (v0 * c4 - pr * s4) : (v0 * c4 + pr * s4); }
                        st_bf4(rp + bj * HALF, v0); st_bf4(rp + bj * HALF + 16, acc[ai][bj][m][1]); } }
        } else if (pn < 15) {
            const int t = pn - 12;
#pragma unroll
            for (int ai = 0; ai < 2; ++ai)
#pragma unroll
                for (int m = 0; m < 4; ++m) { __builtin_amdgcn_sched_barrier(0); const int row = row0 + ai * HALF + m * 16; bf16_t* rp = mc + (size_t)row * 768 + t * 256 + cw;
#pragma unroll
                    for (int bj = 0; bj < 2; ++bj) { f32x4 v0 = acc[ai][bj][m][0], v1 = acc[ai][bj][m][1];
                        float s = (v0[0] * v0[0] + v0[1] * v0[1]) + (v0[2] * v0[2] + v0[3] * v0[3]) + (v1[0] * v1[0] + v1[1] * v1[1]) + (v1[2] * v1[2] + v1[3] * v1[3]);
                        s += __shfl_xor(s, 16); s += __shfl_xor(s, 32);
                        if (fq == 0) *(GAS float*)(ssq + (size_t)row * 24 + t * 8 + bj * 4 + wc) = s;
                        if (t == 2 && bj == 1 && wc == 0) { const int pos = row & (SEQ - 1); const f32x4 c4 = *(const GAS f32x4*)(cm + pos * 16 + fq * 4), s4 = *(const GAS f32x4*)(sm + pos * 16 + fq * 4);
                            const f32x4 n0 = v0 * c4 - v1 * s4, n1 = v1 * c4 + v0 * s4; v0 = n0; v1 = n1; }
                        st_bf4(rp + bj * HALF, v0); st_bf4(rp + bj * HALF + 16, v1); } }
        } else {
            const int t = pn - 15;
            f32x4 bv[2][2];
#pragma unroll
            for (int bj = 0; bj < 2; ++bj)
#pragma unroll
                for (int n = 0; n < 2; ++n) bv[bj][n] = *(const GAS f32x4*)(bg + t * 256 + bj * HALF + n * 16 + cw);
#pragma unroll
            for (int ai = 0; ai < 2; ++ai)
#pragma unroll
                for (int m = 0; m < 4; ++m) { __builtin_amdgcn_sched_barrier(0); bf16_t* rp = gt + (size_t)(row0 + ai * HALF + m * 16) * 3072 + t * 256 + cw;
#pragma unroll
                    for (int bj = 0; bj < 2; ++bj)
#pragma unroll
                        for (int n = 0; n < 2; ++n) { f32x4 v = acc[ai][bj][m][n] + bv[bj][n];
#pragma unroll
                            for (int j = 0; j < 4; ++j) v[j] = __builtin_amdgcn_rcpf(1.0f + __expf(-v[j]));
                            st_bf4(rp + bj * HALF + n * 16, v); } }
        }
    }
};
struct EpiQ {
    bf16_t* mq; const float* ssq; const float *cm, *sm;
    __device__ __forceinline__ void operator()(const f32x4 (&acc)[2][2][4][2], const Unit& u, int wr, int wc, int fr, int fq) const {
        int row0 = u.pm * BM + wr * 64 + fr; asm volatile("" : "+v"(row0) :: "memory"); const int cw = wc * 32 + 4 * fq;
        float rr8[8];
#pragma unroll
        for (int i = 0; i < 8; ++i) { const float* sp = ssq + (size_t)(row0 + (i >> 2) * HALF + (i & 3) * 16) * 24 + fq * 4;
            const f32x4 a = *(const GAS f32x4*)sp;
            float ss = fq < 3 ? ((a[0] + a[1]) + (a[2] + a[3])) : 0.f;
            ss += __shfl_xor(ss, 16); ss += __shfl_xor(ss, 32);
            rr8[i] = rsqrtf(ss * (1.0f / 384.0f) + 1e-6f); }
#pragma unroll
        for (int ai = 0; ai < 2; ++ai)
#pragma unroll
            for (int m = 0; m < 4; ++m) { __builtin_amdgcn_sched_barrier(0); const int row = row0 + ai * HALF + m * 16; const float r = rr8[ai * 4 + m];
                bf16_t* rp = mq + (size_t)row * 768 + u.pn * 256 + cw;
#pragma unroll
                for (int bj = 0; bj < 2; ++bj) { const int G = u.pn * 8 + bj * 4 + wc; f32x4 v0 = acc[ai][bj][m][0] * r, v1 = acc[ai][bj][m][1] * r;
                    if (G % 3 == 2) { const int pos = row & (SEQ - 1); const f32x4 c4 = *(const GAS f32x4*)(cm + pos * 16 + fq * 4), s4 = *(const GAS f32x4*)(sm + pos * 16 + fq * 4);
                        const f32x4 n0 = v0 * c4 - v1 * s4, n1 = v1 * c4 + v0 * s4; v0 = n0; v1 = n1; }
                    st_bf4(rp + bj * HALF, v0); st_bf4(rp + bj * HALF + 16, v1); } }
    }
};
struct EpiKV {
    bf16_t* mkv; const float* ssq;
    __device__ __forceinline__ void operator()(const f32x4 (&acc)[2][2][4][2], const Unit& u, int wr, int wc, int fr, int fq) const {
        int row0 = u.pm * BM + wr * 64 + fr; asm volatile("" : "+v"(row0) :: "memory"); const int cw = wc * 32 + 4 * fq;
        float rr8[8];
#pragma unroll
        for (int i = 0; i < 8; ++i) { const float* sp = ssq + (size_t)(row0 + (i >> 2) * HALF + (i & 3) * 16) * 24 + 12 + (fq & 1) * 4;
            const f32x4 a = *(const GAS f32x4*)sp;
            float ss = fq < 2 ? ((a[0] + a[1]) + (a[2] + a[3])) : 0.f;
            ss += __shfl_xor(ss, 16); ss += __shfl_xor(ss, 32);
            rr8[i] = rsqrtf(ss * (1.0f / 256.0f) + 1e-6f); }
#pragma unroll
        for (int ai = 0; ai < 2; ++ai)
#pragma unroll
            for (int m = 0; m < 4; ++m) { __builtin_amdgcn_sched_barrier(0); const int row = row0 + ai * HALF + m * 16; const float r = rr8[ai * 4 + m];
                bf16_t* rp = mkv + (size_t)row * 1024 + u.pn * 256 + cw;
#pragma unroll
                for (int bj = 0; bj < 2; ++bj)
#pragma unroll
                    for (int n = 0; n < 2; ++n) st_bf4(rp + bj * HALF + n * 16, acc[ai][bj][m][n] * r); }
    }
};
struct EpiBr {
    bf16_t* gt;
    __device__ __forceinline__ void operator()(const f32x4 (&acc)[2][2][4][2], const Unit& u, int wr, int wc, int fr, int fq) const {
        int row0 = u.pm * BM + wr * 64 + fr; asm volatile("" : "+v"(row0) :: "memory"); const int cw = wc * 32 + 4 * fq;
#pragma unroll
        for (int ai = 0; ai < 2; ++ai)
#pragma unroll
            for (int m = 0; m < 4; ++m) { __builtin_amdgcn_sched_barrier(0); bf16_t* rp = gt + (size_t)(row0 + ai * HALF + m * 16) * 3072 + u.pn * 256 + cw;
#pragma unroll
                for (int bj = 0; bj < 2; ++bj)
#pragma unroll
                    for (int n = 0; n < 2; ++n) { bf16_t* p = rp + bj * HALF + n * 16; const u32x2 g = *(const GAS u32x2*)p; const f32x4 a = acc[ai][bj][m][n];
                        f32x4 v; v[0] = a[0] * __uint_as_float(g.x << 16); v[1] = a[1] * __uint_as_float(g.x & 0xffff0000u); v[2] = a[2] * __uint_as_float(g.y << 16); v[3] = a[3] * __uint_as_float(g.y & 0xffff0000u);
                        st_bf4(p, v); } }
    }
};
struct EpiRes {
    float* x;
    __device__ __forceinline__ void operator()(const f32x4 (&acc)[2][2][4][2], const Unit& u, int wr, int wc, int fr, int fq) const {
        int row0 = u.pm * BM + wr * 64 + fr; asm volatile("" : "+v"(row0) :: "memory"); const int cw = wc * 32 + 4 * fq;
#pragma unroll
        for (int ai = 0; ai < 2; ++ai)
#pragma unroll
            for (int m = 0; m < 4; ++m) { __builtin_amdgcn_sched_barrier(0); float* rp = x + (size_t)(row0 + ai * HALF + m * 16) * 1024 + u.pn * 256 + cw;
#pragma unroll
                for (int bj = 0; bj < 2; ++bj)
#pragma unroll
                    for (int n = 0; n < 2; ++n) { float* p = rp + bj * HALF + n * 16; const f32x4 xv = *(const GAS f32x4*)p; *(GAS f32x4*)p = xv * DN_ALPHA + acc[ai][bj][m][n]; } }
    }
};
struct EpiF1 {
    bf16_t* hd;
    __device__ __forceinline__ void operator()(const f32x4 (&acc)[2][2][4][2], const Unit& u, int wr, int wc, int fr, int fq) const {
        int row0 = u.pm * BM + wr * 64 + fr; asm volatile("" : "+v"(row0) :: "memory"); const int cw = wc * 32 + 4 * fq;
#pragma unroll
        for (int ai = 0; ai < 2; ++ai)
#pragma unroll
            for (int m = 0; m < 4; ++m) { __builtin_amdgcn_sched_barrier(0); bf16_t* rp = hd + (size_t)(row0 + ai * HALF + m * 16) * DFF + u.pn * 128 + cw;
#pragma unroll
                for (int n = 0; n < 2; ++n) { const f32x4 g = acc[ai][0][m][n], uu = acc[ai][1][m][n]; f32x4 v;
#pragma unroll
                    for (int j = 0; j < 4; ++j) v[j] = g[j] * __builtin_amdgcn_rcpf(1.0f + __expf(-g[j])) * uu[j];
                    st_bf4(rp + n * 16, v); } }
    }
};

constexpr int SHM_V = 64 * 128 * 2, SHM_K = 64 * 128 * 2;
#define KSWZ(row, colB) ((row) * 256 + ((colB) ^ (((row) & 7) << 4)))
#define SBAR() __builtin_amdgcn_sched_barrier(0)
__device__ __forceinline__ int crow(int r, int hi) { return (r & 3) + 8 * (r >> 2) + 4 * hi; }
struct NaCtx { int vlo, vhi, wstart, qc, drow0; const LAS float* tab; };

template <int MODE>
__device__ __forceinline__ void partialSM(f32x16& p0, f32x16& p1, float& m_reg, float& mn, float& alpha, const NaCtx& na, int t, int hi) {
    constexpr float SCALE = MODE == 2 ? 0.10206207261596575f : 0.125f;
    constexpr float C = SCALE * 1.4426950408889634f;
    constexpr float THRS = 8.f / SCALE;
    if (MODE == 0) {
        const float NINF = -__builtin_inff();
        if (t < na.vlo || t >= na.vhi) {
#pragma unroll
            for (int r = 0; r < 16; ++r) { p0[r] = NINF; p1[r] = NINF; }
        } else {
            const LAS float* trow = na.tab + (na.drow0 + t) * 31 + (15 - na.qc);
#pragma unroll
            for (int q4 = 0; q4 < 4; ++q4) {
#pragma unroll
                for (int r = q4 * 4; r < q4 * 4 + 4; ++r) { const int kc = crow(r, hi); const bool ok0 = (unsigned)(kc - na.wstart) < 16u, ok1 = (unsigned)(kc + 32 - na.wstart) < 16u;
                    const float b0 = trow[ok0 ? kc : na.wstart], b1 = trow[ok1 ? kc + 32 : na.wstart];
                    p0[r] = ok0 ? p0[r] + b0 : NINF; p1[r] = ok1 ? p1[r] + b1 : NINF; }
                __builtin_amdgcn_sched_barrier(0); }
        }
    }
    float pmax = p0[0];
#pragma unroll
    for (int r = 1; r < 16; ++r) pmax = fmaxf(pmax, p0[r]);
#pragma unroll
    for (int r = 0; r < 16; ++r) pmax = fmaxf(pmax, p1[r]);
    { auto rr = __builtin_amdgcn_permlane32_swap(__float_as_uint(pmax), __float_as_uint(pmax), false, false);
      pmax = fmaxf(__uint_as_float(rr[0]), __uint_as_float(rr[1])); }
    if (__builtin_expect(__all(pmax - m_reg <= THRS), 1)) { mn = m_reg; alpha = 1.f; }
    else { mn = fmaxf(m_reg, pmax); alpha = __builtin_amdgcn_exp2f((m_reg - mn) * C); m_reg = mn; }
    const float mnC = -mn * C;
#pragma unroll
    for (int r = 0; r < 16; ++r) p0[r] = fmaf(p0[r], C, mnC);
#pragma unroll
    for (int r = 0; r < 16; ++r) p1[r] = fmaf(p1[r], C, mnC);
#pragma unroll
    for (int r = 0; r < 16; ++r) p0[r] = __builtin_amdgcn_exp2f(p0[r]);
}
__device__ __forceinline__ void finishSM(f32x16& p0, f32x16& p1, float alpha, float& l_reg, bf16x8& pa0, bf16x8& pa1, bf16x8& pa2, bf16x8& pa3) {
#pragma unroll
    for (int r = 0; r < 16; ++r) p1[r] = __builtin_amdgcn_exp2f(p1[r]);
    float ps = 0;
#pragma unroll
    for (int r = 0; r < 16; ++r) ps += p0[r];
#pragma unroll
    for (int r = 0; r < 16; ++r) ps += p1[r];
    { auto rr = __builtin_amdgcn_permlane32_swap(__float_as_uint(ps), __float_as_uint(ps), false, false);
      ps = __uint_as_float(rr[0]) + __uint_as_float(rr[1]); }
    l_reg = l_reg * alpha + ps;
#define PK4(P, BASE, OUT) do { unsigned a0 = cvtpk(P[BASE + 0], P[BASE + 1]), a1 = cvtpk(P[BASE + 2], P[BASE + 3]);   \
    unsigned b0 = cvtpk(P[BASE + 4], P[BASE + 5]), b1 = cvtpk(P[BASE + 6], P[BASE + 7]);                              \
    auto r0 = __builtin_amdgcn_permlane32_swap(a0, b0, false, false); auto r1 = __builtin_amdgcn_permlane32_swap(a1, b1, false, false); \
    u32x4 w = {r0[0], r1[0], r0[1], r1[1]}; OUT = *reinterpret_cast<bf16x8*>(&w); } while (0)
    PK4(p0, 0, pa0); PK4(p0, 8, pa1); PK4(p1, 0, pa2); PK4(p1, 8, pa3);
#undef PK4
}
template <int ND>
__device__ __forceinline__ void qkt(f32x16& p0, f32x16& p1, const char* Ks, const bf16x8* qr, int r32, int hi) {
    p0 = f32x16{}; p1 = f32x16{};
#pragma unroll
    for (int d0 = 0; d0 < ND; ++d0) { const int cb = (d0 * 16 + hi * 8) * 2;
        const bf16x8 b0 = *reinterpret_cast<const bf16x8*>(Ks + KSWZ(r32, cb));
        const bf16x8 b1 = *reinterpret_cast<const bf16x8*>(Ks + KSWZ(32 + r32, cb));
        p0 = __builtin_amdgcn_mfma_f32_32x32x16_bf16(b0, qr[d0], p0, 0, 0, 0);
        p1 = __builtin_amdgcn_mfma_f32_32x32x16_bf16(b1, qr[d0], p1, 0, 0, 0); }
}
__device__ __forceinline__ int v_st(int k, int c) { const int kk = (k & ~0xC) | ((k & 4) << 1) | ((k & 8) >> 1); return ((kk >> 3) * 4 + (c >> 5)) * 512 + ((kk & 7) * 32 + (c & 31)) * 2; }
__device__ __forceinline__ int v_rd_base(int lane) { return ((lane & 3) << 3) | (((lane >> 2) & 3) << 6) | (((lane >> 4) & 1) << 5) | (((lane >> 5) & 1) << 8); }
constexpr int v_rd_off(int d0, int ks, int half) { return d0 * 512 + ks * 4096 + half * 2048; }
template <int OFF> __device__ __forceinline__ s16x4 tr_read(int vb) {
    s16x4 r; asm volatile("ds_read_b64_tr_b16 %0, %1 offset:%2" : "=&v"(r) : "v"(vb), "i"(OFF) : "memory"); return r;
}
template <int D0> __device__ __forceinline__ void pv_one(f32x16& od, int vb, bf16x8 pa0, bf16x8 pa1, bf16x8 pa2, bf16x8 pa3) {
    const s16x4 l0 = tr_read<v_rd_off(D0, 0, 0)>(vb), h0 = tr_read<v_rd_off(D0, 0, 1)>(vb), l1 = tr_read<v_rd_off(D0, 1, 0)>(vb), h1 = tr_read<v_rd_off(D0, 1, 1)>(vb);
    const s16x4 l2 = tr_read<v_rd_off(D0, 2, 0)>(vb), h2 = tr_read<v_rd_off(D0, 2, 1)>(vb), l3 = tr_read<v_rd_off(D0, 3, 0)>(vb), h3 = tr_read<v_rd_off(D0, 3, 1)>(vb);
    asm volatile("s_waitcnt lgkmcnt(0)" ::: "memory"); SBAR();
#define PKV(L, H) (bf16x8){L[0], L[1], L[2], L[3], H[0], H[1], H[2], H[3]}
    od = __builtin_amdgcn_mfma_f32_32x32x16_bf16(pa0, PKV(l0, h0), od, 0, 0, 0);
    od = __builtin_amdgcn_mfma_f32_32x32x16_bf16(pa1, PKV(l1, h1), od, 0, 0, 0);
    od = __builtin_amdgcn_mfma_f32_32x32x16_bf16(pa2, PKV(l2, h2), od, 0, 0, 0);
    od = __builtin_amdgcn_mfma_f32_32x32x16_bf16(pa3, PKV(l3, h3), od, 0, 0, 0);
#undef PKV
}
template <int NO> __device__ __forceinline__ void pv_d0(f32x16* o, int vb, bf16x8 pa0, bf16x8 pa1, bf16x8 pa2, bf16x8 pa3) {
    pv_one<0>(o[0], vb, pa0, pa1, pa2, pa3); pv_one<1>(o[1], vb, pa0, pa1, pa2, pa3);
    if constexpr (NO == 4) { pv_one<2>(o[2], vb, pa0, pa1, pa2, pa3); pv_one<3>(o[3], vb, pa0, pa1, pa2, pa3); }
}

template <int DQ, int DV, int MODE, int ldq, int ldk, int ldk2, int ldv, int SD>
__device__ __forceinline__ void attn_core(const bf16_t* __restrict__ Qb, const bf16_t* __restrict__ K1, const bf16_t* __restrict__ K2,
                                          const bf16_t* __restrict__ Vh, int NT, char* lds, f32x16 (&o)[DV / 32], float (&rli)[16], const NaCtx& na) {
    constexpr int ND = DQ / 16, NO = DV / 32;
    const int tid = otid(), wid = tid >> 6, lane = tid & 63, r32 = lane & 31, hi = lane >> 5;
    char* V_lds = lds; char* K_lds = lds + 2 * SHM_V;
    float* ws = (float*)(lds + 2 * SHM_V + 2 * SHM_K) + wid * 64; float* li_l = ws; float* al_l = ws + 32;
    float m_reg = -1e30f, l_reg = 0;
#pragma unroll
    for (int d = 0; d < NO; ++d) o[d] = f32x16{};
    bf16x8 qr[ND];
    const bf16_t* Qw = Qb + (long)(wid * 32 + r32) * ldq + hi * 8;
#pragma unroll
    for (int d0 = 0; d0 < ND; ++d0) qr[d0] = *(const GAS bf16x8*)(Qw + d0 * 16);
    const int sr = tid >> 4, sc = (tid & 15) * 8, vst0 = v_st(sr, sc), vst1 = v_st(32 + sr, sc);
    const int vb0 = (int)(uintptr_t)V_lds + v_rd_base(lane);
    const bool ldV = sc < DV, ldK = sc < DQ;
    const bf16_t* kp; long kld;
    if (DQ > 64 && sc >= 64) { kp = K2 + (sc - 64); kld = ldk2; } else { kp = K1 + sc; kld = ldk; }
    const bf16_t* vp = Vh + sc;
    struct Slot { bf16x8 vs0, vs1, ks0, ks1; };
    Slot sA, sB; sA.vs0 = sA.vs1 = sA.ks0 = sA.ks1 = bf16x8{}; sB = sA;
    Slot& sO = (SD == 2) ? sB : sA;
#define SLOAD(S_, k0) do { if (ldV) { S_.vs0 = *(const GAS bf16x8*)(vp + (long)((k0) + sr) * ldv); S_.vs1 = *(const GAS bf16x8*)(vp + (long)((k0) + 32 + sr) * ldv); } \
    if (ldK) { S_.ks0 = *(const GAS bf16x8*)(kp + (long)((k0) + sr) * kld); S_.ks1 = *(const GAS bf16x8*)(kp + (long)((k0) + 32 + sr) * kld); } } while (0)
#define SWRITE(b, S_) do { if (ldV) { *(bf16x8*)(V_lds + (b) * SHM_V + vst0) = S_.vs0; *(bf16x8*)(V_lds + (b) * SHM_V + vst1) = S_.vs1; } \
    if (ldK) { const int kc = sc * 2; *(bf16x8*)(K_lds + (b) * SHM_K + KSWZ(sr, kc)) = S_.ks0; *(bf16x8*)(K_lds + (b) * SHM_K + KSWZ(32 + sr, kc)) = S_.ks1; } } while (0)
#define SWAIT() do { if (SD == 2) asm volatile("s_waitcnt vmcnt(4)" ::: "memory"); else asm volatile("s_waitcnt vmcnt(0)" ::: "memory"); } while (0)
#define RESC(a) do { if (__any((a) < 1.f)) { if (hi == 0) al_l[r32] = (a); asm volatile("s_waitcnt lgkmcnt(0)" ::: "memory"); \
    _Pragma("unroll") for (int d = 0; d < NO; ++d) _Pragma("unroll") for (int r = 0; r < 16; ++r) o[d][r] *= al_l[crow(r, hi)]; } } while (0)
    f32x16 pA0, pA1, pB0, pB1; float mnA, mnB, alA, alB; bf16x8 pa0, pa1, pa2, pa3;
    SLOAD(sA, 0); asm volatile("s_waitcnt vmcnt(0)" ::: "memory"); SWRITE(0, sA); __syncthreads();
    qkt<ND>(pA0, pA1, K_lds, qr, r32, hi); partialSM<MODE>(pA0, pA1, m_reg, mnA, alA, na, 0, hi);
    SLOAD(sO, 64); if (SD == 2 && 2 < NT) SLOAD(sA, 128);
    SWAIT(); SWRITE(1, sO); __syncthreads();
    for (int j = 1; j + 1 < NT; j += 2) {
        SBAR(); qkt<ND>(pB0, pB1, K_lds + SHM_K, qr, r32, hi);
        finishSM(pA0, pA1, alA, l_reg, pa0, pa1, pa2, pa3); SBAR();
        SLOAD(sO, (j + SD) * 64); SBAR();
        pv_d0<NO>(o, vb0, pa0, pa1, pa2, pa3); partialSM<MODE>(pB0, pB1, m_reg, mnB, alB, na, j, hi);
        __syncthreads(); SWAIT(); SWRITE(0, sA);
        RESC(alB); __syncthreads();
        SBAR(); qkt<ND>(pA0, pA1, K_lds, qr, r32, hi);
        finishSM(pB0, pB1, alB, l_reg, pa0, pa1, pa2, pa3); SBAR();
        if (SD == 1 || j + 3 < NT) SLOAD(sA, (j + 1 + SD) * 64); SBAR();
        pv_d0<NO>(o, vb0 + SHM_V, pa0, pa1, pa2, pa3); partialSM<MODE>(pA0, pA1, m_reg, mnA, alA, na, j + 1, hi);
        __syncthreads(); SWAIT(); SWRITE(1, sO);
        RESC(alA); __syncthreads();
    }
    SBAR(); qkt<ND>(pB0, pB1, K_lds + SHM_K, qr, r32, hi);
    finishSM(pA0, pA1, alA, l_reg, pa0, pa1, pa2, pa3); SBAR();
    pv_d0<NO>(o, vb0, pa0, pa1, pa2, pa3); partialSM<MODE>(pB0, pB1, m_reg, mnB, alB, na, NT - 1, hi);
    __syncthreads(); RESC(alB);
    finishSM(pB0, pB1, alB, l_reg, pa0, pa1, pa2, pa3); SBAR();
    pv_d0<NO>(o, vb0 + SHM_V, pa0, pa1, pa2, pa3);
    if (hi == 0) li_l[r32] = l_reg;
    asm volatile("s_waitcnt lgkmcnt(0)" ::: "memory");
#pragma unroll
    for (int r = 0; r < 16; ++r) rli[r] = __builtin_amdgcn_rcpf(li_l[crow(r, hi)]);
#undef SLOAD
#undef SWRITE
#undef SWAIT
#undef RESC
}

__device__ __forceinline__ void na_item(const Params& p, int l, int item, char* lds) {
    const int xcd = item & 7, slot = item >> 3;
    const int pair = xcd * 4 + (slot >> 4), rb = slot & 15, b = pair >> 3, h = pair & 7;
    bf16_t* pa = (bf16_t*)(p.ws + OFF_PA);
    const int r0 = rb * 4, lo = min(max(r0 - 4, 0), 52);
    const int tid = otid(), wid = tid >> 6, lane = tid & 63, r32 = lane & 31, hi = lane >> 5;
    LAS float* tab = (LAS float*)((LAS unsigned char*)(uintptr_t)(unsigned)(uintptr_t)lds + 130 * 1024);
    const float* rpb = p.in[5] + ((size_t)l * 8 + h) * 465;
    if (tid < 465) tab[tid] = ((const GAS float*)rpb)[tid] * 8.0f;
    NaCtx na; const int wu = __builtin_amdgcn_readfirstlane(wid); const int r = r0 + (wu >> 1), qc = 32 * (wu & 1) + r32, rs = min(max(r - 4, 0), 56);
    na.vlo = rs - lo; na.vhi = na.vlo + 8; na.wstart = min(max(qc - 8, 0), 48); na.qc = qc; na.drow0 = lo - r + 7; na.tab = tab;
    const size_t tb = (size_t)b * SEQ;
    bf16_t* Q = pa + (tb + (size_t)r0 * 64) * 1536 + h * 64;
    const bf16_t* K = pa + (tb + (size_t)lo * 64) * 1536 + 512 + h * 64;
    const bf16_t* V = K + 512;
    f32x16 o[2]; float rli[16];
    attn_core<64, 64, 0, 1536, 1536, 1536, 1536, 1>(Q, K, K, V, 12, lds, o, rli, na);
    bf16_t* Ow = Q + (size_t)(wid * 32) * 1536;
#pragma unroll
    for (int rr = 0; rr < 16; ++rr) { const int orow = crow(rr, hi);
#pragma unroll
        for (int d = 0; d < 2; ++d) { const float v = o[d][rr] * rli[rr]; ((GAS bf16_t*)Ow)[(size_t)orow * 1536 + d * 32 + r32] = (bf16_t)(cvtpk(v, v) & 0xffffu); } }
    __syncthreads();
}
__device__ __forceinline__ void diff_item(const Params& p, int l, int item, char* lds) {
    const int xcd = item & 7, slot = item >> 3;
    const int pair = xcd * 2 + (slot >> 4), qb = slot & 15, b = pair >> 2, h = pair & 3;
    bf16_t* pd = (bf16_t*)(p.ws + OFF_PD);
    const int tid = otid(), wid = tid >> 6, lane = tid & 63, r32 = lane & 31, hi = lane >> 5;
    const float* lv = p.in[6] + (size_t)l * 256;
    float s1 = 0.f, s2 = 0.f;
    for (int i = 0; i < 64; ++i) { s1 += ((const GAS float*)lv)[i] * ((const GAS float*)lv)[64 + i]; s2 += ((const GAS float*)lv)[128 + i] * ((const GAS float*)lv)[192 + i]; }
    const float lam_init = p.lam_init[l], lam = __expf(s1) - __expf(s2) + lam_init;
    const size_t tb = (size_t)b * SEQ;
    bf16_t* Q = pd + (tb + (size_t)qb * 256) * 1536 + h * 128;
    const bf16_t* K = pd + tb * 1536 + 512 + h * 128;
    const bf16_t* V = pd + tb * 1536 + 1024 + h * 128;
    NaCtx na{};
    unsigned short* stash = (unsigned short*)(lds + 66 * 1024) + (size_t)wid * 64 * 64 + lane;
    f32x16 o[4]; float rli[16];
    attn_core<64, 128, 1, 1536, 1536, 1536, 1536, 2>(Q, K, K, V, 64, lds, o, rli, na);
#pragma unroll
    for (int d = 0; d < 4; ++d)
#pragma unroll
        for (int rr = 0; rr < 16; ++rr) { const float v = o[d][rr] * rli[rr]; stash[(d * 16 + rr) * 64] = (unsigned short)(cvtpk(v, v) & 0xffffu); }
    __syncthreads();
    attn_core<64, 128, 1, 1536, 1536, 1536, 1536, 2>(Q + 64, K + 64, K, V, 64, lds, o, rli, na);
    const float* sg = p.in[7] + (size_t)l * 128;
    float gcol[4];
#pragma unroll
    for (int d = 0; d < 4; ++d) gcol[d] = ((const GAS float*)sg)[d * 32 + r32] * (1.0f - lam_init);
    bf16_t* Ow = Q + (size_t)(wid * 32) * 1536;
#pragma unroll
    for (int rr = 0; rr < 16; ++rr) {
        float v[4]; float ss = 0.f;
#pragma unroll
        for (int d = 0; d < 4; ++d) { v[d] = bf2f(stash[(d * 16 + rr) * 64]) - lam * (o[d][rr] * rli[rr]); ss += v[d] * v[d]; }
        ss += __shfl_xor(ss, 1); ss += __shfl_xor(ss, 2); ss += __shfl_xor(ss, 4); ss += __shfl_xor(ss, 8); ss += __shfl_xor(ss, 16);
        const float rn = rsqrtf(ss * (1.0f / 128.0f) + 1e-6f);
        const int orow = crow(rr, hi);
#pragma unroll
        for (int d = 0; d < 4; ++d) { const float y = v[d] * rn * gcol[d]; ((GAS bf16_t*)Ow)[(size_t)orow * 1536 + d * 32 + r32] = (bf16_t)(cvtpk(y, y) & 0xffffu); }
    }
    __syncthreads();
}
__device__ __forceinline__ void mla_item(const Params& p, int item, char* lds) {
    const int xcd = item & 7, slot = item >> 3;
    const int pair = xcd * 4 + (slot >> 4), qb = slot & 15, b = pair >> 3, h = pair & 7;
    const int tid = otid(), wid = tid >> 6, lane = tid & 63, r32 = lane & 31, hi = lane >> 5;
    bf16_t* mc = (bf16_t*)(p.ws + OFF_MC); const bf16_t* mq = (const bf16_t*)(p.ws + OFF_MQ); const bf16_t* mkv = (const bf16_t*)(p.ws + OFF_MKV);
    const size_t tb = (size_t)b * SEQ;
    const bf16_t* Q = mq + (tb + (size_t)qb * 256) * 768 + h * 96;
    const bf16_t* K1 = mkv + tb * 1024 + h * 128;
    const bf16_t* K2 = mc + tb * 768 + 640;
    const bf16_t* V = K1 + 64;
    NaCtx na{};
    f32x16 o[2]; float rli[16];
    attn_core<96, 64, 2, 768, 1024, 768, 1024, 2>(Q, K1, K2, V, 64, lds, o, rli, na);
    bf16_t* Ow = mc + (tb + (size_t)qb * 256 + wid * 32) * 768 + h * 64;
#pragma unroll
    for (int rr = 0; rr < 16; ++rr) { const int orow = crow(rr, hi);
#pragma unroll
        for (int d = 0; d < 2; ++d) { const float v = o[d][rr] * rli[rr]; ((GAS bf16_t*)Ow)[(size_t)orow * 768 + d * 32 + r32] = (bf16_t)(cvtpk(v, v) & 0xffffu); } }
    __syncthreads();
}

struct MapId { __device__ __forceinline__ int operator()(int n) const { return n; } };
struct MapIn { __device__ __forceinline__ int operator()(int n) const { return n < 3744 ? n : (n < 3840 ? -1 : n - 96); } };
struct MapF1 { __device__ __forceinline__ int operator()(int n) const { const int pt = n >> 8, r = n & 255; return r < 128 ? pt * 128 + r : DFF + pt * 128 + (r - 128); } };
template <class Map>
__device__ __forceinline__ void prep_w(const float* __restrict__ src, int Ks, int Ns, bf16_t* __restrict__ dst, int Nd, int Kd, const float* __restrict__ kscale, Map map, float* tile) {
    const int tid = otid(), tx = tid & 63, ty = tid >> 6, nk = Kd / 64, ntile = (Nd / 64) * nk;
    for (int t = blockIdx.x; t < ntile; t += gridDim.x) {
        const int n0 = (t / nk) * 64, k0 = (t % nk) * 64;
        const int ns = map(n0 + tx);
#pragma unroll
        for (int j = 0; j < 8; ++j) { const int kl = ty + 8 * j, ks = (k0 + kl) % Ks; float v = 0.f;
            if (ns >= 0) { v = ((const GAS float*)src)[(size_t)ks * Ns + ns]; if (kscale) v *= ((const GAS float*)kscale)[ks]; }
            tile[kl * 65 + tx] = v; }
        __syncthreads();
        const int kx = (tid & 31) * 2, ny = tid >> 5;
#pragma unroll
        for (int j = 0; j < 4; ++j) { const int nl = ny + 16 * j;
            *(GAS unsigned*)(dst + (size_t)(n0 + nl) * Kd + k0 + kx) = cvtpk(tile[kx * 65 + nl], tile[(kx + 1) * 65 + nl]); }
        __syncthreads();
    }
}
__device__ __forceinline__ void ln_rows(const float* src, float* dstf, bf16_t* dstb, const float* __restrict__ g, const float* __restrict__ bta, int row0, int nrows) {
    const int tid_ = otid(); const int lane = tid_ & 63, wv = blockIdx.x * 8 + (tid_ >> 6), nw = gridDim.x * 8;
    f32x4 gv[4], bv[4];
#pragma unroll
    for (int i = 0; i < 4; ++i) { gv[i] = *(const GAS f32x4*)(g + i * 256 + lane * 4); bv[i] = *(const GAS f32x4*)(bta + i * 256 + lane * 4); }
    for (int r = wv; r < nrows; r += nw) {
        const size_t ro = (size_t)(row0 + r) * 1024;
        f32x4 v[4]; float s = 0.f;
#pragma unroll
        for (int i = 0; i < 4; ++i) { v[i] = *(const GAS f32x4*)(src + ro + i * 256 + lane * 4); s += (v[i][0] + v[i][1]) + (v[i][2] + v[i][3]); }
#pragma unroll
        for (int k = 1; k < 64; k <<= 1) s += __shfl_xor(s, k);
        const float mu = s * (1.0f / 1024.0f); float q = 0.f;
#pragma unroll
        for (int i = 0; i < 4; ++i) { v[i] = v[i] - mu; q += (v[i][0] * v[i][0] + v[i][1] * v[i][1]) + (v[i][2] * v[i][2] + v[i][3] * v[i][3]); }
#pragma unroll
        for (int k = 1; k < 64; k <<= 1) q += __shfl_xor(q, k);
        const float rstd = rsqrtf(q * (1.0f / 1024.0f) + 1e-5f);
#pragma unroll
        for (int i = 0; i < 4; ++i) { const f32x4 y = v[i] * rstd * gv[i] + bv[i]; *(GAS f32x4*)(dstf + ro + i * 256 + lane * 4) = y;
            if (dstb) st_bf4(dstb + ro + i * 256 + lane * 4, y); }
    }
}

#ifndef PHMASK
#define PHMASK 0xffff
#endif
#define WSP(T_, off) ((T_*)(wsb + (off)))
__device__ __forceinline__ void gsync(cg::grid_group& g) { asm volatile("s_waitcnt vmcnt(0)" ::: "memory"); g.sync(); __builtin_amdgcn_fence(__ATOMIC_ACQUIRE, "agent"); }
__global__ __launch_bounds__(512, 2) void fwd_megakernel(Params p) {
    extern __shared__ __attribute__((aligned(16))) unsigned char shm[];
    cg::grid_group grid = cg::this_grid();
    LAS unsigned char* ldsg = (LAS unsigned char*)shm;
    char* lds = (char*)shm;
    if (PHMASK & 512) {
        unsigned char* wsb = p.ws;
        float* tile = (float*)shm;
        for (int l = 0; l < DEPTH; ++l) {
            prep_w(p.in[3] + (size_t)l * 1024 * 6816, 1024, 6816, WSP(bf16_t, OFF_WIN) + (size_t)l * NIN * 1024, NIN, 1024, nullptr, MapIn(), tile);
            prep_w(p.in[10] + (size_t)l * 384 * 768, 384, 768, WSP(bf16_t, OFF_WQB) + (size_t)l * 768 * 384, 768, 384, p.in[8] + l * 384, MapId(), tile);
            prep_w(p.in[11] + (size_t)l * 256 * 1024, 256, 1024, WSP(bf16_t, OFF_WKVB) + (size_t)l * 1024 * 256, 1024, 256, p.in[9] + l * 256, MapId(), tile);
            for (int i = 0; i < 3; ++i)
                prep_w(p.in[12] + ((size_t)l * 3 + i) * 512 * 1024, 512, 1024, WSP(bf16_t, OFF_WBR) + ((size_t)l * 3 + i) * 1024 * 512, 1024, 512, nullptr, MapId(), tile);
            prep_w(p.in[13] + (size_t)l * 1024 * 1024, 1024, 1024, WSP(bf16_t, OFF_WOUT) + (size_t)l * 1024 * 3072, 1024, 3072, nullptr, MapId(), tile);
            prep_w(p.in[16] + (size_t)l * 1024 * 5632, 1024, 5632, WSP(bf16_t, OFF_WF1) + (size_t)l * 5632 * 1024, 5632, 1024, nullptr, MapF1(), tile);
            prep_w(p.in[17] + (size_t)l * 2816 * 1024, 2816, 1024, WSP(bf16_t, OFF_WF2) + (size_t)l * 1024 * 2816, 1024, 2816, nullptr, MapId(), tile);
        }
        const int gtid = blockIdx.x * 512 + otid(), gn = gridDim.x * 512;
        const float nlt = -13.122363377404328f;
        float* cd = WSP(float, OFF_TD); float* sd = cd + SEQ * 8; float* cm = WSP(float, OFF_TM); float* sm = cm + SEQ * 16;
        for (int i = gtid; i < SEQ * 8; i += gn) { const int pos = i >> 3, f = i & 7; const float inv = expf(nlt * (float)f / 8.0f), ang = (float)pos * inv; ((GAS float*)cd)[i] = cosf(ang); ((GAS float*)sd)[i] = sinf(ang); }
        for (int i = gtid; i < SEQ * 16; i += gn) { const int pos = i >> 4, f = i & 15; const float inv = expf(nlt * (float)f / 16.0f), ang = (float)pos * inv; ((GAS float*)cm)[i] = cosf(ang); ((GAS float*)sm)[i] = sinf(ang); }
        ln_rows(p.in[0], p.out, WSP(bf16_t, OFF_XB), p.in[1], p.in[2], 0, T_ALL);
    }
    gsync(grid);
    for (int step = 0; step < DEPTH * 14; ++step) {
        const int l = step / 14, ls = step % 14, ck = ls < 5 ? 0 : 1, ph = ls < 10 ? ls % 5 : ls - 5;
        const size_t tok0 = ls < 10 ? (size_t)ck * TC : 0;
        const int mrows = ls < 10 ? TC : T_ALL;
        unsigned wlo_ = (unsigned)(uintptr_t)p.ws, whi_ = (unsigned)((uintptr_t)p.ws >> 32); asm volatile("" : "+v"(wlo_), "+v"(whi_));
        unsigned char* wsb = (unsigned char*)(((uintptr_t)(unsigned)__builtin_amdgcn_readfirstlane((int)whi_) << 32) | (uintptr_t)(unsigned)__builtin_amdgcn_readfirstlane((int)wlo_));
        switch (ph) {
        case 0: if (PHMASK & 1) {
            float* cd = WSP(float, OFF_TD); float* cm = WSP(float, OFF_TM);
            EpiIn E{WSP(bf16_t, OFF_PA), WSP(bf16_t, OFF_PD), WSP(bf16_t, OFF_MC), WSP(bf16_t, OFF_GT), WSP(float, OFF_SSQ), p.in[4] + (size_t)l * 3072, cd, cd + SEQ * 8, cm, cm + SEQ * 16};
            gemm_phase(ldsg, WSP(bf16_t, OFF_XB) + tok0 * 1024, 1024, WSP(bf16_t, OFF_WIN) + (size_t)l * NIN * 1024, 1024, TC, NIN, 1024, E);
        } break;
        case 1: if (PHMASK & 2) {
            if (PHMASK & 1024) { EpiKV E{WSP(bf16_t, OFF_MKV), WSP(float, OFF_SSQ)}; gemm_phase(ldsg, WSP(bf16_t, OFF_MC) + 384, 768, WSP(bf16_t, OFF_WKVB) + (size_t)l * 1024 * 256, 256, TC, 1024, 256, E); }
            if (PHMASK & 2048) { float* cm = WSP(float, OFF_TM); EpiQ E{WSP(bf16_t, OFF_MQ), WSP(float, OFF_SSQ), cm, cm + SEQ * 16}; gemm_phase(ldsg, WSP(bf16_t, OFF_MC), 768, WSP(bf16_t, OFF_WQB) + (size_t)l * 768 * 384, 384, TC, 768, 384, E); }
            __syncthreads();
            if (PHMASK & 4096) for (int it = blockIdx.x; it < 512; it += gridDim.x) na_item(p, l, it, lds);
        } break;
        case 2: if (PHMASK & 4) {
            if (PHMASK & 8192) for (int it = blockIdx.x; it < 256; it += gridDim.x) diff_item(p, l, it, lds);
            if (PHMASK & 16384) for (int it = blockIdx.x; it < 512; it += gridDim.x) mla_item(p, it, lds);
        } break;
        case 3: if (PHMASK & 8) {
            for (int i = 0; i < 3; ++i) {
                const bf16_t* A = i == 0 ? WSP(bf16_t, OFF_PA) : (i == 1 ? WSP(bf16_t, OFF_PD) : WSP(bf16_t, OFF_MC)); const int lda = i == 2 ? 768 : 1536;
                EpiBr E{WSP(bf16_t, OFF_GT) + i * 1024};
                gemm_phase(ldsg, A, lda, WSP(bf16_t, OFF_WBR) + ((size_t)l * 3 + i) * 1024 * 512, 512, TC, 1024, 512, E);
            }
        } break;
        case 4: case 7: if (PHMASK & 16) {
            EpiRes E{p.out + tok0 * 1024};
            const bf16_t* A = ph == 4 ? WSP(bf16_t, OFF_GT) : WSP(bf16_t, OFF_PA); const int kk = ph == 4 ? 3072 : DFF;
            const bf16_t* B = ph == 4 ? WSP(bf16_t, OFF_WOUT) + (size_t)l * 1024 * 3072 : WSP(bf16_t, OFF_WF2) + (size_t)l * 1024 * DFF;
            gemm_phase(ldsg, A, kk, B, kk, mrows, 1024, kk, E);
        } break;
        case 5: case 8: if (PHMASK & 32) {
            const float* g = ph == 5 ? p.in[14] : p.in[18]; const float* bb = ph == 5 ? p.in[15] : p.in[19];
            ln_rows(p.out, p.out, WSP(bf16_t, OFF_XB), g + l * 1024, bb + l * 1024, (int)tok0, mrows);
        } break;
        case 6: if (PHMASK & 64) {
            EpiF1 E{WSP(bf16_t, OFF_PA)};
            gemm_phase(ldsg, WSP(bf16_t, OFF_XB) + tok0 * 1024, 1024, WSP(bf16_t, OFF_WF1) + (size_t)l * 5632 * 1024, 1024, mrows, 5632, 1024, E);
        } break;
        }
        gsync(grid);
    }
}

extern "C" void kernel_launch(void* const* d_in, const int* in_sizes, int n_in, void* d_out, int out_size, void* d_ws, size_t ws_size, hipStream_t stream) {
    static int grid = 0;
    if (grid == 0) {
        if (n_in != 20 || in_sizes[0] != T_ALL * DM || out_size != T_ALL * DM || ws_size < WS_END) {
            fprintf(stderr, "kernel_launch: unexpected shapes / workspace (n_in %d, ws %zu, need %zu)\n", n_in, ws_size, (size_t)WS_END); grid = -1; return; }
        int dev = 0, cus = 0, per_cu = 0;
        hipGetDevice(&dev); hipDeviceGetAttribute(&cus, hipDeviceAttributeMultiprocessorCount, dev);
        if (hipFuncSetAttribute((const void*)fwd_megakernel, hipFuncAttributeMaxDynamicSharedMemorySize, LDS_BYTES) != hipSuccess) { fprintf(stderr, "kernel_launch: hipFuncSetAttribute failed\n"); grid = -1; return; }
        if (hipOccupancyMaxActiveBlocksPerMultiprocessor(&per_cu, (const void*)fwd_megakernel, 512, LDS_BYTES) != hipSuccess || per_cu < 1) { fprintf(stderr, "kernel_launch: occupancy query gave %d\n", per_cu); per_cu = 1; }
        (void)hipGetLastError();
        grid = cus;
    }
    if (grid < 0) return;
    Params p{};
    for (int i = 0; i < 20; ++i) p.in[i] = (const float*)d_in[i];
    p.out = (float*)d_out; p.ws = (unsigned char*)d_ws;
    for (int l = 0; l < 4; ++l) p.lam_init[l] = (float)(0.8 - 0.6 * exp(-0.3 * (double)l));
    void* args[] = {&p};
    hipError_t e = hipLaunchCooperativeKernel((const void*)fwd_megakernel, dim3(grid), dim3(512), args, LDS_BYTES, stream);
    if (e != hipSuccess) fprintf(stderr, "kernel_launch: cooperative launch failed: %s (grid %d)\n", hipGetErrorString(e), grid);
}
```

```cpp
#include <hip/hip_runtime.h>
#include <hip/hip_cooperative_groups.h>
#include <cstdio>
#include <cstdint>
namespace cg = cooperative_groups;

#define LAS __attribute__((address_space(3)))
#define GAS __attribute__((address_space(1)))
typedef unsigned short bf16_t;
typedef short bf16x8 __attribute__((ext_vector_type(8)));
typedef short s16x4 __attribute__((ext_vector_type(4)));
typedef float f32x4 __attribute__((ext_vector_type(4)));
typedef float f32x16 __attribute__((ext_vector_type(16)));
typedef unsigned u32x4 __attribute__((ext_vector_type(4)));
typedef unsigned u32x2 __attribute__((ext_vector_type(2)));

constexpr int T_ALL = 32768, TC = 16384, DM = 1024, SEQ = 4096, NIN = 6912, DFF = 2816, DEPTH = 4, NCHUNK = 2;
constexpr size_t SZ_WIN = (size_t)DEPTH * NIN * 1024 * 2, SZ_WQB = (size_t)DEPTH * 768 * 384 * 2, SZ_WKVB = (size_t)DEPTH * 1024 * 256 * 2,
                 SZ_WBR = (size_t)DEPTH * 3 * 1024 * 512 * 2, SZ_WOUT = (size_t)DEPTH * 1024 * 3072 * 2, SZ_WF1 = (size_t)DEPTH * 5632 * 1024 * 2,
                 SZ_WF2 = (size_t)DEPTH * 1024 * 2816 * 2, SZ_XB = (size_t)T_ALL * 1024 * 2, SZ_PA = (size_t)TC * 1536 * 2, SZ_PD = SZ_PA,
                 SZ_MC = (size_t)TC * 768 * 2, SZ_GT = (size_t)TC * 3072 * 2, SZ_MQ = (size_t)TC * 768 * 2, SZ_MKV = (size_t)TC * 1024 * 2,
                 SZ_SSQ = (size_t)TC * 24 * 4, SZ_TD = (size_t)SEQ * 8 * 4 * 2, SZ_TM = (size_t)SEQ * 16 * 4 * 2;
constexpr size_t OFF_WIN = 0, OFF_WQB = OFF_WIN + SZ_WIN, OFF_WKVB = OFF_WQB + SZ_WQB, OFF_WBR = OFF_WKVB + SZ_WKVB, OFF_WOUT = OFF_WBR + SZ_WBR,
                 OFF_WF1 = OFF_WOUT + SZ_WOUT, OFF_WF2 = OFF_WF1 + SZ_WF1, OFF_XB = OFF_WF2 + SZ_WF2, OFF_PA = OFF_XB + SZ_XB, OFF_PD = OFF_PA + SZ_PA,
                 OFF_MC = OFF_PD + SZ_PD, OFF_GT = OFF_MC + SZ_MC, OFF_MQ = OFF_GT + SZ_GT, OFF_MKV = OFF_MQ + SZ_MQ, OFF_SSQ = OFF_MKV + SZ_MKV,
                 OFF_TD = OFF_SSQ + SZ_SSQ, OFF_TM = OFF_TD + SZ_TD, WS_END = OFF_TM + SZ_TM;
constexpr int LDS_BYTES = 132 * 1024;
static_assert((size_t)T_ALL * DFF * 2 <= SZ_PA + SZ_PD + SZ_MC + SZ_GT, "SwiGLU hidden of all tokens aliases projA|projD|mla_c|gates");
constexpr float DN_ALPHA = 1.681792830507429f;

struct Params { const float* in[20]; float* out; unsigned char* ws; float lam_init[4]; };

typedef __bf16 bf2_t __attribute__((ext_vector_type(2)));
typedef float f32x2 __attribute__((ext_vector_type(2)));
__device__ __forceinline__ unsigned cvtpk(float lo, float hi) { f32x2 v = {lo, hi}; bf2_t b = __builtin_convertvector(v, bf2_t); return __builtin_bit_cast(unsigned, b); }
__device__ __forceinline__ int otid() { int t = threadIdx.x; asm volatile("" : "+v"(t)); return t; }
__device__ __forceinline__ float bf2f(unsigned short b) { return __uint_as_float(((unsigned)b) << 16); }
__device__ __forceinline__ void st_bf4(bf16_t* p, f32x4 v) { u32x2 w; w.x = cvtpk(v[0], v[1]); w.y = cvtpk(v[2], v[3]); *(GAS u32x2*)p = w; }

constexpr int BM = 256, BK = 64, HALF = 128, HTB = HALF * BK * 2, NXCD = 8, WGM = 8;
__device__ __forceinline__ int lds_byte(int r, int c) { const int st = (r >> 4) * 2 + (c >> 5), rr = r & 15, cc = c & 31, ob = rr * 64 + cc * 2; return st * 1024 + (ob ^ (((ob >> 9) & 1) << 5)); }
__device__ __forceinline__ void stage_rc(int b, int& R, int& C) { const int st = b / 1024, sb = b % 1024, swz = sb ^ (((sb >> 9) & 1) << 5); R = (st >> 1) * 16 + swz / 64; C = (st & 1) * 32 + (swz % 64) / 2; }
struct Unit { int pm, pn; };
struct StaticOrder {
    int nM, nN, nwg, G, c;
    __device__ void init(int M, int N, int G_, int c_) { nM = M / BM; nN = N / BM; nwg = nM * nN; G = G_; c = c_; }
    __device__ bool next(int i, Unit& u) const {
        const long L = (long)i * G + c; if (L >= nwg) return false;
        int wgid = (int)L; { const int q = nwg / NXCD, r = nwg % NXCD, xcd = wgid % NXCD, off = wgid / NXCD; wgid = (xcd < r ? xcd * (q + 1) : r * (q + 1) + (xcd - r) * q) + off; }
        const int nig = WGM * nN, gid = wgid / nig, fm = gid * WGM, gsz = (nM - fm) < WGM ? (nM - fm) : WGM;
        u.pm = __builtin_amdgcn_readfirstlane(fm + ((wgid % nig) % gsz)); u.pn = __builtin_amdgcn_readfirstlane((wgid % nig) / gsz); return true;
    }
};

template <class Epi>
__device__ __forceinline__ void gemm_phase(LAS unsigned char* lds, const bf16_t* A, int lda, const bf16_t* Bt, int ldb, int M, int N, int K, const Epi& E) {
    const int tid = otid(), wid = __builtin_amdgcn_readfirstlane(tid >> 6), lane = tid & 63, wr = wid >> 2, wc = wid & 3, fr = lane & 15, fq = lane >> 4;
    int ntv_ = K / BK; asm volatile("" : "+v"(ntv_)); const int nt = __builtin_amdgcn_readfirstlane(ntv_);
    StaticOrder S; S.init(M, N, (int)gridDim.x, (int)blockIdx.x);
    unsigned voffA[2], voffB[2];
#pragma unroll
    for (int i = 0; i < 2; ++i) { int R, C; stage_rc(tid * 16 + i * 8192, R, C); voffA[i] = (unsigned)(R * lda + C) * 2u; voffB[i] = (unsigned)(R * ldb + C) * 2u; }
    const size_t kstep = (size_t)(BK * 2);
    const size_t hstepA = (size_t)HALF * lda * 2, tstepA = 2 * hstepA, hstepB = (size_t)HALF * ldb * 2, tstepB = 2 * hstepB;
    const unsigned ldsw = (unsigned)wid * 1024u;
    const int aoff = lds_byte(wr * 64 + fr, fq * 8), boff = lds_byte(wc * 32 + fr, fq * 8);
#define PG8_SA(b, h) (((b) * 2 + (h)) * HTB)
#define PG8_SB(b, h) ((4 + (b) * 2 + (h)) * HTB)
#define PG8_STAGE(bufoff, gbase, voff) do { _Pragma("unroll") for (int _i = 0; _i < 2; ++_i) \
        __builtin_amdgcn_global_load_lds((const unsigned*)((const char*)(gbase) + (voff)[_i]), (LAS unsigned*)(lds + (bufoff) + ldsw + _i * 8192), 16, 0, 0); } while (0)
#define PG8_LDA(dst, b, h) do { _Pragma("unroll") for (int m = 0; m < 4; ++m) _Pragma("unroll") for (int k = 0; k < 2; ++k) dst[m][k] = *(const LAS bf16x8*)(lds + PG8_SA(b, h) + aoff + m * 2048 + k * 1024); } while (0)
#define PG8_LDB(dst, b, h) do { _Pragma("unroll") for (int n = 0; n < 2; ++n) _Pragma("unroll") for (int k = 0; k < 2; ++k) dst[n][k] = *(const LAS bf16x8*)(lds + PG8_SB(b, h) + boff + n * 2048 + k * 1024); } while (0)
#define PG8_MMA(ai, bj, At, Bt_) do { __builtin_amdgcn_s_setprio(1); _Pragma("unroll") for (int m = 0; m < 4; ++m) _Pragma("unroll") for (int n = 0; n < 2; ++n) _Pragma("unroll") for (int k = 0; k < 2; ++k) \
        acc[ai][bj][m][n] = __builtin_amdgcn_mfma_f32_16x16x32_bf16(Bt_[n][k], At[m][k], acc[ai][bj][m][n], 0, 0, 0); __builtin_amdgcn_s_setprio(0); } while (0)
#define PG8_WAIT_V(n) asm volatile("s_waitcnt vmcnt(" #n ")" ::: "memory")
#define PG8_WAIT_L(n) asm volatile("s_waitcnt lgkmcnt(" #n ")" ::: "memory")
#define PG8_BAR __builtin_amdgcn_s_barrier()
#define PG8_SCHED __builtin_amdgcn_sched_barrier(0)
    Unit cur, nxt; int ui = 0;
    if (!S.next(0, cur)) return;
    f32x4 acc[2][2][4][2];
#pragma unroll
    for (int a = 0; a < 2; ++a)
#pragma unroll
        for (int b = 0; b < 2; ++b)
#pragma unroll
            for (int m = 0; m < 4; ++m)
#pragma unroll
                for (int n = 0; n < 2; ++n) acc[a][b][m][n] = (f32x4){0.f, 0.f, 0.f, 0.f};
    bf16x8 At[4][2], B0[2][2], B1[2][2];
    const char* cA = (const char*)A + (size_t)cur.pm * tstepA; const char* cB = (const char*)Bt + (size_t)cur.pn * tstepB;
    PG8_STAGE(PG8_SB(0, 0), cB, voffB); PG8_STAGE(PG8_SA(0, 0), cA, voffA); PG8_STAGE(PG8_SB(0, 1), cB + hstepB, voffB); PG8_STAGE(PG8_SA(0, 1), cA + hstepA, voffA);
    if (wr == 1) PG8_BAR;
    PG8_WAIT_V(4); PG8_BAR;
    PG8_STAGE(PG8_SB(1, 0), cB + kstep, voffB); PG8_STAGE(PG8_SA(1, 0), cA + kstep, voffA); PG8_STAGE(PG8_SB(1, 1), cB + hstepB + kstep, voffB);
    PG8_WAIT_V(6); PG8_BAR;
    for (;;) {
        const bool has_next = S.next(ui + 1, nxt);
        const char* nA = has_next ? (const char*)A + (size_t)nxt.pm * tstepA : cA; const char* nB = has_next ? (const char*)Bt + (size_t)nxt.pn * tstepB : cB;
#pragma unroll 1
        for (int t = 0; t < nt; t += 2) {
            const bool last = (t == nt - 2);
            const char* a1 = cA + (size_t)(t + 1) * kstep;
            const char* a2 = last ? nA : cA + (size_t)(t + 2) * kstep; const char* b2 = last ? nB : cB + (size_t)(t + 2) * kstep;
            const char* a3 = a2 + kstep; const char* b3 = b2 + kstep;
            PG8_LDB(B0, 0, 0); PG8_SCHED; PG8_LDA(At, 0, 0); PG8_STAGE(PG8_SA(1, 1), a1 + hstepA, voffA);
            PG8_WAIT_L(8); PG8_BAR; PG8_WAIT_L(0); PG8_MMA(0, 0, At, B0); PG8_BAR; PG8_SCHED;
            PG8_LDB(B1, 0, 1); PG8_STAGE(PG8_SB(0, 0), b2, voffB);
            PG8_BAR; PG8_WAIT_L(0); PG8_MMA(0, 1, At, B1); PG8_BAR;
            PG8_LDA(At, 0, 1); PG8_STAGE(PG8_SA(0, 0), a2, voffA);
            PG8_BAR; PG8_WAIT_L(0); PG8_MMA(1, 0, At, B0); PG8_BAR; PG8_SCHED;
            PG8_STAGE(PG8_SB(0, 1), b2 + hstepB, voffB);
            PG8_WAIT_V(6); PG8_BAR; PG8_MMA(1, 1, At, B1); PG8_BAR;
            PG8_LDB(B0, 1, 0); PG8_SCHED; PG8_LDA(At, 1, 0); PG8_STAGE(PG8_SA(0, 1), a2 + hstepA, voffA);
            PG8_WAIT_L(8); PG8_BAR; PG8_WAIT_L(0); PG8_MMA(0, 0, At, B0); PG8_BAR; PG8_SCHED;
            PG8_LDB(B1, 1, 1); PG8_STAGE(PG8_SB(1, 0), b3, voffB);
            PG8_BAR; PG8_WAIT_L(0); PG8_MMA(0, 1, At, B1); PG8_BAR;
            PG8_LDA(At, 1, 1); PG8_STAGE(PG8_SA(1, 0), a3, voffA);
            PG8_BAR; PG8_WAIT_L(0); PG8_MMA(1, 0, At, B0); PG8_BAR; PG8_SCHED;
            PG8_STAGE(PG8_SB(1, 1), b3 + hstepB, voffB);
            PG8_WAIT_V(6); PG8_BAR; PG8_MMA(1, 1, At, B1); PG8_BAR;
        }
        E(acc, cur, wr, wc, fr, fq);
        if (!has_next) break;
#pragma unroll
        for (int a = 0; a < 2; ++a)
#pragma unroll
            for (int b = 0; b < 2; ++b)
#pragma unroll
                for (int m = 0; m < 4; ++m)
#pragma unroll
                    for (int n = 0; n < 2; ++n) acc[a][b][m][n] = (f32x4){0.f, 0.f, 0.f, 0.f};
        cur = nxt; cA = nA; cB = nB; ++ui;
    }
    PG8_WAIT_V(0);
    if (wr == 0) PG8_BAR;
    PG8_BAR;
#undef PG8_SA
#undef PG8_SB
#undef PG8_STAGE
#undef PG8_LDA
#undef PG8_LDB
#undef PG8_MMA
#undef PG8_WAIT_V
#undef PG8_WAIT_L
#undef PG8_BAR
#undef PG8_SCHED
}

struct EpiIn {
    bf16_t *pa, *pd, *mc, *gt; float* ssq; const float* bg; const float *cd, *sd, *cm, *sm;
    __device__ __forceinline__ void operator()(const f32x4 (&acc)[2][2][4][2], const Unit& u, int wr, int wc, int fr, int fq) const {
        int row0 = u.pm * BM + wr * 64 + fr; asm volatile("" : "+v"(row0) :: "memory"); const int pn = u.pn, cw = wc * 32 + 4 * fq;
        if (pn < 6) {
#pragma unroll
            for (int ai = 0; ai < 2; ++ai)
#pragma unroll
                for (int m = 0; m < 4; ++m) { __builtin_amdgcn_sched_barrier(0); bf16_t* rp = pa + (size_t)(row0 + ai * HALF + m * 16) * 1536 + pn * 256 + cw;
#pragma unroll
                    for (int bj = 0; bj < 2; ++bj)
#pragma unroll
                        for (int n = 0; n < 2; ++n) st_bf4(rp + bj * HALF + n * 16, acc[ai][bj][m][n]); }
        } else if (pn < 12) {
            const bool rope = (pn < 10) && !(wc & 1);
#pragma unroll
            for (int ai = 0; ai < 2; ++ai)
#pragma unroll
                for (int m = 0; m < 4; ++m) { __builtin_amdgcn_sched_barrier(0); const int row = row0 + ai * HALF + m * 16; bf16_t* rp = pd + (size_t)row * 1536 + (pn - 6) * 256 + cw;
                    f32x4 c4 = {1.f, 1.f, 1.f, 1.f}, s4 = {0.f, 0.f, 0.f, 0.f};
                    if (rope) { const int pos = row & (SEQ - 1); c4 = *(const GAS f32x4*)(cd + pos * 8 + (fq & 1) * 4); s4 = *(const GAS f32x4*)(sd + pos * 8 + (fq & 1) * 4); }
#pragma unroll
                    for (int bj = 0; bj < 2; ++bj) { f32x4 v0 = acc[ai][bj][m][0];
                        if (rope) { f32x4 pr;
#pragma unroll
                            for (int j = 0; j < 4; ++j) pr[j] = __shfl_xor(v0[j], 32);
                            v0 = (fq < 2) ? (v0 * c4 - pr * s4) : (v0 * c4 + pr * s4); }
                        st_bf4(rp + bj * HALF, v0); st_bf4(rp + bj * HALF + 16, acc[ai][bj][m][1]); } }
        } else if (pn < 15) {
            const int t = pn - 12;
#pragma unroll
            for (int ai = 0; ai < 2; ++ai)
#pragma unroll
                for (int m = 0; m < 4; ++m) { __builtin_amdgcn_sched_barrier(0); const int row = row0 + ai * HALF + m * 16; bf16_t* rp = mc + (size_t)row * 768 + t * 256 + cw;
#pragma unroll
                    for (int bj = 0; bj < 2; ++bj) { f32x4 v0 = acc[ai][bj][m][0], v1 = acc[ai][bj][m][1];
                        float s = (v0[0] * v0[0] + v0[1] * v0[1]) + (v0[2] * v0[2] + v0[3] * v0[3]) + (v1[0] * v1[0] + v1[1] * v1[1]) + (v1[2] * v1[2] + v1[3] * v1[3]);
                        s += __shfl_xor(s, 16); s += __shfl_xor(s, 32);
                        if (fq == 0) *(GAS float*)(ssq + (size_t)row * 24 + t * 8 + bj * 4 + wc) = s;
                        if (t == 2 && bj == 1 && wc == 0) { const int pos = row & (SEQ - 1); const f32x4 c4 = *(const GAS f32x4*)(cm + pos * 16 + fq * 4), s4 = *(const GAS f32x4*)(sm + pos * 16 + fq * 4);
                            const f32x4 n0 = v0 * c4 - v1 * s4, n1 = v1 * c4 + v0 * s4; v0 = n0; v1 = n1; }
                        st_bf4(rp + bj * HALF, v0); st_bf4(rp + bj * HALF + 16, v1); } }
        } else {
            const int t = pn - 15;
            f32x4 bv[2][2];
#pragma unroll
            for (int bj = 0; bj < 2; ++bj)
#pragma unroll
                for (int n = 0; n < 2; ++n) bv[bj][n] = *(const GAS f32x4*)(bg + t * 256 + bj * HALF + n * 16 + cw);
#pragma unroll
            for (int ai = 0; ai < 2; ++ai)
#pragma unroll
                for (int m = 0; m < 4; ++m) { __builtin_amdgcn_sched_barrier(0); bf16_t* rp = gt + (size_t)(row0 + ai * HALF + m * 16) * 3072 + t * 256 + cw;
#pragma unroll
                    for (int bj = 0; bj < 2; ++bj)
#pragma unroll
                        for (int n = 0; n < 2; ++n) { f32x4 v = acc[ai][bj][m][n] + bv[bj][n];
#pragma unroll
                            for (int j = 0; j < 4; ++j) v[j] = __builtin_amdgcn_rcpf(1.0f + __expf(-v[j]));
                            st_bf4(rp + bj * HALF + n * 16, v); } }
        }
    }
};
struct EpiQ {
    bf16_t* mq; const float* ssq; const float *cm, *sm;
    __device__ __forceinline__ void operator()(const f32x4 (&acc)[2][2][4][2], const Unit& u, int wr, int wc, int fr, int fq) const {
        int row0 = u.pm * BM + wr * 64 + fr; asm volatile("" : "+v"(row0) :: "memory"); const int cw = wc * 32 + 4 * fq;
        float rr8[8];
#pragma unroll
        for (int i = 0; i < 8; ++i) { const float* sp = ssq + (size_t)(row0 + (i >> 2) * HALF + (i & 3) * 16) * 24 + fq * 4;
            const f32x4 a = *(const GAS f32x4*)sp;
            float ss = fq < 3 ? ((a[0] + a[1]) + (a[2] + a[3])) : 0.f;
            ss += __shfl_xor(ss, 16); ss += __shfl_xor(ss, 32);
            rr8[i] = rsqrtf(ss * (1.0f / 384.0f) + 1e-6f); }
#pragma unroll
        for (int ai = 0; ai < 2; ++ai)
#pragma unroll
            for (int m = 0; m < 4; ++m) { __builtin_amdgcn_sched_barrier(0); const int row = row0 + ai * HALF + m * 16; const float r = rr8[ai * 4 + m];
                bf16_t* rp = mq + (size_t)row * 768 + u.pn * 256 + cw;
#pragma unroll
                for (int bj = 0; bj < 2; ++bj) { const int G = u.pn * 8 + bj * 4 + wc; f32x4 v0 = acc[ai][bj][m][0] * r, v1 = acc[ai][bj][m][1] * r;
                    if (G % 3 == 2) { const int pos = row & (SEQ - 1); const f32x4 c4 = *(const GAS f32x4*)(cm + pos * 16 + fq * 4), s4 = *(const GAS f32x4*)(sm + pos * 16 + fq * 4);
                        const f32x4 n0 = v0 * c4 - v1 * s4, n1 = v1 * c4 + v0 * s4; v0 = n0; v1 = n1; }
                    st_bf4(rp + bj * HALF, v0); st_bf4(rp + bj * HALF + 16, v1); } }
    }
};
struct EpiKV {
    bf16_t* mkv; const float* ssq;
    __device__ __forceinline__ void operator()(const f32x4 (&acc)[2][2][4][2], const Unit& u, int wr, int wc, int fr, int fq) const {
        int row0 = u.pm * BM + wr * 64 + fr; asm volatile("" : "+v"(row0) :: "memory"); const int cw = wc * 32 + 4 * fq;
        float rr8[8];
#pragma unroll
        for (int i = 0; i < 8; ++i) { const float* sp = ssq + (size_t)(row0 + (i >> 2) * HALF + (i & 3) * 16) * 24 + 12 + (fq & 1) * 4;
            const f32x4 a = *(const GAS f32x4*)sp;
            float ss = fq < 2 ? ((a[0] + a[1]) + (a[2] + a[3])) : 0.f;
            ss += __shfl_xor(ss, 16); ss += __shfl_xor(ss, 32);
            rr8[i] = rsqrtf(ss * (1.0f / 256.0f) + 1e-6f); }
#pragma unroll
        for (int ai = 0; ai < 2; ++ai)
#pragma unroll
            for (int m = 0; m < 4; ++m) { __builtin_amdgcn_sched_barrier(0); const int row = row0 + ai * HALF + m * 16; const float r = rr8[ai * 4 + m];
                bf16_t* rp = mkv + (size_t)row * 1024 + u.pn * 256 + cw;
#pragma unroll
                for (int bj = 0; bj < 2; ++bj)
#pragma unroll
                    for (int n = 0; n < 2; ++n) st_bf4(rp + bj * HALF + n * 16, acc[ai][bj][m][n] * r); }
    }
};
struct EpiBr {
    bf16_t* gt;
    int br;
    __device__ __forceinline__ void operator()(const f32x4 (&acc)[2][2][4][2], const Unit& u, int wr, int wc, int fr, int fq) const {
        int row0 = u.pm * BM + wr * 64 + fr; asm volatile("" : "+v"(row0) :: "memory"); const int cw = wc * 32 + 4 * fq;
#pragma unroll
        for (int ai = 0; ai < 2; ++ai)
#pragma unroll
            for (int m = 0; m < 4; ++m) { __builtin_amdgcn_sched_barrier(0); bf16_t* rp = gt + (size_t)(row0 + ai * HALF + m * 16) * 3072 + u.pn * 256 + cw;
#pragma unroll
                for (int bj = 0; bj < 2; ++bj)
#pragma unroll
                    for (int n = 0; n < 2; ++n) { bf16_t* p = rp + bj * HALF + n * 16; const u32x2 g = *(const GAS u32x2*)(p + br * 1024); const f32x4 a = acc[ai][bj][m][n];
                        f32x4 v; v[0] = a[0] * __uint_as_float(g.x << 16); v[1] = a[1] * __uint_as_float(g.x & 0xffff0000u); v[2] = a[2] * __uint_as_float(g.y << 16); v[3] = a[3] * __uint_as_float(g.y & 0xffff0000u);
                        if (br > 0) { const unsigned long long pv = __hip_atomic_load((const GAS unsigned long long*)p, __ATOMIC_RELAXED, __HIP_MEMORY_SCOPE_AGENT); const unsigned lo = (unsigned)pv, hi = (unsigned)(pv >> 32);
                            v[0] += __uint_as_float(lo << 16); v[1] += __uint_as_float(lo & 0xffff0000u); v[2] += __uint_as_float(hi << 16); v[3] += __uint_as_float(hi & 0xffff0000u); }
                        st_bf4(p, v); } }
    }
};
struct EpiRes {
    float* x;
    __device__ __forceinline__ void operator()(const f32x4 (&acc)[2][2][4][2], const Unit& u, int wr, int wc, int fr, int fq) const {
        int row0 = u.pm * BM + wr * 64 + fr; asm volatile("" : "+v"(row0) :: "memory"); const int cw = wc * 32 + 4 * fq;
#pragma unroll
        for (int ai = 0; ai < 2; ++ai)
#pragma unroll
            for (int m = 0; m < 4; ++m) { __builtin_amdgcn_sched_barrier(0); float* rp = x + (size_t)(row0 + ai * HALF + m * 16) * 1024 + u.pn * 256 + cw;
#pragma unroll
                for (int bj = 0; bj < 2; ++bj)
#pragma unroll
                    for (int n = 0; n < 2; ++n) { float* p = rp + bj * HALF + n * 16; const f32x4 xv = *(const GAS f32x4*)p; *(GAS f32x4*)p = xv * DN_ALPHA + acc[ai][bj][m][n]; } }
    }
};
struct EpiF1 {
    bf16_t* hd;
    __device__ __forceinline__ void operator()(const f32x4 (&acc)[2][2][4][2], const Unit& u, int wr, int wc, int fr, int fq) const {
        int row0 = u.pm * BM + wr * 64 + fr; asm volatile("" : "+v"(row0) :: "memory"); const int cw = wc * 32 + 4 * fq;
#pragma unroll
        for (int ai = 0; ai < 2; ++ai)
#pragma unroll
            for (int m = 0; m < 4; ++m) { __builtin_amdgcn_sched_barrier(0); bf16_t* rp = hd + (size_t)(row0 + ai * HALF + m * 16) * DFF + u.pn * 128 + cw;
#pragma unroll
                for (int n = 0; n < 2; ++n) { const f32x4 g = acc[ai][0][m][n], uu = acc[ai][1][m][n]; f32x4 v;
#pragma unroll
                    for (int j = 0; j < 4; ++j) v[j] = g[j] * __builtin_amdgcn_rcpf(1.0f + __expf(-g[j])) * uu[j];
                    st_bf4(rp + n * 16, v); } }
    }
};

constexpr int SHM_V = 64 * 128 * 2, SHM_K = 64 * 128 * 2;
#define KSWZ(row, colB) ((row) * 256 + ((colB) ^ (((row) & 7) << 4)))
#define SBAR() __builtin_amdgcn_sched_barrier(0)
__device__ __forceinline__ int crow(int r, int hi) { return (r & 3) + 8 * (r >> 2) + 4 * hi; }
struct NaCtx { int vlo, vhi, wstart, qc, drow0; const LAS float* tab; };

template <int MODE>
__device__ __forceinline__ void partialSM(f32x16& p0, f32x16& p1, float& m_reg, float& mn, float& alpha, const NaCtx& na, int t, int hi) {
    constexpr float SCALE = MODE == 2 ? 0.10206207261596575f : 0.125f;
    constexpr float C = SCALE * 1.4426950408889634f;
    constexpr float THRS = 8.f / SCALE;
    if (MODE == 0) {
        const float NINF = -__builtin_inff();
        if (t < na.vlo || t >= na.vhi) {
#pragma unroll
            for (int r = 0; r < 16; ++r) { p0[r] = NINF; p1[r] = NINF; }
        } else {
            const LAS float* trow = na.tab + (na.drow0 + t) * 31 + (15 - na.qc);
#pragma unroll
            for (int q4 = 0; q4 < 4; ++q4) {
#pragma unroll
                for (int r = q4 * 4; r < q4 * 4 + 4; ++r) { const int kc = crow(r, hi); const bool ok0 = (unsigned)(kc - na.wstart) < 16u, ok1 = (unsigned)(kc + 32 - na.wstart) < 16u;
                    const float b0 = trow[ok0 ? kc : na.wstart], b1 = trow[ok1 ? kc + 32 : na.wstart];
                    p0[r] = ok0 ? p0[r] + b0 : NINF; p1[r] = ok1 ? p1[r] + b1 : NINF; }
                __builtin_amdgcn_sched_barrier(0); }
        }
    }
    float pmax = p0[0];
#pragma unroll
    for (int r = 1; r < 16; ++r) pmax = fmaxf(pmax, p0[r]);
#pragma unroll
    for (int r = 0; r < 16; ++r) pmax = fmaxf(pmax, p1[r]);
    { auto rr = __builtin_amdgcn_permlane32_swap(__float_as_uint(pmax), __float_as_uint(pmax), false, false);
      pmax = fmaxf(__uint_as_float(rr[0]), __uint_as_float(rr[1])); }
    if (__builtin_expect(__all(pmax - m_reg <= THRS), 1)) { mn = m_reg; alpha = 1.f; }
    else { mn = fmaxf(m_reg, pmax); alpha = __builtin_amdgcn_exp2f((m_reg - mn) * C); m_reg = mn; }
    const float mnC = -mn * C;
#pragma unroll
    for (int r = 0; r < 16; ++r) p0[r] = fmaf(p0[r], C, mnC);
#pragma unroll
    for (int r = 0; r < 16; ++r) p1[r] = fmaf(p1[r], C, mnC);
#pragma unroll
    for (int r = 0; r < 16; ++r) p0[r] = __builtin_amdgcn_exp2f(p0[r]);
}
__device__ __forceinline__ void finishSM(f32x16& p0, f32x16& p1, float alpha, float& l_reg, bf16x8& pa0, bf16x8& pa1, bf16x8& pa2, bf16x8& pa3) {
#pragma unroll
    for (int r = 0; r < 16; ++r) p1[r] = __builtin_amdgcn_exp2f(p1[r]);
    float ps = 0;
#pragma unroll
    for (int r = 0; r < 16; ++r) ps += p0[r];
#pragma unroll
    for (int r = 0; r < 16; ++r) ps += p1[r];
    { auto rr = __builtin_amdgcn_permlane32_swap(__float_as_uint(ps), __float_as_uint(ps), false, false);
      ps = __uint_as_float(rr[0]) + __uint_as_float(rr[1]); }
    l_reg = l_reg * alpha + ps;
#define PK4(P, BASE, OUT) do { unsigned a0 = cvtpk(P[BASE + 0], P[BASE + 1]), a1 = cvtpk(P[BASE + 2], P[BASE + 3]);   \
    unsigned b0 = cvtpk(P[BASE + 4], P[BASE + 5]), b1 = cvtpk(P[BASE + 6], P[BASE + 7]);                              \
    auto r0 = __builtin_amdgcn_permlane32_swap(a0, b0, false, false); auto r1 = __builtin_amdgcn_permlane32_swap(a1, b1, false, false); \
    u32x4 w = {r0[0], r1[0], r0[1], r1[1]}; OUT = *reinterpret_cast<bf16x8*>(&w); } while (0)
    PK4(p0, 0, pa0); PK4(p0, 8, pa1); PK4(p1, 0, pa2); PK4(p1, 8, pa3);
#undef PK4
}
template <int ND>
__device__ __forceinline__ void qkt(f32x16& p0, f32x16& p1, const char* Ks, const bf16x8* qr, int r32, int hi) {
    p0 = f32x16{}; p1 = f32x16{};
#pragma unroll
    for (int d0 = 0; d0 < ND; ++d0) { const int cb = (d0 * 16 + hi * 8) * 2;
        const bf16x8 b0 = *reinterpret_cast<const bf16x8*>(Ks + KSWZ(r32, cb));
        const bf16x8 b1 = *reinterpret_cast<const bf16x8*>(Ks + KSWZ(32 + r32, cb));
        p0 = __builtin_amdgcn_mfma_f32_32x32x16_bf16(b0, qr[d0], p0, 0, 0, 0);
        p1 = __builtin_amdgcn_mfma_f32_32x32x16_bf16(b1, qr[d0], p1, 0, 0, 0); }
}
__device__ __forceinline__ int v_st(int k, int c) { const int kk = (k & ~0xC) | ((k & 4) << 1) | ((k & 8) >> 1); return ((kk >> 3) * 4 + (c >> 5)) * 512 + ((kk & 7) * 32 + (c & 31)) * 2; }
__device__ __forceinline__ int v_rd_base(int lane) { return ((lane & 3) << 3) | (((lane >> 2) & 3) << 6) | (((lane >> 4) & 1) << 5) | (((lane >> 5) & 1) << 8); }
constexpr int v_rd_off(int d0, int ks, int half) { return d0 * 512 + ks * 4096 + half * 2048; }
template <int OFF> __device__ __forceinline__ s16x4 tr_read(int vb) {
    s16x4 r; asm volatile("ds_read_b64_tr_b16 %0, %1 offset:%2" : "=&v"(r) : "v"(vb), "i"(OFF) : "memory"); return r;
}
template <int D0> __device__ __forceinline__ void pv_one(f32x16& od, int vb, bf16x8 pa0, bf16x8 pa1, bf16x8 pa2, bf16x8 pa3) {
    const s16x4 l0 = tr_read<v_rd_off(D0, 0, 0)>(vb), h0 = tr_read<v_rd_off(D0, 0, 1)>(vb), l1 = tr_read<v_rd_off(D0, 1, 0)>(vb), h1 = tr_read<v_rd_off(D0, 1, 1)>(vb);
    const s16x4 l2 = tr_read<v_rd_off(D0, 2, 0)>(vb), h2 = tr_read<v_rd_off(D0, 2, 1)>(vb), l3 = tr_read<v_rd_off(D0, 3, 0)>(vb), h3 = tr_read<v_rd_off(D0, 3, 1)>(vb);
    asm volatile("s_waitcnt lgkmcnt(0)" ::: "memory"); SBAR();
#define PKV(L, H) (bf16x8){L[0], L[1], L[2], L[3], H[0], H[1], H[2], H[3]}
    od = __builtin_amdgcn_mfma_f32_32x32x16_bf16(pa0, PKV(l0, h0), od, 0, 0, 0);
    od = __builtin_amdgcn_mfma_f32_32x32x16_bf16(pa1, PKV(l1, h1), od, 0, 0, 0);
    od = __builtin_amdgcn_mfma_f32_32x32x16_bf16(pa2, PKV(l2, h2), od, 0, 0, 0);
    od = __builtin_amdgcn_mfma_f32_32x32x16_bf16(pa3, PKV(l3, h3), od, 0, 0, 0);
#undef PKV
}
template <int NO> __device__ __forceinline__ void pv_d0(f32x16* o, int vb, bf16x8 pa0, bf16x8 pa1, bf16x8 pa2, bf16x8 pa3) {
    pv_one<0>(o[0], vb, pa0, pa1, pa2, pa3); pv_one<1>(o[1], vb, pa0, pa1, pa2, pa3);
    if constexpr (NO == 4) { pv_one<2>(o[2], vb, pa0, pa1, pa2, pa3); pv_one<3>(o[3], vb, pa0, pa1, pa2, pa3); }
}

template <int DQ, int DV, int MODE, int ldq, int ldk, int ldk2, int ldv, int SD>
__device__ __forceinline__ void attn_core(const bf16_t* __restrict__ Qb, const bf16_t* __restrict__ K1, const bf16_t* __restrict__ K2,
                                          const bf16_t* __restrict__ Vh, int NT, char* lds, f32x16 (&o)[DV / 32], float (&rli)[16], const NaCtx& na) {
    constexpr int ND = DQ / 16, NO = DV / 32;
    const int tid = otid(), wid = tid >> 6, lane = tid & 63, r32 = lane & 31, hi = lane >> 5;
    char* V_lds = lds; char* K_lds = lds + 2 * SHM_V;
    float* ws = (float*)(lds + 2 * SHM_V + 2 * SHM_K) + wid * 64; float* li_l = ws; float* al_l = ws + 32;
    float m_reg = -1e30f, l_reg = 0;
#pragma unroll
    for (int d = 0; d < NO; ++d) o[d] = f32x16{};
    bf16x8 qr[ND];
    const bf16_t* Qw = Qb + (long)(wid * 32 + r32) * ldq + hi * 8;
#pragma unroll
    for (int d0 = 0; d0 < ND; ++d0) qr[d0] = *(const GAS bf16x8*)(Qw + d0 * 16);
    const int sr = tid >> 4, sc = (tid & 15) * 8, vst0 = v_st(sr, sc), vst1 = v_st(32 + sr, sc);
    const int vb0 = (int)(uintptr_t)V_lds + v_rd_base(lane);
    const bool ldV = sc < DV, ldK = sc < DQ;
    const bf16_t* kp; long kld;
    if (DQ > 64 && sc >= 64) { kp = K2 + (sc - 64); kld = ldk2; } else { kp = K1 + sc; kld = ldk; }
    const bf16_t* vp = Vh + sc;
    struct Slot { bf16x8 vs0, vs1, ks0, ks1; };
    Slot sA, sB; sA.vs0 = sA.vs1 = sA.ks0 = sA.ks1 = bf16x8{}; sB = sA;
    Slot& sO = (SD == 2) ? sB : sA;
#define SLOAD(S_, k0) do { if (ldV) { S_.vs0 = *(const GAS bf16x8*)(vp + (long)((k0) + sr) * ldv); S_.vs1 = *(const GAS bf16x8*)(vp + (long)((k0) + 32 + sr) * ldv); } \
    if (ldK) { S_.ks0 = *(const GAS bf16x8*)(kp + (long)((k0) + sr) * kld); S_.ks1 = *(const GAS bf16x8*)(kp + (long)((k0) + 32 + sr) * kld); } } while (0)
#define SWRITE(b, S_) do { if (ldV) { *(bf16x8*)(V_lds + (b) * SHM_V + vst0) = S_.vs0; *(bf16x8*)(V_lds + (b) * SHM_V + vst1) = S_.vs1; } \
    if (ldK) { const int kc = sc * 2; *(bf16x8*)(K_lds + (b) * SHM_K + KSWZ(sr, kc)) = S_.ks0; *(bf16x8*)(K_lds + (b) * SHM_K + KSWZ(32 + sr, kc)) = S_.ks1; } } while (0)
#define SWAIT() do { if (SD == 2) asm volatile("s_waitcnt vmcnt(4)" ::: "memory"); else asm volatile("s_waitcnt vmcnt(0)" ::: "memory"); } while (0)
#define RESC(a) do { if (__any((a) < 1.f)) { if (hi == 0) al_l[r32] = (a); asm volatile("s_waitcnt lgkmcnt(0)" ::: "memory"); \
    _Pragma("unroll") for (int d = 0; d < NO; ++d) _Pragma("unroll") for (int r = 0; r < 16; ++r) o[d][r] *= al_l[crow(r, hi)]; } } while (0)
    f32x16 pA0, pA1, pB0, pB1; float mnA, mnB, alA, alB; bf16x8 pa0, pa1, pa2, pa3;
    SLOAD(sA, 0); asm volatile("s_waitcnt vmcnt(0)" ::: "memory"); SWRITE(0, sA); __syncthreads();
    qkt<ND>(pA0, pA1, K_lds, qr, r32, hi); partialSM<MODE>(pA0, pA1, m_reg, mnA, alA, na, 0, hi);
    SLOAD(sO, 64); if (SD == 2 && 2 < NT) SLOAD(sA, 128);
    SWAIT(); SWRITE(1, sO); __syncthreads();
    for (int j = 1; j + 1 < NT; j += 2) {
        SBAR(); qkt<ND>(pB0, pB1, K_lds + SHM_K, qr, r32, hi);
        finishSM(pA0, pA1, alA, l_reg, pa0, pa1, pa2, pa3); SBAR();
        SLOAD(sO, (j + SD) * 64); SBAR();
        pv_d0<NO>(o, vb0, pa0, pa1, pa2, pa3); partialSM<MODE>(pB0, pB1, m_reg, mnB, alB, na, j, hi);
        __syncthreads(); SWAIT(); SWRITE(0, sA);
        RESC(alB); __syncthreads();
        SBAR(); qkt<ND>(pA0, pA1, K_lds, qr, r32, hi);
        finishSM(pB0, pB1, alB, l_reg, pa0, pa1, pa2, pa3); SBAR();
        if (SD == 1 || j + 3 < NT) SLOAD(sA, (j + 1 + SD) * 64); SBAR();
        pv_d0<NO>(o, vb0 + SHM_V, pa0, pa1, pa2, pa3); partialSM<MODE>(pA0, pA1, m_reg, mnA, alA, na, j + 1, hi);
        __syncthreads(); SWAIT(); SWRITE(1, sO);
        RESC(alA); __syncthreads();
    }
    SBAR(); qkt<ND>(pB0, pB1, K_lds + SHM_K, qr, r32, hi);
    finishSM(pA0, pA1, alA, l_reg, pa0, pa1, pa2, pa3); SBAR();
    pv_d0<NO>(o, vb0, pa0, pa1, pa2, pa3); partialSM<MODE>(pB0, pB1, m_reg, mnB, alB, na, NT - 1, hi);
    __syncthreads(); RESC(alB);
    finishSM(pB0, pB1, alB, l_reg, pa0, pa1, pa2, pa3); SBAR();
    pv_d0<NO>(o, vb0 + SHM_V, pa0, pa1, pa2, pa3);
    if (hi == 0) li_l[r32] = l_reg;
    asm volatile("s_waitcnt lgkmcnt(0)" ::: "memory");
#pragma unroll
    for (int r = 0; r < 16; ++r) rli[r] = __builtin_amdgcn_rcpf(li_l[crow(r, hi)]);
#undef SLOAD
#undef SWRITE
#undef SWAIT
#undef RESC
}

__device__ __forceinline__ void na_item(const Params& p, int l, int item, char* lds) {
    const int xcd = item & 7, slot = item >> 3;
    const int pair = xcd * 4 + (slot >> 4), rb = slot & 15, b = pair >> 3, h = pair & 7;
    bf16_t* pa = (bf16_t*)(p.ws + OFF_PA);
    const int r0 = rb * 4, lo = min(max(r0 - 4, 0), 52);
    const int tid = otid(), wid = tid >> 6, lane = tid & 63, r32 = lane & 31, hi = lane >> 5;
    LAS float* tab = (LAS float*)((LAS unsigned char*)(uintptr_t)(unsigned)(uintptr_t)lds + 130 * 1024);
    const float* rpb = p.in[5] + ((size_t)l * 8 + h) * 465;
    if (tid < 465) tab[tid] = ((const GAS float*)rpb)[tid] * 8.0f;
    NaCtx na; const int wu = __builtin_amdgcn_readfirstlane(wid); const int r = r0 + (wu >> 1), qc = 32 * (wu & 1) + r32, rs = min(max(r - 4, 0), 56);
    na.vlo = rs - lo; na.vhi = na.vlo + 8; na.wstart = min(max(qc - 8, 0), 48); na.qc = qc; na.drow0 = lo - r + 7; na.tab = tab;
    const size_t tb = (size_t)b * SEQ;
    bf16_t* Q = pa + (tb + (size_t)r0 * 64) * 1536 + h * 64;
    const bf16_t* K = pa + (tb + (size_t)lo * 64) * 1536 + 512 + h * 64;
    const bf16_t* V = K + 512;
    f32x16 o[2]; float rli[16];
    attn_core<64, 64, 0, 1536, 1536, 1536, 1536, 1>(Q, K, K, V, 12, lds, o, rli, na);
    bf16_t* Ow = Q + (size_t)(wid * 32) * 1536;
#pragma unroll
    for (int rr = 0; rr < 16; ++rr) { const int orow = crow(rr, hi);
#pragma unroll
        for (int d = 0; d < 2; ++d) { const float v = o[d][rr] * rli[rr]; ((GAS bf16_t*)Ow)[(size_t)orow * 1536 + d * 32 + r32] = (bf16_t)(cvtpk(v, v) & 0xffffu); } }
    __syncthreads();
}
__device__ __forceinline__ void diff_item(const Params& p, int l, int item, char* lds) {
    const int xcd = item & 7, slot = item >> 3;
    const int pair = xcd * 2 + (slot >> 4), qb = slot & 15, b = pair >> 2, h = pair & 3;
    bf16_t* pd = (bf16_t*)(p.ws + OFF_PD);
    const int tid = otid(), wid = tid >> 6, lane = tid & 63, r32 = lane & 31, hi = lane >> 5;
    const float* lv = p.in[6] + (size_t)l * 256;
    float s1 = 0.f, s2 = 0.f;
    for (int i = 0; i < 64; ++i) { s1 += ((const GAS float*)lv)[i] * ((const GAS float*)lv)[64 + i]; s2 += ((const GAS float*)lv)[128 + i] * ((const GAS float*)lv)[192 + i]; }
    const float lam_init = p.lam_init[l], lam = __expf(s1) - __expf(s2) + lam_init;
    const size_t tb = (size_t)b * SEQ;
    bf16_t* Q = pd + (tb + (size_t)qb * 256) * 1536 + h * 128;
    const bf16_t* K = pd + tb * 1536 + 512 + h * 128;
    const bf16_t* V = pd + tb * 1536 + 1024 + h * 128;
    NaCtx na{};
    unsigned short* stash = (unsigned short*)(lds + 66 * 1024) + (size_t)wid * 64 * 64 + lane;
    f32x16 o[4]; float rli[16];
    attn_core<64, 128, 1, 1536, 1536, 1536, 1536, 2>(Q, K, K, V, 64, lds, o, rli, na);
#pragma unroll
    for (int d = 0; d < 4; ++d)
#pragma unroll
        for (int rr = 0; rr < 16; ++rr) { const float v = o[d][rr] * rli[rr]; stash[(d * 16 + rr) * 64] = (unsigned short)(cvtpk(v, v) & 0xffffu); }
    __syncthreads();
    attn_core<64, 128, 1, 1536, 1536, 1536, 1536, 2>(Q + 64, K + 64, K, V, 64, lds, o, rli, na);
    const float* sg = p.in[7] + (size_t)l * 128;
    float gcol[4];
#pragma unroll
    for (int d = 0; d < 4; ++d) gcol[d] = ((const GAS float*)sg)[d * 32 + r32] * (1.0f - lam_init);
    bf16_t* Ow = Q + (size_t)(wid * 32) * 1536;
#pragma unroll
    for (int rr = 0; rr < 16; ++rr) {
        float v[4]; float ss = 0.f;
#pragma unroll
        for (int d = 0; d < 4; ++d) { v[d] = bf2f(stash[(d * 16 + rr) * 64]) - lam * (o[d][rr] * rli[rr]); ss += v[d] * v[d]; }
        ss += __shfl_xor(ss, 1); ss += __shfl_xor(ss, 2); ss += __shfl_xor(ss, 4); ss += __shfl_xor(ss, 8); ss += __shfl_xor(ss, 16);
        const float rn = rsqrtf(ss * (1.0f / 128.0f) + 1e-6f);
        const int orow = crow(rr, hi);
#pragma unroll
        for (int d = 0; d < 4; ++d) { const float y = v[d] * rn * gcol[d]; ((GAS bf16_t*)Ow)[(size_t)orow * 1536 + d * 32 + r32] = (bf16_t)(cvtpk(y, y) & 0xffffu); }
    }
    __syncthreads();
}
__device__ __forceinline__ void mla_item(const Params& p, int item, char* lds) {
    const int xcd = item & 7, slot = item >> 3;
    const int pair = xcd * 4 + (slot >> 4), qb = slot & 15, b = pair >> 3, h = pair & 7;
    const int tid = otid(), wid = tid >> 6, lane = tid & 63, r32 = lane & 31, hi = lane >> 5;
    bf16_t* mc = (bf16_t*)(p.ws + OFF_MC); const bf16_t* mq = (const bf16_t*)(p.ws + OFF_MQ); const bf16_t* mkv = (const bf16_t*)(p.ws + OFF_MKV);
    const size_t tb = (size_t)b * SEQ;
    const bf16_t* Q = mq + (tb + (size_t)qb * 256) * 768 + h * 96;
    const bf16_t* K1 = mkv + tb * 1024 + h * 128;
    const bf16_t* K2 = mc + tb * 768 + 640;
    const bf16_t* V = K1 + 64;
    NaCtx na{};
    f32x16 o[2]; float rli[16];
    attn_core<96, 64, 2, 768, 1024, 768, 1024, 2>(Q, K1, K2, V, 64, lds, o, rli, na);
    bf16_t* Ow = mc + (tb + (size_t)qb * 256 + wid * 32) * 768 + h * 64;
#pragma unroll
    for (int rr = 0; rr < 16; ++rr) { const int orow = crow(rr, hi);
#pragma unroll
        for (int d = 0; d < 2; ++d) { const float v = o[d][rr] * rli[rr]; ((GAS bf16_t*)Ow)[(size_t)orow * 768 + d * 32 + r32] = (bf16_t)(cvtpk(v, v) & 0xffffu); } }
    __syncthreads();
}

struct MapId { __device__ __forceinline__ int operator()(int n) const { return n; } };
struct MapIn { __device__ __forceinline__ int operator()(int n) const { return n < 3744 ? n : (n < 3840 ? -1 : n - 96); } };
struct MapF1 { __device__ __forceinline__ int operator()(int n) const { const int pt = n >> 8, r = n & 255; return r < 128 ? pt * 128 + r : DFF + pt * 128 + (r - 128); } };
template <class Map>
__device__ __forceinline__ void prep_w(const float* __restrict__ src, int Ks, int Ns, bf16_t* __restrict__ dst, int Nd, int Kd, const float* __restrict__ kscale, Map map, float* tile) {
    const int tid = otid(), tx = tid & 63, ty = tid >> 6, nk = Kd / 64, ntile = (Nd / 64) * nk;
    for (int t = blockIdx.x; t < ntile; t += gridDim.x) {
        const int n0 = (t / nk) * 64, k0 = (t % nk) * 64;
        const int ns = map(n0 + tx);
#pragma unroll
        for (int j = 0; j < 8; ++j) { const int kl = ty + 8 * j, ks = (k0 + kl) % Ks; float v = 0.f;
            if (ns >= 0) { v = ((const GAS float*)src)[(size_t)ks * Ns + ns]; if (kscale) v *= ((const GAS float*)kscale)[ks]; }
            tile[kl * 65 + tx] = v; }
        __syncthreads();
        const int kx = (tid & 31) * 2, ny = tid >> 5;
#pragma unroll
        for (int j = 0; j < 4; ++j) { const int nl = ny + 16 * j;
            *(GAS unsigned*)(dst + (size_t)(n0 + nl) * Kd + k0 + kx) = cvtpk(tile[kx * 65 + nl], tile[(kx + 1) * 65 + nl]); }
        __syncthreads();
    }
}
__device__ __forceinline__ void ln_rows(const float* src, float* dstf, bf16_t* dstb, const float* __restrict__ g, const float* __restrict__ bta, int row0, int nrows) {
    const int tid_ = otid(); const int lane = tid_ & 63, wv = blockIdx.x * 8 + (tid_ >> 6), nw = gridDim.x * 8;
    f32x4 gv[4], bv[4];
#pragma unroll
    for (int i = 0; i < 4; ++i) { gv[i] = *(const GAS f32x4*)(g + i * 256 + lane * 4); bv[i] = *(const GAS f32x4*)(bta + i * 256 + lane * 4); }
    for (int r = wv; r < nrows; r += nw) {
        const size_t ro = (size_t)(row0 + r) * 1024;
        f32x4 v[4]; float s = 0.f;
#pragma unroll
        for (int i = 0; i < 4; ++i) { v[i] = *(const GAS f32x4*)(src + ro + i * 256 + lane * 4); s += (v[i][0] + v[i][1]) + (v[i][2] + v[i][3]); }
#pragma unroll
        for (int k = 1; k < 64; k <<= 1) s += __shfl_xor(s, k);
        const float mu = s * (1.0f / 1024.0f); float q = 0.f;
#pragma unroll
        for (int i = 0; i < 4; ++i) { v[i] = v[i] - mu; q += (v[i][0] * v[i][0] + v[i][1] * v[i][1]) + (v[i][2] * v[i][2] + v[i][3] * v[i][3]); }
#pragma unroll
        for (int k = 1; k < 64; k <<= 1) q += __shfl_xor(q, k);
        const float rstd = rsqrtf(q * (1.0f / 1024.0f) + 1e-5f);
#pragma unroll
        for (int i = 0; i < 4; ++i) { const f32x4 y = v[i] * rstd * gv[i] + bv[i]; *(GAS f32x4*)(dstf + ro + i * 256 + lane * 4) = y;
            if (dstb) st_bf4(dstb + ro + i * 256 + lane * 4, y); }
    }
}

#ifndef PHMASK
#define PHMASK 0xffff
#endif
#define WSP(T_, off) ((T_*)(wsb + (off)))
__device__ __forceinline__ void gsync(cg::grid_group& g) { asm volatile("s_waitcnt vmcnt(0)" ::: "memory"); g.sync(); __builtin_amdgcn_fence(__ATOMIC_ACQUIRE, "agent"); }
__global__ __launch_bounds__(512, 2) void fwd_megakernel(Params p) {
    extern __shared__ __attribute__((aligned(16))) unsigned char shm[];
    cg::grid_group grid = cg::this_grid();
    LAS unsigned char* ldsg = (LAS unsigned char*)shm;
    char* lds = (char*)shm;
    if (PHMASK & 512) {
        unsigned char* wsb = p.ws;
        float* tile = (float*)shm;
        for (int l = 0; l < DEPTH; ++l) {
            prep_w(p.in[3] + (size_t)l * 1024 * 6816, 1024, 6816, WSP(bf16_t, OFF_WIN) + (size_t)l * NIN * 1024, NIN, 1024, nullptr, MapIn(), tile);
            prep_w(p.in[10] + (size_t)l * 384 * 768, 384, 768, WSP(bf16_t, OFF_WQB) + (size_t)l * 768 * 384, 768, 384, p.in[8] + l * 384, MapId(), tile);
            prep_w(p.in[11] + (size_t)l * 256 * 1024, 256, 1024, WSP(bf16_t, OFF_WKVB) + (size_t)l * 1024 * 256, 1024, 256, p.in[9] + l * 256, MapId(), tile);
            for (int i = 0; i < 3; ++i)
                prep_w(p.in[12] + ((size_t)l * 3 + i) * 512 * 1024, 512, 1024, WSP(bf16_t, OFF_WBR) + ((size_t)l * 3 + i) * 1024 * 512, 1024, 512, nullptr, MapId(), tile);
            prep_w(p.in[13] + (size_t)l * 1024 * 1024, 1024, 1024, WSP(bf16_t, OFF_WOUT) + (size_t)l * 1024 * 3072, 1024, 3072, nullptr, MapId(), tile);
            prep_w(p.in[16] + (size_t)l * 1024 * 5632, 1024, 5632, WSP(bf16_t, OFF_WF1) + (size_t)l * 5632 * 1024, 5632, 1024, nullptr, MapF1(), tile);
            prep_w(p.in[17] + (size_t)l * 2816 * 1024, 2816, 1024, WSP(bf16_t, OFF_WF2) + (size_t)l * 1024 * 2816, 1024, 2816, nullptr, MapId(), tile);
        }
        const int gtid = blockIdx.x * 512 + otid(), gn = gridDim.x * 512;
        const float nlt = -13.122363377404328f;
        float* cd = WSP(float, OFF_TD); float* sd = cd + SEQ * 8; float* cm = WSP(float, OFF_TM); float* sm = cm + SEQ * 16;
        for (int i = gtid; i < SEQ * 8; i += gn) { const int pos = i >> 3, f = i & 7; const float inv = expf(nlt * (float)f / 8.0f), ang = (float)pos * inv; ((GAS float*)cd)[i] = cosf(ang); ((GAS float*)sd)[i] = sinf(ang); }
        for (int i = gtid; i < SEQ * 16; i += gn) { const int pos = i >> 4, f = i & 15; const float inv = expf(nlt * (float)f / 16.0f), ang = (float)pos * inv; ((GAS float*)cm)[i] = cosf(ang); ((GAS float*)sm)[i] = sinf(ang); }
        ln_rows(p.in[0], p.out, WSP(bf16_t, OFF_XB), p.in[1], p.in[2], 0, T_ALL);
    }
    gsync(grid);
    for (int step = 0; step < DEPTH * 14; ++step) {
        const int l = step / 14, ls = step % 14, ck = ls < 5 ? 0 : 1, ph = ls < 10 ? ls % 5 : ls - 5;
        const size_t tok0 = ls < 10 ? (size_t)ck * TC : 0;
        const int mrows = ls < 10 ? TC : T_ALL;
        unsigned wlo_ = (unsigned)(uintptr_t)p.ws, whi_ = (unsigned)((uintptr_t)p.ws >> 32); asm volatile("" : "+v"(wlo_), "+v"(whi_));
        unsigned char* wsb = (unsigned char*)(((uintptr_t)(unsigned)__builtin_amdgcn_readfirstlane((int)whi_) << 32) | (uintptr_t)(unsigned)__builtin_amdgcn_readfirstlane((int)wlo_));
        switch (ph) {
        case 0: if (PHMASK & 1) {
            float* cd = WSP(float, OFF_TD); float* cm = WSP(float, OFF_TM);
            EpiIn E{WSP(bf16_t, OFF_PA), WSP(bf16_t, OFF_PD), WSP(bf16_t, OFF_MC), WSP(bf16_t, OFF_GT), WSP(float, OFF_SSQ), p.in[4] + (size_t)l * 3072, cd, cd + SEQ * 8, cm, cm + SEQ * 16};
            gemm_phase(ldsg, WSP(bf16_t, OFF_XB) + tok0 * 1024, 1024, WSP(bf16_t, OFF_WIN) + (size_t)l * NIN * 1024, 1024, TC, NIN, 1024, E);
        } break;
        case 1: if (PHMASK & 2) {
            if (PHMASK & 1024) { EpiKV E{WSP(bf16_t, OFF_MKV), WSP(float, OFF_SSQ)}; gemm_phase(ldsg, WSP(bf16_t, OFF_MC) + 384, 768, WSP(bf16_t, OFF_WKVB) + (size_t)l * 1024 * 256, 256, TC, 1024, 256, E); }
            if (PHMASK & 2048) { float* cm = WSP(float, OFF_TM); EpiQ E{WSP(bf16_t, OFF_MQ), WSP(float, OFF_SSQ), cm, cm + SEQ * 16}; gemm_phase(ldsg, WSP(bf16_t, OFF_MC), 768, WSP(bf16_t, OFF_WQB) + (size_t)l * 768 * 384, 384, TC, 768, 384, E); }
            __syncthreads();
            if (PHMASK & 4096) for (int it = blockIdx.x; it < 512; it += gridDim.x) na_item(p, l, it, lds);
        } break;
        case 2: if (PHMASK & 4) {
            if (PHMASK & 8192) for (int it = blockIdx.x; it < 256; it += gridDim.x) diff_item(p, l, it, lds);
            if (PHMASK & 16384) for (int it = blockIdx.x; it < 512; it += gridDim.x) mla_item(p, it, lds);
        } break;
        case 3: if (PHMASK & 8) {
            for (int i = 0; i < 3; ++i) {
                const bf16_t* A = i == 0 ? WSP(bf16_t, OFF_PA) : (i == 1 ? WSP(bf16_t, OFF_PD) : WSP(bf16_t, OFF_MC)); const int lda = i == 2 ? 768 : 1536;
                EpiBr E{WSP(bf16_t, OFF_GT), i};
                gemm_phase(ldsg, A, lda, WSP(bf16_t, OFF_WBR) + ((size_t)l * 3 + i) * 1024 * 512, 512, TC, 1024, 512, E);
            }
        } break;
        case 4: case 7: if (PHMASK & 16) {
            EpiRes E{p.out + tok0 * 1024};
            const bf16_t* A = ph == 4 ? WSP(bf16_t, OFF_GT) : WSP(bf16_t, OFF_PA); const int ld = ph == 4 ? 3072 : DFF, kk = ph == 4 ? 1024 : DFF;
            const bf16_t* B = ph == 4 ? WSP(bf16_t, OFF_WOUT) + (size_t)l * 1024 * 3072 : WSP(bf16_t, OFF_WF2) + (size_t)l * 1024 * DFF;
            gemm_phase(ldsg, A, ld, B, ld, mrows, 1024, kk, E);
        } break;
        case 5: case 8: if (PHMASK & 32) {
            const float* g = ph == 5 ? p.in[14] : p.in[18]; const float* bb = ph == 5 ? p.in[15] : p.in[19];
            ln_rows(p.out, p.out, WSP(bf16_t, OFF_XB), g + l * 1024, bb + l * 1024, (int)tok0, mrows);
        } break;
        case 6: if (PHMASK & 64) {
            EpiF1 E{WSP(bf16_t, OFF_PA)};
            gemm_phase(ldsg, WSP(bf16_t, OFF_XB) + tok0 * 1024, 1024, WSP(bf16_t, OFF_WF1) + (size_t)l * 5632 * 1024, 1024, mrows, 5632, 1024, E);
        } break;
        }
        gsync(grid);
    }
}

extern "C" void kernel_launch(void* const* d_in, const int* in_sizes, int n_in, void* d_out, int out_size, void* d_ws, size_t ws_size, hipStream_t stream) {
    static int grid = 0;
    if (grid == 0) {
        if (n_in != 20 || in_sizes[0] != T_ALL * DM || out_size != T_ALL * DM || ws_size < WS_END) {
            fprintf(stderr, "kernel_launch: unexpected shapes / workspace (n_in %d, ws %zu, need %zu)\n", n_in, ws_size, (size_t)WS_END); grid = -1; return; }
        int dev = 0, cus = 0, per_cu = 0;
        hipGetDevice(&dev); hipDeviceGetAttribute(&cus, hipDeviceAttributeMultiprocessorCount, dev);
        if (hipFuncSetAttribute((const void*)fwd_megakernel, hipFuncAttributeMaxDynamicSharedMemorySize, LDS_BYTES) != hipSuccess) { fprintf(stderr, "kernel_launch: hipFuncSetAttribute failed\n"); grid = -1; return; }
        if (hipOccupancyMaxActiveBlocksPerMultiprocessor(&per_cu, (const void*)fwd_megakernel, 512, LDS_BYTES) != hipSuccess || per_cu < 1) { fprintf(stderr, "kernel_launch: occupancy query gave %d\n", per_cu); per_cu = 1; }
        (void)hipGetLastError();
        grid = cus;
    }
    if (grid < 0) return;
    Params p{};
    for (int i = 0; i < 20; ++i) p.in[i] = (const float*)d_in[i];
    p.out = (float*)d_out; p.ws = (unsigned char*)d_ws;
    for (int l = 0; l < 4; ++l) p.lam_init[l] = (float)(0.8 - 0.6 * exp(-0.3 * (double)l));
    void* args[] = {&p};
    hipError_t e = hipLaunchCooperativeKernel((const void*)fwd_megakernel, dim3(grid), dim3(512), args, LDS_BYTES, stream);
    if (e != hipSuccess) fprintf(stderr, "kernel_launch: cooperative launch failed: %s (grid %d)\n", hipGetErrorString(e), grid);
}
```

```cpp
#include <hip/hip_runtime.h>
#include <hip/hip_cooperative_groups.h>
#include <cstdio>
#include <cstdint>
namespace cg = cooperative_groups;

#define LAS __attribute__((address_space(3)))
#define GAS __attribute__((address_space(1)))
typedef unsigned short bf16_t;
typedef short bf16x8 __attribute__((ext_vector_type(8)));
typedef short s16x4 __attribute__((ext_vector_type(4)));
typedef float f32x4 __attribute__((ext_vector_type(4)));
typedef float f32x16 __attribute__((ext_vector_type(16)));
typedef unsigned u32x4 __attribute__((ext_vector_type(4)));
typedef unsigned u32x2 __attribute__((ext_vector_type(2)));

constexpr int T_ALL = 32768, TC = 16384, DM = 1024, SEQ = 4096, NIN = 6912, DFF = 2816, DEPTH = 4, NCHUNK = 2;
constexpr size_t SZ_WIN = (size_t)DEPTH * NIN * 1024 * 2, SZ_WQB = (size_t)DEPTH * 768 * 384 * 2, SZ_WKVB = (size_t)DEPTH * 1024 * 256 * 2,
                 SZ_WBR = (size_t)DEPTH * 3 * 1024 * 512 * 2, SZ_WOUT = (size_t)DEPTH * 1024 * 3072 * 2, SZ_WF1 = (size_t)DEPTH * 5632 * 1024 * 2,
                 SZ_WF2 = (size_t)DEPTH * 1024 * 2816 * 2, SZ_XB = (size_t)T_ALL * 1024 * 2, SZ_PA = (size_t)TC * 1536 * 2, SZ_PD = SZ_PA,
                 SZ_MC = (size_t)TC * 768 * 2, SZ_GT = (size_t)TC * 3072 * 2, SZ_MQ = (size_t)TC * 768 * 2, SZ_MKV = (size_t)TC * 1024 * 2,
                 SZ_SSQ = (size_t)TC * 24 * 4, SZ_TD = (size_t)SEQ * 8 * 4 * 2, SZ_TM = (size_t)SEQ * 16 * 4 * 2;
constexpr size_t OFF_WIN = 0, OFF_WQB = OFF_WIN + SZ_WIN, OFF_WKVB = OFF_WQB + SZ_WQB, OFF_WBR = OFF_WKVB + SZ_WKVB, OFF_WOUT = OFF_WBR + SZ_WBR,
                 OFF_WF1 = OFF_WOUT + SZ_WOUT, OFF_WF2 = OFF_WF1 + SZ_WF1, OFF_XB = OFF_WF2 + SZ_WF2, OFF_PA = OFF_XB + SZ_XB, OFF_PD = OFF_PA + SZ_PA,
                 OFF_MC = OFF_PD + SZ_PD, OFF_GT = OFF_MC + SZ_MC, OFF_MQ = OFF_GT + SZ_GT, OFF_MKV = OFF_MQ + SZ_MQ, OFF_SSQ = OFF_MKV + SZ_MKV,
                 OFF_TD = OFF_SSQ + SZ_SSQ, OFF_TM = OFF_TD + SZ_TD, WS_END = OFF_TM + SZ_TM;
constexpr int LDS_BYTES = 132 * 1024;
static_assert((size_t)T_ALL * DFF * 2 <= SZ_PA + SZ_PD + SZ_MC + SZ_GT, "SwiGLU hidden of all tokens aliases projA|projD|mla_c|gates");
constexpr float DN_ALPHA = 1.681792830507429f;

struct Params { const float* in[20]; float* out; unsigned char* ws; float lam_init[4]; };

typedef __bf16 bf2_t __attribute__((ext_vector_type(2)));
typedef float f32x2 __attribute__((ext_vector_type(2)));
__device__ __forceinline__ unsigned cvtpk(float lo, float hi) { f32x2 v = {lo, hi}; bf2_t b = __builtin_convertvector(v, bf2_t); return __builtin_bit_cast(unsigned, b); }
__device__ __forceinline__ int otid() { int t = threadIdx.x; asm volatile("" : "+v"(t)); return t; }
__device__ __forceinline__ float bf2f(unsigned short b) { return __uint_as_float(((unsigned)b) << 16); }
__device__ __forceinline__ void st_bf4(bf16_t* p, f32x4 v) { u32x2 w; w.x = cvtpk(v[0], v[1]); w.y = cvtpk(v[2], v[3]); *(GAS u32x2*)p = w; }

constexpr int BM = 256, BK = 64, HALF = 128, HTB = HALF * BK * 2, NXCD = 8, WGM = 8;
__device__ __forceinline__ int lds_byte(int r, int c) { const int st = (r >> 4) * 2 + (c >> 5), rr = r & 15, cc = c & 31, ob = rr * 64 + cc * 2; return st * 1024 + (ob ^ (((ob >> 9) & 1) << 5)); }
__device__ __forceinline__ void stage_rc(int b, int& R, int& C) { const int st = b / 1024, sb = b % 1024, swz = sb ^ (((sb >> 9) & 1) << 5); R = (st >> 1) * 16 + swz / 64; C = (st & 1) * 32 + (swz % 64) / 2; }
struct Unit { int pm, pn; };
struct StaticOrder {
    int nM, nN, nwg, G, c;
    __device__ void init(int M, int N, int G_, int c_) { nM = M / BM; nN = N / BM; nwg = nM * nN; G = G_; c = c_; }
    __device__ bool next(int i, Unit& u) const {
        const long L = (long)i * G + c; if (L >= nwg) return false;
        int wgid = (int)L; { const int q = nwg / NXCD, r = nwg % NXCD, xcd = wgid % NXCD, off = wgid / NXCD; wgid = (xcd < r ? xcd * (q + 1) : r * (q + 1) + (xcd - r) * q) + off; }
        const int nig = WGM * nN, gid = wgid / nig, fm = gid * WGM, gsz = (nM - fm) < WGM ? (nM - fm) : WGM;
        u.pm = __builtin_amdgcn_readfirstlane(fm + ((wgid % nig) % gsz)); u.pn = __builtin_amdgcn_readfirstlane((wgid % nig) / gsz); return true;
    }
};

template <class Epi>
__device__ __forceinline__ void gemm_phase(LAS unsigned char* lds, const bf16_t* A, int lda, const bf16_t* Bt, int ldb, int M, int N, int K, const Epi& E) {
    const int tid = otid(), wid = __builtin_amdgcn_readfirstlane(tid >> 6), lane = tid & 63, wr = wid >> 2, wc = wid & 3, fr = lane & 15, fq = lane >> 4;
    int ntv_ = K / BK; asm volatile("" : "+v"(ntv_)); const int nt = __builtin_amdgcn_readfirstlane(ntv_);
    StaticOrder S; S.init(M, N, (int)gridDim.x, (int)blockIdx.x);
    unsigned voffA[2], voffB[2];
#pragma unroll
    for (int i = 0; i < 2; ++i) { int R, C; stage_rc(tid * 16 + i * 8192, R, C); voffA[i] = (unsigned)(R * lda + C) * 2u; voffB[i] = (unsigned)(R * ldb + C) * 2u; }
    const size_t kstep = (size_t)(BK * 2);
    const size_t hstepA = (size_t)HALF * lda * 2, tstepA = 2 * hstepA, hstepB = (size_t)HALF * ldb * 2, tstepB = 2 * hstepB;
    const unsigned ldsw = (unsigned)wid * 1024u;
    const int aoff = lds_byte(wr * 64 + fr, fq * 8), boff = lds_byte(wc * 32 + fr, fq * 8);
#define PG8_SA(b, h) (((b) * 2 + (h)) * HTB)
#define PG8_SB(b, h) ((4 + (b) * 2 + (h)) * HTB)
#define PG8_STAGE(bufoff, gbase, voff) do { _Pragma("unroll") for (int _i = 0; _i < 2; ++_i) \
        __builtin_amdgcn_global_load_lds((const unsigned*)((const char*)(gbase) + (voff)[_i]), (LAS unsigned*)(lds + (bufoff) + ldsw + _i * 8192), 16, 0, 0); } while (0)
#define PG8_LDA(dst, b, h) do { _Pragma("unroll") for (int m = 0; m < 4; ++m) _Pragma("unroll") for (int k = 0; k < 2; ++k) dst[m][k] = *(const LAS bf16x8*)(lds + PG8_SA(b, h) + aoff + m * 2048 + k * 1024); } while (0)
#define PG8_LDB(dst, b, h) do { _Pragma("unroll") for (int n = 0; n < 2; ++n) _Pragma("unroll") for (int k = 0; k < 2; ++k) dst[n][k] = *(const LAS bf16x8*)(lds + PG8_SB(b, h) + boff + n * 2048 + k * 1024); } while (0)
#define PG8_MMA(ai, bj, At, Bt_) do { __builtin_amdgcn_s_setprio(1); _Pragma("unroll") for (int m = 0; m < 4; ++m) _Pragma("unroll") for (int n = 0; n < 2; ++n) _Pragma("unroll") for (int k = 0; k < 2; ++k) \
        acc[ai][bj][m][n] = __builtin_amdgcn_mfma_f32_16x16x32_bf16(Bt_[n][k], At[m][k], acc[ai][bj][m][n], 0, 0, 0); __builtin_amdgcn_s_setprio(0); } while (0)
#define PG8_WAIT_V(n) asm volatile("s_waitcnt vmcnt(" #n ")" ::: "memory")
#define PG8_WAIT_L(n) asm volatile("s_waitcnt lgkmcnt(" #n ")" ::: "memory")
#define PG8_BAR __builtin_amdgcn_s_barrier()
#define PG8_SCHED __builtin_amdgcn_sched_barrier(0)
    Unit cur, nxt; int ui = 0;
    if (!S.next(0, cur)) return;
    f32x4 acc[2][2][4][2];
#pragma unroll
    for (int a = 0; a < 2; ++a)
#pragma unroll
        for (int b = 0; b < 2; ++b)
#pragma unroll
            for (int m = 0; m < 4; ++m)
#pragma unroll
                for (int n = 0; n < 2; ++n) acc[a][b][m][n] = (f32x4){0.f, 0.f, 0.f, 0.f};
    bf16x8 At[4][2], B0[2][2], B1[2][2];
    const char* cA = (const char*)A + (size_t)cur.pm * tstepA; const char* cB = (const char*)Bt + (size_t)cur.pn * tstepB;
    PG8_STAGE(PG8_SB(0, 0), cB, voffB); PG8_STAGE(PG8_SA(0, 0), cA, voffA); PG8_STAGE(PG8_SB(0, 1), cB + hstepB, voffB); PG8_STAGE(PG8_SA(0, 1), cA + hstepA, voffA);
    if (wr == 1) PG8_BAR;
    PG8_WAIT_V(4); PG8_BAR;
    PG8_STAGE(PG8_SB(1, 0), cB + kstep, voffB); PG8_STAGE(PG8_SA(1, 0), cA + kstep, voffA); PG8_STAGE(PG8_SB(1, 1), cB + hstepB + kstep, voffB);
    PG8_WAIT_V(6); PG8_BAR;
    for (;;) {
        const bool has_next = S.next(ui + 1, nxt);
        const char* nA = has_next ? (const char*)A + (size_t)nxt.pm * tstepA : cA; const char* nB = has_next ? (const char*)Bt + (size_t)nxt.pn * tstepB : cB;
#pragma unroll 1
        for (int t = 0; t < nt; t += 2) {
            const bool last = (t == nt - 2);
            const char* a1 = cA + (size_t)(t + 1) * kstep;
            const char* a2 = last ? nA : cA + (size_t)(t + 2) * kstep; const char* b2 = last ? nB : cB + (size_t)(t + 2) * kstep;
            const char* a3 = a2 + kstep; const char* b3 = b2 + kstep;
            PG8_LDB(B0, 0, 0); PG8_SCHED; PG8_LDA(At, 0, 0); PG8_STAGE(PG8_SA(1, 1), a1 + hstepA, voffA);
            PG8_WAIT_L(8); PG8_BAR; PG8_WAIT_L(0); PG8_MMA(0, 0, At, B0); PG8_BAR; PG8_SCHED;
            PG8_LDB(B1, 0, 1); PG8_STAGE(PG8_SB(0, 0), b2, voffB);
            PG8_BAR; PG8_WAIT_L(0); PG8_MMA(0, 1, At, B1); PG8_BAR;
            PG8_LDA(At, 0, 1); PG8_STAGE(PG8_SA(0, 0), a2, voffA);
            PG8_BAR; PG8_WAIT_L(0); PG8_MMA(1, 0, At, B0); PG8_BAR; PG8_SCHED;
            PG8_STAGE(PG8_SB(0, 1), b2 + hstepB, voffB);
            PG8_WAIT_V(6); PG8_BAR; PG8_MMA(1, 1, At, B1); PG8_BAR;
            PG8_LDB(B0, 1, 0); PG8_SCHED; PG8_LDA(At, 1, 0); PG8_STAGE(PG8_SA(0, 1), a2 + hstepA, voffA);
            PG8_WAIT_L(8); PG8_BAR; PG8_WAIT_L(0); PG8_MMA(0, 0, At, B0); PG8_BAR; PG8_SCHED;
            PG8_LDB(B1, 1, 1); PG8_STAGE(PG8_SB(1, 0), b3, voffB);
            PG8_BAR; PG8_WAIT_L(0); PG8_MMA(0, 1, At, B1); PG8_BAR;
            PG8_LDA(At, 1, 1); PG8_STAGE(PG8_SA(1, 0), a3, voffA);
            PG8_BAR; PG8_WAIT_L(0); PG8_MMA(1, 0, At, B0); PG8_BAR; PG8_SCHED;
            PG8_STAGE(PG8_SB(1, 1), b3 + hstepB, voffB);
            PG8_WAIT_V(6); PG8_BAR; PG8_MMA(1, 1, At, B1); PG8_BAR;
        }
        E(acc, cur, wr, wc, fr, fq);
        if (!has_next) break;
#pragma unroll
        for (int a = 0; a < 2; ++a)
#pragma unroll
            for (int b = 0; b < 2; ++b)
#pragma unroll
                for (int m = 0; m < 4; ++m)
#pragma unroll
                    for (int n = 0; n < 2; ++n) acc[a][b][m][n] = (f32x4){0.f, 0.f, 0.f, 0.f};
        cur = nxt; cA = nA; cB = nB; ++ui;
    }
    PG8_WAIT_V(0);
    if (wr == 0) PG8_BAR;
    PG8_BAR;
#undef PG8_SA
#undef PG8_SB
#undef PG8_STAGE
#undef PG8_LDA
#undef PG8_LDB
#undef PG8_MMA
#undef PG8_WAIT_V
#undef PG8_WAIT_L
#undef PG8_BAR
#undef PG8_SCHED
}

struct EpiIn {
    bf16_t *pa, *pd, *mc, *gt; float* ssq; const float* bg; const float *cd, *sd, *cm, *sm;
    __device__ __forceinline__ void operator()(const f32x4 (&acc)[2][2][4][2], const Unit& u, int wr, int wc, int fr, int fq) const {
        int row0 = u.pm * BM + wr * 64 + fr; asm volatile("" : "+v"(row0) :: "memory"); const int pn = u.pn, cw = wc * 32 + 4 * fq;
        if (pn < 6) {
#pragma unroll
            for (int ai = 0; ai < 2; ++ai)
#pragma unroll
                for (int m = 0; m < 4; ++m) { __builtin_amdgcn_sched_barrier(0); bf16_t* rp = pa + (size_t)(row0 + ai * HALF + m * 16) * 1536 + pn * 256 + cw;
#pragma unroll
                    for (int bj = 0; bj < 2; ++bj)
#pragma unroll
                        for (int n = 0; n < 2; ++n) st_bf4(rp + bj * HALF + n * 16, acc[ai][bj][m][n]); }
        } else if (pn < 12) {
            const bool rope = (pn < 10) && !(wc & 1);
#pragma unroll
            for (int ai = 0; ai < 2; ++ai)
#pragma unroll
                for (int m = 0; m < 4; ++m) { __builtin_amdgcn_sched_barrier(0); const int row = row0 + ai * HALF + m * 16; bf16_t* rp = pd + (size_t)row * 1536 + (pn - 6) * 256 + cw;
                    f32x4 c4 = {1.f, 1.f, 1.f, 1.f}, s4 = {0.f, 0.f, 0.f, 0.f};
                    if (rope) { const int pos = row & (SEQ - 1); c4 = *(const GAS f32x4*)(cd + pos * 8 + (fq & 1) * 4); s4 = *(const GAS f32x4*)(sd + pos * 8 + (fq & 1) * 4); }
#pragma unroll
                    for (int bj = 0; bj < 2; ++bj) { f32x4 v0 = acc[ai][bj][m][0];
                        if (rope) { f32x4 pr;
#pragma unroll
                            for (int j = 0; j < 4; ++j) pr[j] = __shfl_xor(v0[j], 32);
                            v0 = (fq < 2) ? (v0 * c4 - pr * s4) : (v0 * c4 + pr * s4); }
                        st_bf4(rp + bj * HALF, v0); st_bf4(rp + bj * HALF + 16, acc[ai][bj][m][1]); } }
        } else if (pn < 15) {
            const int t = pn - 12;
#pragma unroll
            for (int ai = 0; ai < 2; ++ai)
#pragma unroll
                for (int m = 0; m < 4; ++m) { __builtin_amdgcn_sched_barrier(0); const int row = row0 + ai * HALF + m * 16; bf16_t* rp = mc + (size_t)row * 768 + t * 256 + cw;
#pragma unroll
                    for (int bj = 0; bj < 2; ++bj) { f32x4 v0 = acc[ai][bj][m][0], v1 = acc[ai][bj][m][1];
                        float s = (v0[0] * v0[0] + v0[1] * v0[1]) + (v0[2] * v0[2] + v0[3] * v0[3]) + (v1[0] * v1[0] + v1[1] * v1[1]) + (v1[2] * v1[2] + v1[3] * v1[3]);
                        s += __shfl_xor(s, 16); s += __shfl_xor(s, 32);
                        if (fq == 0) *(GAS float*)(ssq + (size_t)row * 24 + t * 8 + bj * 4 + wc) = s;
                        if (t == 2 && bj == 1 && wc == 0) { const int pos = row & (SEQ - 1); const f32x4 c4 = *(const GAS f32x4*)(cm + pos * 16 + fq * 4), s4 = *(const GAS f32x4*)(sm + pos * 16 + fq * 4);
                            const f32x4 n0 = v0 * c4 - v1 * s4, n1 = v1 * c4 + v0 * s4; v0 = n0; v1 = n1; }
                        st_bf4(rp + bj * HALF, v0); st_bf4(rp + bj * HALF + 16, v1); } }
        } else {
            const int t = pn - 15;
            f32x4 bv[2][2];
#pragma unroll
            for (int bj = 0; bj < 2; ++bj)
#pragma unroll
                for (int n = 0; n < 2; ++n) bv[bj][n] = *(const GAS f32x4*)(bg + t * 256 + bj * HALF + n * 16 + cw);
#pragma unroll
            for (int ai = 0; ai < 2; ++ai)
#pragma unroll
                for (int m = 0; m < 4; ++m) { __builtin_amdgcn_sched_barrier(0); bf16_t* rp = gt + (size_t)(row0 + ai * HALF + m * 16) * 3072 + t * 256 + cw;
#pragma unroll
                    for (int bj = 0; bj < 2; ++bj)
#pragma unroll
                        for (int n = 0; n < 2; ++n) { f32x4 v = acc[ai][bj][m][n] + bv[bj][n];
#pragma unroll
                            for (int j = 0; j < 4; ++j) v[j] = __builtin_amdgcn_rcpf(1.0f + __expf(-v[j]));
                            st_bf4(rp + bj * HALF + n * 16, v); } }
        }
    }
};
struct EpiQ {
    bf16_t* mq; const float* ssq; const float *cm, *sm;
    __device__ __forceinline__ void operator()(const f32x4 (&acc)[2][2][4][2], const Unit& u, int wr, int wc, int fr, int fq) const {
        int row0 = u.pm * BM + wr * 64 + fr; asm volatile("" : "+v"(row0) :: "memory"); const int cw = wc * 32 + 4 * fq;
        float rr8[8];
#pragma unroll
        for (int i = 0; i < 8; ++i) { const float* sp = ssq + (size_t)(row0 + (i >> 2) * HALF + (i & 3) * 16) * 24 + fq * 4;
            const f32x4 a = *(const GAS f32x4*)sp;
            float ss = fq < 3 ? ((a[0] + a[1]) + (a[2] + a[3])) : 0.f;
            ss += __shfl_xor(ss, 16); ss += __shfl_xor(ss, 32);
            rr8[i] = rsqrtf(ss * (1.0f / 384.0f) + 1e-6f); }
#pragma unroll
        for (int ai = 0; ai < 2; ++ai)
#pragma unroll
            for (int m = 0; m < 4; ++m) { __builtin_amdgcn_sched_barrier(0); const int row = row0 + ai * HALF + m * 16; const float r = rr8[ai * 4 + m];
                bf16_t* rp = mq + (size_t)row * 768 + u.pn * 256 + cw;
#pragma unroll
                for (int bj = 0; bj < 2; ++bj) { const int G = u.pn * 8 + bj * 4 + wc; f32x4 v0 = acc[ai][bj][m][0] * r, v1 = acc[ai][bj][m][1] * r;
                    if (G % 3 == 2) { const int pos = row & (SEQ - 1); const f32x4 c4 = *(const GAS f32x4*)(cm + pos * 16 + fq * 4), s4 = *(const GAS f32x4*)(sm + pos * 16 + fq * 4);
                        const f32x4 n0 = v0 * c4 - v1 * s4, n1 = v1 * c4 + v0 * s4; v0 = n0; v1 = n1; }
                    st_bf4(rp + bj * HALF, v0); st_bf4(rp + bj * HALF + 16, v1); } }
    }
};
struct EpiKV {
    bf16_t* mkv; const float* ssq;
    __device__ __forceinline__ void operator()(const f32x4 (&acc)[2][2][4][2], const Unit& u, int wr, int wc, int fr, int fq) const {
        int row0 = u.pm * BM + wr * 64 + fr; asm volatile("" : "+v"(row0) :: "memory"); const int cw = wc * 32 + 4 * fq;
        float rr8[8];
#pragma unroll
        for (int i = 0; i < 8; ++i) { const float* sp = ssq + (size_t)(row0 + (i >> 2) * HALF + (i & 3) * 16) * 24 + 12 + (fq & 1) * 4;
            const f32x4 a = *(const GAS f32x4*)sp;
            float ss = fq < 2 ? ((a[0] + a[1]) + (a[2] + a[3])) : 0.f;
            ss += __shfl_xor(ss, 16); ss += __shfl_xor(ss, 32);
            rr8[i] = rsqrtf(ss * (1.0f / 256.0f) + 1e-6f); }
#pragma unroll
        for (int ai = 0; ai < 2; ++ai)
#pragma unroll
            for (int m = 0; m < 4; ++m) { __builtin_amdgcn_sched_barrier(0); const int row = row0 + ai * HALF + m * 16; const float r = rr8[ai * 4 + m];
                bf16_t* rp = mkv + (size_t)row * 1024 + u.pn * 256 + cw;
#pragma unroll
                for (int bj = 0; bj < 2; ++bj)
#pragma unroll
                    for (int n = 0; n < 2; ++n) st_bf4(rp + bj * HALF + n * 16, acc[ai][bj][m][n] * r); }
    }
};
struct EpiBr {
    const bf16_t* gt; bf16_t* mg;
    int br;
    __device__ __forceinline__ void operator()(const f32x4 (&acc)[2][2][4][2], const Unit& u, int wr, int wc, int fr, int fq) const {
        int row0 = u.pm * BM + wr * 64 + fr; asm volatile("" : "+v"(row0) :: "memory"); const int cw = wc * 32 + 4 * fq;
#pragma unroll
        for (int ai = 0; ai < 2; ++ai)
#pragma unroll
            for (int m = 0; m < 4; ++m) { __builtin_amdgcn_sched_barrier(0); const size_t rr_ = (size_t)(row0 + ai * HALF + m * 16); const bf16_t* gp = gt + rr_ * 3072 + br * 1024 + u.pn * 256 + cw; bf16_t* rp = mg + rr_ * 1024 + u.pn * 256 + cw;
#pragma unroll
                for (int bj = 0; bj < 2; ++bj)
#pragma unroll
                    for (int n = 0; n < 2; ++n) { bf16_t* p = rp + bj * HALF + n * 16; const u32x2 g = *(const GAS u32x2*)(gp + bj * HALF + n * 16); const f32x4 a = acc[ai][bj][m][n];
                        f32x4 v; v[0] = a[0] * __uint_as_float(g.x << 16); v[1] = a[1] * __uint_as_float(g.x & 0xffff0000u); v[2] = a[2] * __uint_as_float(g.y << 16); v[3] = a[3] * __uint_as_float(g.y & 0xffff0000u);
                        if (br > 0) { const unsigned long long pv = __hip_atomic_load((const GAS unsigned long long*)p, __ATOMIC_RELAXED, __HIP_MEMORY_SCOPE_AGENT); const unsigned lo = (unsigned)pv, hi = (unsigned)(pv >> 32);
                            v[0] += __uint_as_float(lo << 16); v[1] += __uint_as_float(lo & 0xffff0000u); v[2] += __uint_as_float(hi << 16); v[3] += __uint_as_float(hi & 0xffff0000u); }
                        st_bf4(p, v); } }
    }
};
struct EpiRes {
    float* x;
    __device__ __forceinline__ void operator()(const f32x4 (&acc)[2][2][4][2], const Unit& u, int wr, int wc, int fr, int fq) const {
        int row0 = u.pm * BM + wr * 64 + fr; asm volatile("" : "+v"(row0) :: "memory"); const int cw = wc * 32 + 4 * fq;
#pragma unroll
        for (int ai = 0; ai < 2; ++ai)
#pragma unroll
            for (int m = 0; m < 4; ++m) { __builtin_amdgcn_sched_barrier(0); float* rp = x + (size_t)(row0 + ai * HALF + m * 16) * 1024 + u.pn * 256 + cw;
#pragma unroll
                for (int bj = 0; bj < 2; ++bj)
#pragma unroll
                    for (int n = 0; n < 2; ++n) { float* p = rp + bj * HALF + n * 16; const f32x4 xv = *(const GAS f32x4*)p; *(GAS f32x4*)p = xv * DN_ALPHA + acc[ai][bj][m][n]; } }
    }
};
struct EpiF1 {
    bf16_t* hd;
    __device__ __forceinline__ void operator()(const f32x4 (&acc)[2][2][4][2], const Unit& u, int wr, int wc, int fr, int fq) const {
        int row0 = u.pm * BM + wr * 64 + fr; asm volatile("" : "+v"(row0) :: "memory"); const int cw = wc * 32 + 4 * fq;
#pragma unroll
        for (int ai = 0; ai < 2; ++ai)
#pragma unroll
            for (int m = 0; m < 4; ++m) { __builtin_amdgcn_sched_barrier(0); bf16_t* rp = hd + (size_t)(row0 + ai * HALF + m * 16) * DFF + u.pn * 128 + cw;
#pragma unroll
                for (int n = 0; n < 2; ++n) { const f32x4 g = acc[ai][0][m][n], uu = acc[ai][1][m][n]; f32x4 v;
#pragma unroll
                    for (int j = 0; j < 4; ++j) v[j] = g[j] * __builtin_amdgcn_rcpf(1.0f + __expf(-g[j])) * uu[j];
                    st_bf4(rp + n * 16, v); } }
    }
};

constexpr int SHM_V = 64 * 128 * 2, SHM_K = 64 * 128 * 2;
#define KSWZ(row, colB) ((row) * 256 + ((colB) ^ (((row) & 7) << 4)))
#define SBAR() __builtin_amdgcn_sched_barrier(0)
__device__ __forceinline__ int crow(int r, int hi) { return (r & 3) + 8 * (r >> 2) + 4 * hi; }
struct NaCtx { int vlo, vhi, wstart, qc, drow0; const LAS float* tab; };

template <int MODE>
__device__ __forceinline__ void partialSM(f32x16& p0, f32x16& p1, float& m_reg, float& mn, float& alpha, const NaCtx& na, int t, int hi) {
    constexpr float SCALE = MODE == 2 ? 0.10206207261596575f : 0.125f;
    constexpr float C = SCALE * 1.4426950408889634f;
    constexpr float THRS = 8.f / SCALE;
    if (MODE == 0) {
        const float NINF = -__builtin_inff();
        if (t < na.vlo || t >= na.vhi) {
#pragma unroll
            for (int r = 0; r < 16; ++r) { p0[r] = NINF; p1[r] = NINF; }
        } else {
            const LAS float* trow = na.tab + (na.drow0 + t) * 31 + (15 - na.qc);
#pragma unroll
            for (int q4 = 0; q4 < 4; ++q4) {
#pragma unroll
                for (int r = q4 * 4; r < q4 * 4 + 4; ++r) { const int kc = crow(r, hi); const bool ok0 = (unsigned)(kc - na.wstart) < 16u, ok1 = (unsigned)(kc + 32 - na.wstart) < 16u;
                    const float b0 = trow[ok0 ? kc : na.wstart], b1 = trow[ok1 ? kc + 32 : na.wstart];
                    p0[r] = ok0 ? p0[r] + b0 : NINF; p1[r] = ok1 ? p1[r] + b1 : NINF; }
                __builtin_amdgcn_sched_barrier(0); }
        }
    }
    float pmax = p0[0];
#pragma unroll
    for (int r = 1; r < 16; ++r) pmax = fmaxf(pmax, p0[r]);
#pragma unroll
    for (int r = 0; r < 16; ++r) pmax = fmaxf(pmax, p1[r]);
    { auto rr = __builtin_amdgcn_permlane32_swap(__float_as_uint(pmax), __float_as_uint(pmax), false, false);
      pmax = fmaxf(__uint_as_float(rr[0]), __uint_as_float(rr[1])); }
    if (__builtin_expect(__all(pmax - m_reg <= THRS), 1)) { mn = m_reg; alpha = 1.f; }
    else { mn = fmaxf(m_reg, pmax); alpha = __builtin_amdgcn_exp2f((m_reg - mn) * C); m_reg = mn; }
    const float mnC = -mn * C;
#pragma unroll
    for (int r = 0; r < 16; ++r) p0[r] = fmaf(p0[r], C, mnC);
#pragma unroll
    for (int r = 0; r < 16; ++r) p1[r] = fmaf(p1[r], C, mnC);
#pragma unroll
    for (int r = 0; r < 16; ++r) p0[r] = __builtin_amdgcn_exp2f(p0[r]);
}
__device__ __forceinline__ void finishSM(f32x16& p0, f32x16& p1, float alpha, float& l_reg, bf16x8& pa0, bf16x8& pa1, bf16x8& pa2, bf16x8& pa3) {
#pragma unroll
    for (int r = 0; r < 16; ++r) p1[r] = __builtin_amdgcn_exp2f(p1[r]);
    float ps = 0;
#pragma unroll
    for (int r = 0; r < 16; ++r) ps += p0[r];
#pragma unroll
    for (int r = 0; r < 16; ++r) ps += p1[r];
    { auto rr = __builtin_amdgcn_permlane32_swap(__float_as_uint(ps), __float_as_uint(ps), false, false);
      ps = __uint_as_float(rr[0]) + __uint_as_float(rr[1]); }
    l_reg = l_reg * alpha + ps;
#define PK4(P, BASE, OUT) do { unsigned a0 = cvtpk(P[BASE + 0], P[BASE + 1]), a1 = cvtpk(P[BASE + 2], P[BASE + 3]);   \
    unsigned b0 = cvtpk(P[BASE + 4], P[BASE + 5]), b1 = cvtpk(P[BASE + 6], P[BASE + 7]);                              \
    auto r0 = __builtin_amdgcn_permlane32_swap(a0, b0, false, false); auto r1 = __builtin_amdgcn_permlane32_swap(a1, b1, false, false); \
    u32x4 w = {r0[0], r1[0], r0[1], r1[1]}; OUT = *reinterpret_cast<bf16x8*>(&w); } while (0)
    PK4(p0, 0, pa0); PK4(p0, 8, pa1); PK4(p1, 0, pa2); PK4(p1, 8, pa3);
#undef PK4
}
template <int ND>
__device__ __forceinline__ void qkt(f32x16& p0, f32x16& p1, const char* Ks, const bf16x8* qr, int r32, int hi) {
    p0 = f32x16{}; p1 = f32x16{};
#pragma unroll
    for (int d0 = 0; d0 < ND; ++d0) { const int cb = (d0 * 16 + hi * 8) * 2;
        const bf16x8 b0 = *reinterpret_cast<const bf16x8*>(Ks + KSWZ(r32, cb));
        const bf16x8 b1 = *reinterpret_cast<const bf16x8*>(Ks + KSWZ(32 + r32, cb));
        p0 = __builtin_amdgcn_mfma_f32_32x32x16_bf16(b0, qr[d0], p0, 0, 0, 0);
        p1 = __builtin_amdgcn_mfma_f32_32x32x16_bf16(b1, qr[d0], p1, 0, 0, 0); }
}
__device__ __forceinline__ int v_st(int k, int c) { const int kk = (k & ~0xC) | ((k & 4) << 1) | ((k & 8) >> 1); return ((kk >> 3) * 4 + (c >> 5)) * 512 + ((kk & 7) * 32 + (c & 31)) * 2; }
__device__ __forceinline__ int v_rd_base(int lane) { return ((lane & 3) << 3) | (((lane >> 2) & 3) << 6) | (((lane >> 4) & 1) << 5) | (((lane >> 5) & 1) << 8); }
constexpr int v_rd_off(int d0, int ks, int half) { return d0 * 512 + ks * 4096 + half * 2048; }
template <int OFF> __device__ __forceinline__ s16x4 tr_read(int vb) {
    s16x4 r; asm volatile("ds_read_b64_tr_b16 %0, %1 offset:%2" : "=&v"(r) : "v"(vb), "i"(OFF) : "memory"); return r;
}
template <int D0> __device__ __forceinline__ void pv_one(f32x16& od, int vb, bf16x8 pa0, bf16x8 pa1, bf16x8 pa2, bf16x8 pa3) {
    const s16x4 l0 = tr_read<v_rd_off(D0, 0, 0)>(vb), h0 = tr_read<v_rd_off(D0, 0, 1)>(vb), l1 = tr_read<v_rd_off(D0, 1, 0)>(vb), h1 = tr_read<v_rd_off(D0, 1, 1)>(vb);
    const s16x4 l2 = tr_read<v_rd_off(D0, 2, 0)>(vb), h2 = tr_read<v_rd_off(D0, 2, 1)>(vb), l3 = tr_read<v_rd_off(D0, 3, 0)>(vb), h3 = tr_read<v_rd_off(D0, 3, 1)>(vb);
    asm volatile("s_waitcnt lgkmcnt(0)" ::: "memory"); SBAR();
#define PKV(L, H) (bf16x8){L[0], L[1], L[2], L[3], H[0], H[1], H[2], H[3]}
    od = __builtin_amdgcn_mfma_f32_32x32x16_bf16(pa0, PKV(l0, h0), od, 0, 0, 0);
    od = __builtin_amdgcn_mfma_f32_32x32x16_bf16(pa1, PKV(l1, h1), od, 0, 0, 0);
    od = __builtin_amdgcn_mfma_f32_32x32x16_bf16(pa2, PKV(l2, h2), od, 0, 0, 0);
    od = __builtin_amdgcn_mfma_f32_32x32x16_bf16(pa3, PKV(l3, h3), od, 0, 0, 0);
#undef PKV
}
template <int NO> __device__ __forceinline__ void pv_d0(f32x16* o, int vb, bf16x8 pa0, bf16x8 pa1, bf16x8 pa2, bf16x8 pa3) {
    pv_one<0>(o[0], vb, pa0, pa1, pa2, pa3); pv_one<1>(o[1], vb, pa0, pa1, pa2, pa3);
    if constexpr (NO == 4) { pv_one<2>(o[2], vb, pa0, pa1, pa2, pa3); pv_one<3>(o[3], vb, pa0, pa1, pa2, pa3); }
}

template <int DQ, int DV, int MODE, int ldq, int ldk, int ldk2, int ldv, int SD>
__device__ __forceinline__ void attn_core(const bf16_t* __restrict__ Qb, const bf16_t* __restrict__ K1, const bf16_t* __restrict__ K2,
                                          const bf16_t* __restrict__ Vh, int NT, char* lds, f32x16 (&o)[DV / 32], float (&rli)[16], const NaCtx& na) {
    constexpr int ND = DQ / 16, NO = DV / 32;
    const int tid = otid(), wid = tid >> 6, lane = tid & 63, r32 = lane & 31, hi = lane >> 5;
    char* V_lds = lds; char* K_lds = lds + 2 * SHM_V;
    float* ws = (float*)(lds + 2 * SHM_V + 2 * SHM_K) + wid * 64; float* li_l = ws; float* al_l = ws + 32;
    float m_reg = -1e30f, l_reg = 0;
#pragma unroll
    for (int d = 0; d < NO; ++d) o[d] = f32x16{};
    bf16x8 qr[ND];
    const bf16_t* Qw = Qb + (long)(wid * 32 + r32) * ldq + hi * 8;
#pragma unroll
    for (int d0 = 0; d0 < ND; ++d0) qr[d0] = *(const GAS bf16x8*)(Qw + d0 * 16);
    const int sr = tid >> 4, sc = (tid & 15) * 8, vst0 = v_st(sr, sc), vst1 = v_st(32 + sr, sc);
    const int vb0 = (int)(uintptr_t)V_lds + v_rd_base(lane);
    const bool ldV = sc < DV, ldK = sc < DQ;
    const bf16_t* kp; long kld;
    if (DQ > 64 && sc >= 64) { kp = K2 + (sc - 64); kld = ldk2; } else { kp = K1 + sc; kld = ldk; }
    const bf16_t* vp = Vh + sc;
    struct Slot { bf16x8 vs0, vs1, ks0, ks1; };
    Slot sA, sB; sA.vs0 = sA.vs1 = sA.ks0 = sA.ks1 = bf16x8{}; sB = sA;
    Slot& sO = (SD == 2) ? sB : sA;
#define SLOAD(S_, k0) do { if (ldV) { S_.vs0 = *(const GAS bf16x8*)(vp + (long)((k0) + sr) * ldv); S_.vs1 = *(const GAS bf16x8*)(vp + (long)((k0) + 32 + sr) * ldv); } \
    if (ldK) { S_.ks0 = *(const GAS bf16x8*)(kp + (long)((k0) + sr) * kld); S_.ks1 = *(const GAS bf16x8*)(kp + (long)((k0) + 32 + sr) * kld); } } while (0)
#define SWRITE(b, S_) do { if (ldV) { *(bf16x8*)(V_lds + (b) * SHM_V + vst0) = S_.vs0; *(bf16x8*)(V_lds + (b) * SHM_V + vst1) = S_.vs1; } \
    if (ldK) { const int kc = sc * 2; *(bf16x8*)(K_lds + (b) * SHM_K + KSWZ(sr, kc)) = S_.ks0; *(bf16x8*)(K_lds + (b) * SHM_K + KSWZ(32 + sr, kc)) = S_.ks1; } } while (0)
#define SWAIT() do { if (SD == 2) asm volatile("s_waitcnt vmcnt(4)" ::: "memory"); else asm volatile("s_waitcnt vmcnt(0)" ::: "memory"); } while (0)
#define RESC(a) do { if (__any((a) < 1.f)) { if (hi == 0) al_l[r32] = (a); asm volatile("s_waitcnt lgkmcnt(0)" ::: "memory"); \
    _Pragma("unroll") for (int d = 0; d < NO; ++d) _Pragma("unroll") for (int r = 0; r < 16; ++r) o[d][r] *= al_l[crow(r, hi)]; } } while (0)
    f32x16 pA0, pA1, pB0, pB1; float mnA, mnB, alA, alB; bf16x8 pa0, pa1, pa2, pa3;
    SLOAD(sA, 0); asm volatile("s_waitcnt vmcnt(0)" ::: "memory"); SWRITE(0, sA); __syncthreads();
    qkt<ND>(pA0, pA1, K_lds, qr, r32, hi); partialSM<MODE>(pA0, pA1, m_reg, mnA, alA, na, 0, hi);
    SLOAD(sO, 64); if (SD == 2 && 2 < NT) SLOAD(sA, 128);
    SWAIT(); SWRITE(1, sO); __syncthreads();
    for (int j = 1; j + 1 < NT; j += 2) {
        SBAR(); qkt<ND>(pB0, pB1, K_lds + SHM_K, qr, r32, hi);
        finishSM(pA0, pA1, alA, l_reg, pa0, pa1, pa2, pa3); SBAR();
        SLOAD(sO, (j + SD) * 64); SBAR();
        pv_d0<NO>(o, vb0, pa0, pa1, pa2, pa3); partialSM<MODE>(pB0, pB1, m_reg, mnB, alB, na, j, hi);
        __syncthreads(); SWAIT(); SWRITE(0, sA);
        RESC(alB); __syncthreads();
        SBAR(); qkt<ND>(pA0, pA1, K_lds, qr, r32, hi);
        finishSM(pB0, pB1, alB, l_reg, pa0, pa1, pa2, pa3); SBAR();
        if (SD == 1 || j + 3 < NT) SLOAD(sA, (j + 1 + SD) * 64); SBAR();
        pv_d0<NO>(o, vb0 + SHM_V, pa0, pa1, pa2, pa3); partialSM<MODE>(pA0, pA1, m_reg, mnA, alA, na, j + 1, hi);
        __syncthreads(); SWAIT(); SWRITE(1, sO);
        RESC(alA); __syncthreads();
    }
    SBAR(); qkt<ND>(pB0, pB1, K_lds + SHM_K, qr, r32, hi);
    finishSM(pA0, pA1, alA, l_reg, pa0, pa1, pa2, pa3); SBAR();
    pv_d0<NO>(o, vb0, pa0, pa1, pa2, pa3); partialSM<MODE>(pB0, pB1, m_reg, mnB, alB, na, NT - 1, hi);
    __syncthreads(); RESC(alB);
    finishSM(pB0, pB1, alB, l_reg, pa0, pa1, pa2, pa3); SBAR();
    pv_d0<NO>(o, vb0 + SHM_V, pa0, pa1, pa2, pa3);
    if (hi == 0) li_l[r32] = l_reg;
    asm volatile("s_waitcnt lgkmcnt(0)" ::: "memory");
#pragma unroll
    for (int r = 0; r < 16; ++r) rli[r] = __builtin_amdgcn_rcpf(li_l[crow(r, hi)]);
#undef SLOAD
#undef SWRITE
#undef SWAIT
#undef RESC
}

__device__ __forceinline__ void na_item(const Params& p, int l, int item, char* lds) {
    const int xcd = item & 7, slot = item >> 3;
    const int pair = xcd * 4 + (slot >> 4), rb = slot & 15, b = pair >> 3, h = pair & 7;
    bf16_t* pa = (bf16_t*)(p.ws + OFF_PA);
    const int r0 = rb * 4, lo = min(max(r0 - 4, 0), 52);
    const int tid = otid(), wid = tid >> 6, lane = tid & 63, r32 = lane & 31, hi = lane >> 5;
    LAS float* tab = (LAS float*)((LAS unsigned char*)(uintptr_t)(unsigned)(uintptr_t)lds + 130 * 1024);
    const float* rpb = p.in[5] + ((size_t)l * 8 + h) * 465;
    if (tid < 465) tab[tid] = ((const GAS float*)rpb)[tid] * 8.0f;
    NaCtx na; const int wu = __builtin_amdgcn_readfirstlane(wid); const int r = r0 + (wu >> 1), qc = 32 * (wu & 1) + r32, rs = min(max(r - 4, 0), 56);
    na.vlo = rs - lo; na.vhi = na.vlo + 8; na.wstart = min(max(qc - 8, 0), 48); na.qc = qc; na.drow0 = lo - r + 7; na.tab = tab;
    const size_t tb = (size_t)b * SEQ;
    bf16_t* Q = pa + (tb + (size_t)r0 * 64) * 1536 + h * 64;
    const bf16_t* K = pa + (tb + (size_t)lo * 64) * 1536 + 512 + h * 64;
    const bf16_t* V = K + 512;
    f32x16 o[2]; float rli[16];
    attn_core<64, 64, 0, 1536, 1536, 1536, 1536, 1>(Q, K, K, V, 12, lds, o, rli, na);
    bf16_t* Ow = Q + (size_t)(wid * 32) * 1536;
#pragma unroll
    for (int rr = 0; rr < 16; ++rr) { const int orow = crow(rr, hi);
#pragma unroll
        for (int d = 0; d < 2; ++d) { const float v = o[d][rr] * rli[rr]; ((GAS bf16_t*)Ow)[(size_t)orow * 1536 + d * 32 + r32] = (bf16_t)(cvtpk(v, v) & 0xffffu); } }
    __syncthreads();
}
__device__ __forceinline__ void diff_item(const Params& p, int l, int item, char* lds) {
    const int xcd = item & 7, slot = item >> 3;
    const int pair = xcd * 2 + (slot >> 4), qb = slot & 15, b = pair >> 2, h = pair & 3;
    bf16_t* pd = (bf16_t*)(p.ws + OFF_PD);
    const int tid = otid(), wid = tid >> 6, lane = tid & 63, r32 = lane & 31, hi = lane >> 5;
    const float* lv = p.in[6] + (size_t)l * 256;
    float s1 = 0.f, s2 = 0.f;
    for (int i = 0; i < 64; ++i) { s1 += ((const GAS float*)lv)[i] * ((const GAS float*)lv)[64 + i]; s2 += ((const GAS float*)lv)[128 + i] * ((const GAS float*)lv)[192 + i]; }
    const float lam_init = p.lam_init[l], lam = __expf(s1) - __expf(s2) + lam_init;
    const size_t tb = (size_t)b * SEQ;
    bf16_t* Q = pd + (tb + (size_t)qb * 256) * 1536 + h * 128;
    const bf16_t* K = pd + tb * 1536 + 512 + h * 128;
    const bf16_t* V = pd + tb * 1536 + 1024 + h * 128;
    NaCtx na{};
    unsigned short* stash = (unsigned short*)(lds + 66 * 1024) + (size_t)wid * 64 * 64 + lane;
    f32x16 o[4]; float rli[16];
    attn_core<64, 128, 1, 1536, 1536, 1536, 1536, 2>(Q, K, K, V, 64, lds, o, rli, na);
#pragma unroll
    for (int d = 0; d < 4; ++d)
#pragma unroll
        for (int rr = 0; rr < 16; ++rr) { const float v = o[d][rr] * rli[rr]; stash[(d * 16 + rr) * 64] = (unsigned short)(cvtpk(v, v) & 0xffffu); }
    __syncthreads();
    attn_core<64, 128, 1, 1536, 1536, 1536, 1536, 2>(Q + 64, K + 64, K, V, 64, lds, o, rli, na);
    const float* sg = p.in[7] + (size_t)l * 128;
    float gcol[4];
#pragma unroll
    for (int d = 0; d < 4; ++d) gcol[d] = ((const GAS float*)sg)[d * 32 + r32] * (1.0f - lam_init);
    bf16_t* Ow = Q + (size_t)(wid * 32) * 1536;
#pragma unroll
    for (int rr = 0; rr < 16; ++rr) {
        float v[4]; float ss = 0.f;
#pragma unroll
        for (int d = 0; d < 4; ++d) { v[d] = bf2f(stash[(d * 16 + rr) * 64]) - lam * (o[d][rr] * rli[rr]); ss += v[d] * v[d]; }
        ss += __shfl_xor(ss, 1); ss += __shfl_xor(ss, 2); ss += __shfl_xor(ss, 4); ss += __shfl_xor(ss, 8); ss += __shfl_xor(ss, 16);
        const float rn = rsqrtf(ss * (1.0f / 128.0f) + 1e-6f);
        const int orow = crow(rr, hi);
#pragma unroll
        for (int d = 0; d < 4; ++d) { const float y = v[d] * rn * gcol[d]; ((GAS bf16_t*)Ow)[(size_t)orow * 1536 + d * 32 + r32] = (bf16_t)(cvtpk(y, y) & 0xffffu); }
    }
    __syncthreads();
}
__device__ __forceinline__ void mla_item(const Params& p, int item, char* lds) {
    const int xcd = item & 7, slot = item >> 3;
    const int pair = xcd * 4 + (slot >> 4), qb = slot & 15, b = pair >> 3, h = pair & 7;
    const int tid = otid(), wid = tid >> 6, lane = tid & 63, r32 = lane & 31, hi = lane >> 5;
    bf16_t* mc = (bf16_t*)(p.ws + OFF_MC); const bf16_t* mq = (const bf16_t*)(p.ws + OFF_MQ); const bf16_t* mkv = (const bf16_t*)(p.ws + OFF_MKV);
    const size_t tb = (size_t)b * SEQ;
    const bf16_t* Q = mq + (tb + (size_t)qb * 256) * 768 + h * 96;
    const bf16_t* K1 = mkv + tb * 1024 + h * 128;
    const bf16_t* K2 = mc + tb * 768 + 640;
    const bf16_t* V = K1 + 64;
    NaCtx na{};
    f32x16 o[2]; float rli[16];
    attn_core<96, 64, 2, 768, 1024, 768, 1024, 2>(Q, K1, K2, V, 64, lds, o, rli, na);
    bf16_t* Ow = mc + (tb + (size_t)qb * 256 + wid * 32) * 768 + h * 64;
#pragma unroll
    for (int rr = 0; rr < 16; ++rr) { const int orow = crow(rr, hi);
#pragma unroll
        for (int d = 0; d < 2; ++d) { const float v = o[d][rr] * rli[rr]; ((GAS bf16_t*)Ow)[(size_t)orow * 768 + d * 32 + r32] = (bf16_t)(cvtpk(v, v) & 0xffffu); } }
    __syncthreads();
}

struct MapId { __device__ __forceinline__ int operator()(int n) const { return n; } };
struct MapIn { __device__ __forceinline__ int operator()(int n) const { return n < 3744 ? n : (n < 3840 ? -1 : n - 96); } };
struct MapF1 { __device__ __forceinline__ int operator()(int n) const { const int pt = n >> 8, r = n & 255; return r < 128 ? pt * 128 + r : DFF + pt * 128 + (r - 128); } };
template <class Map>
__device__ __forceinline__ void prep_w(const float* __restrict__ src, int Ks, int Ns, bf16_t* __restrict__ dst, int Nd, int Kd, const float* __restrict__ kscale, Map map, float* tile) {
    const int tid = otid(), tx = tid & 63, ty = tid >> 6, nk = Kd / 64, ntile = (Nd / 64) * nk;
    for (int t = blockIdx.x; t < ntile; t += gridDim.x) {
        const int n0 = (t / nk) * 64, k0 = (t % nk) * 64;
        const int ns = map(n0 + tx);
#pragma unroll
        for (int j = 0; j < 8; ++j) { const int kl = ty + 8 * j, ks = (k0 + kl) % Ks; float v = 0.f;
            if (ns >= 0) { v = ((const GAS float*)src)[(size_t)ks * Ns + ns]; if (kscale) v *= ((const GAS float*)kscale)[ks]; }
            tile[kl * 65 + tx] = v; }
        __syncthreads();
        const int kx = (tid & 31) * 2, ny = tid >> 5;
#pragma unroll
        for (int j = 0; j < 4; ++j) { const int nl = ny + 16 * j;
            *(GAS unsigned*)(dst + (size_t)(n0 + nl) * Kd + k0 + kx) = cvtpk(tile[kx * 65 + nl], tile[(kx + 1) * 65 + nl]); }
        __syncthreads();
    }
}
__device__ __forceinline__ void ln_rows(const float* src, float* dstf, bf16_t* dstb, const float* __restrict__ g, const float* __restrict__ bta, int row0, int nrows) {
    const int tid_ = otid(); const int lane = tid_ & 63, wv = blockIdx.x * 8 + (tid_ >> 6), nw = gridDim.x * 8;
    f32x4 gv[4], bv[4];
#pragma unroll
    for (int i = 0; i < 4; ++i) { gv[i] = *(const GAS f32x4*)(g + i * 256 + lane * 4); bv[i] = *(const GAS f32x4*)(bta + i * 256 + lane * 4); }
    for (int r = wv; r < nrows; r += nw) {
        const size_t ro = (size_t)(row0 + r) * 1024;
        f32x4 v[4]; float s = 0.f;
#pragma unroll
        for (int i = 0; i < 4; ++i) { v[i] = *(const GAS f32x4*)(src + ro + i * 256 + lane * 4); s += (v[i][0] + v[i][1]) + (v[i][2] + v[i][3]); }
#pragma unroll
        for (int k = 1; k < 64; k <<= 1) s += __shfl_xor(s, k);
        const float mu = s * (1.0f / 1024.0f); float q = 0.f;
#pragma unroll
        for (int i = 0; i < 4; ++i) { v[i] = v[i] - mu; q += (v[i][0] * v[i][0] + v[i][1] * v[i][1]) + (v[i][2] * v[i][2] + v[i][3] * v[i][3]); }
#pragma unroll
        for (int k = 1; k < 64; k <<= 1) q += __shfl_xor(q, k);
        const float rstd = rsqrtf(q * (1.0f / 1024.0f) + 1e-5f);
#pragma unroll
        for (int i = 0; i < 4; ++i) { const f32x4 y = v[i] * rstd * gv[i] + bv[i]; *(GAS f32x4*)(dstf + ro + i * 256 + lane * 4) = y;
            if (dstb) st_bf4(dstb + ro + i * 256 + lane * 4, y); }
    }
}

#ifndef PHMASK
#define PHMASK 0xffff
#endif
#define WSP(T_, off) ((T_*)(wsb + (off)))
__device__ __forceinline__ void gsync(cg::grid_group& g) { asm volatile("s_waitcnt vmcnt(0)" ::: "memory"); g.sync(); __builtin_amdgcn_fence(__ATOMIC_ACQUIRE, "agent"); }
__global__ __launch_bounds__(512, 2) void fwd_megakernel(Params p) {
    extern __shared__ __attribute__((aligned(16))) unsigned char shm[];
    cg::grid_group grid = cg::this_grid();
    LAS unsigned char* ldsg = (LAS unsigned char*)shm;
    char* lds = (char*)shm;
    if (PHMASK & 512) {
        unsigned char* wsb = p.ws;
        float* tile = (float*)shm;
        for (int l = 0; l < DEPTH; ++l) {
            prep_w(p.in[3] + (size_t)l * 1024 * 6816, 1024, 6816, WSP(bf16_t, OFF_WIN) + (size_t)l * NIN * 1024, NIN, 1024, nullptr, MapIn(), tile);
            prep_w(p.in[10] + (size_t)l * 384 * 768, 384, 768, WSP(bf16_t, OFF_WQB) + (size_t)l * 768 * 384, 768, 384, p.in[8] + l * 384, MapId(), tile);
            prep_w(p.in[11] + (size_t)l * 256 * 1024, 256, 1024, WSP(bf16_t, OFF_WKVB) + (size_t)l * 1024 * 256, 1024, 256, p.in[9] + l * 256, MapId(), tile);
            for (int i = 0; i < 3; ++i)
                prep_w(p.in[12] + ((size_t)l * 3 + i) * 512 * 1024, 512, 1024, WSP(bf16_t, OFF_WBR) + ((size_t)l * 3 + i) * 1024 * 512, 1024, 512, nullptr, MapId(), tile);
            prep_w(p.in[13] + (size_t)l * 1024 * 1024, 1024, 1024, WSP(bf16_t, OFF_WOUT) + (size_t)l * 1024 * 3072, 1024, 3072, nullptr, MapId(), tile);
            prep_w(p.in[16] + (size_t)l * 1024 * 5632, 1024, 5632, WSP(bf16_t, OFF_WF1) + (size_t)l * 5632 * 1024, 5632, 1024, nullptr, MapF1(), tile);
            prep_w(p.in[17] + (size_t)l * 2816 * 1024, 2816, 1024, WSP(bf16_t, OFF_WF2) + (size_t)l * 1024 * 2816, 1024, 2816, nullptr, MapId(), tile);
        }
        const int gtid = blockIdx.x * 512 + otid(), gn = gridDim.x * 512;
        const float nlt = -13.122363377404328f;
        float* cd = WSP(float, OFF_TD); float* sd = cd + SEQ * 8; float* cm = WSP(float, OFF_TM); float* sm = cm + SEQ * 16;
        for (int i = gtid; i < SEQ * 8; i += gn) { const int pos = i >> 3, f = i & 7; const float inv = expf(nlt * (float)f / 8.0f), ang = (float)pos * inv; ((GAS float*)cd)[i] = cosf(ang); ((GAS float*)sd)[i] = sinf(ang); }
        for (int i = gtid; i < SEQ * 16; i += gn) { const int pos = i >> 4, f = i & 15; const float inv = expf(nlt * (float)f / 16.0f), ang = (float)pos * inv; ((GAS float*)cm)[i] = cosf(ang); ((GAS float*)sm)[i] = sinf(ang); }
        ln_rows(p.in[0], p.out, WSP(bf16_t, OFF_XB), p.in[1], p.in[2], 0, T_ALL);
    }
    gsync(grid);
    for (int step = 0; step < DEPTH * 13; ++step) {
      const int l = step / 13, ls = step % 13, nsub = ls == 4 ? 2 : 1;
      for (int sub = 0; sub < nsub; ++sub) {
        int ck, ph;
        if (ls < 4) { ck = 0; ph = ls; } else if (ls == 4) { ck = sub; ph = sub == 0 ? 4 : 0; } else if (ls < 9) { ck = 1; ph = ls - 4; } else { ck = 0; ph = ls - 4; }
        const size_t tok0 = ls < 9 ? (size_t)ck * TC : 0;
        const int mrows = ls < 9 ? TC : T_ALL;
        unsigned wlo_ = (unsigned)(uintptr_t)p.ws, whi_ = (unsigned)((uintptr_t)p.ws >> 32); asm volatile("" : "+v"(wlo_), "+v"(whi_));
        unsigned char* wsb = (unsigned char*)(((uintptr_t)(unsigned)__builtin_amdgcn_readfirstlane((int)whi_) << 32) | (uintptr_t)(unsigned)__builtin_amdgcn_readfirstlane((int)wlo_));
        switch (ph) {
        case 0: if (PHMASK & 1) {
            float* cd = WSP(float, OFF_TD); float* cm = WSP(float, OFF_TM);
            EpiIn E{WSP(bf16_t, OFF_PA), WSP(bf16_t, OFF_PD), WSP(bf16_t, OFF_MC), WSP(bf16_t, OFF_GT), WSP(float, OFF_SSQ), p.in[4] + (size_t)l * 3072, cd, cd + SEQ * 8, cm, cm + SEQ * 16};
            gemm_phase(ldsg, WSP(bf16_t, OFF_XB) + tok0 * 1024, 1024, WSP(bf16_t, OFF_WIN) + (size_t)l * NIN * 1024, 1024, TC, NIN, 1024, E);
        } break;
        case 1: if (PHMASK & 2) {
            if (PHMASK & 1024) { EpiKV E{WSP(bf16_t, OFF_MKV), WSP(float, OFF_SSQ)}; gemm_phase(ldsg, WSP(bf16_t, OFF_MC) + 384, 768, WSP(bf16_t, OFF_WKVB) + (size_t)l * 1024 * 256, 256, TC, 1024, 256, E); }
            if (PHMASK & 2048) { float* cm = WSP(float, OFF_TM); EpiQ E{WSP(bf16_t, OFF_MQ), WSP(float, OFF_SSQ), cm, cm + SEQ * 16}; gemm_phase(ldsg, WSP(bf16_t, OFF_MC), 768, WSP(bf16_t, OFF_WQB) + (size_t)l * 768 * 384, 384, TC, 768, 384, E); }
            __syncthreads();
            if (PHMASK & 4096) for (int it = blockIdx.x; it < 512; it += gridDim.x) na_item(p, l, it, lds);
        } break;
        case 2: if (PHMASK & 4) {
            if (PHMASK & 8192) for (int it = blockIdx.x; it < 256; it += gridDim.x) diff_item(p, l, it, lds);
            if (PHMASK & 16384) for (int it = blockIdx.x; it < 512; it += gridDim.x) mla_item(p, it, lds);
        } break;
        case 3: if (PHMASK & 8) {
            for (int i = 0; i < 3; ++i) {
                const bf16_t* A = i == 0 ? WSP(bf16_t, OFF_PA) : (i == 1 ? WSP(bf16_t, OFF_PD) : WSP(bf16_t, OFF_MC)); const int lda = i == 2 ? 768 : 1536;
                EpiBr E{WSP(bf16_t, OFF_GT), WSP(bf16_t, OFF_MKV), i};
                gemm_phase(ldsg, A, lda, WSP(bf16_t, OFF_WBR) + ((size_t)l * 3 + i) * 1024 * 512, 512, TC, 1024, 512, E);
            }
        } break;
        case 4: case 7: if (PHMASK & 16) {
            EpiRes E{p.out + tok0 * 1024};
            const bf16_t* A = ph == 4 ? WSP(bf16_t, OFF_MKV) : WSP(bf16_t, OFF_PA); const int ld = ph == 4 ? 1024 : DFF, ldb_ = ph == 4 ? 3072 : DFF, kk = ph == 4 ? 1024 : DFF;
            const bf16_t* B = ph == 4 ? WSP(bf16_t, OFF_WOUT) + (size_t)l * 1024 * 3072 : WSP(bf16_t, OFF_WF2) + (size_t)l * 1024 * DFF;
            gemm_phase(ldsg, A, ld, B, ldb_, mrows, 1024, kk, E);
        } break;
        case 5: case 8: if (PHMASK & 32) {
            const float* g = ph == 5 ? p.in[14] : p.in[18]; const float* bb = ph == 5 ? p.in[15] : p.in[19];
            ln_rows(p.out, p.out, WSP(bf16_t, OFF_XB), g + l * 1024, bb + l * 1024, (int)tok0, mrows);
        } break;
        case 6: if (PHMASK & 64) {
            EpiF1 E{WSP(bf16_t, OFF_PA)};
            gemm_phase(ldsg, WSP(bf16_t, OFF_XB) + tok0 * 1024, 1024, WSP(bf16_t, OFF_WF1) + (size_t)l * 5632 * 1024, 1024, mrows, 5632, 1024, E);
        } break;
        }
      }
      gsync(grid);
    }
}

extern "C" void kernel_launch(void* const* d_in, const int* in_sizes, int n_in, void* d_out, int out_size, void* d_ws, size_t ws_size, hipStream_t stream) {
    static int grid = 0;
    if (grid == 0) {
        if (n_in != 20 || in_sizes[0] != T_ALL * DM || out_size != T_ALL * DM || ws_size < WS_END) {
            fprintf(stderr, "kernel_launch: unexpected shapes / workspace (n_in %d, ws %zu, need %zu)\n", n_in, ws_size, (size_t)WS_END); grid = -1; return; }
        int dev = 0, cus = 0, per_cu = 0;
        hipGetDevice(&dev); hipDeviceGetAttribute(&cus, hipDeviceAttributeMultiprocessorCount, dev);
        if (hipFuncSetAttribute((const void*)fwd_megakernel, hipFuncAttributeMaxDynamicSharedMemorySize, LDS_BYTES) != hipSuccess) { fprintf(stderr, "kernel_launch: hipFuncSetAttribute failed\n"); grid = -1; return; }
        if (hipOccupancyMaxActiveBlocksPerMultiprocessor(&per_cu, (const void*)fwd_megakernel, 512, LDS_BYTES) != hipSuccess || per_cu < 1) { fprintf(stderr, "kernel_launch: occupancy query gave %d\n", per_cu); per_cu = 1; }
        (void)hipGetLastError();
        grid = cus;
    }
    if (grid < 0) return;
    Params p{};
    for (int i = 0; i < 20; ++i) p.in[i] = (const float*)d_in[i];
    p.out = (float*)d_out; p.ws = (unsigned char*)d_ws;
    for (int l = 0; l < 4; ++l) p.lam_init[l] = (float)(0.8 - 0.6 * exp(-0.3 * (double)l));
    void* args[] = {&p};
    hipError_t e = hipLaunchCooperativeKernel((const void*)fwd_megakernel, dim3(grid), dim3(512), args, LDS_BYTES, stream);
    if (e != hipSuccess) fprintf(stderr, "kernel_launch: cooperative launch failed: %s (grid %d)\n", hipGetErrorString(e), grid);
}
```

```cpp
#include <hip/hip_runtime.h>
#include <hip/hip_cooperative_groups.h>
#include <cstdio>
#include <cstdint>
namespace cg = cooperative_groups;

#define LAS __attribute__((address_space(3)))
#define GAS __attribute__((address_space(1)))
typedef unsigned short bf16_t;
typedef short bf16x8 __attribute__((ext_vector_type(8)));
typedef short s16x4 __attribute__((ext_vector_type(4)));
typedef float f32x4 __attribute__((ext_vector_type(4)));
typedef float f32x16 __attribute__((ext_vector_type(16)));
typedef unsigned u32x4 __attribute__((ext_vector_type(4)));
typedef unsigned u32x2 __attribute__((ext_vector_type(2)));

constexpr int T_ALL = 32768, TC = 16384, DM = 1024, SEQ = 4096, NIN = 6912, DFF = 2816, DEPTH = 4, NCHUNK = 2;
constexpr size_t SZ_WIN = (size_t)DEPTH * NIN * 1024 * 2, SZ_WQB = (size_t)DEPTH * 768 * 384 * 2, SZ_WKVB = (size_t)DEPTH * 1024 * 256 * 2,
                 SZ_WBR = (size_t)DEPTH * 3 * 1024 * 512 * 2, SZ_WOUT = (size_t)DEPTH * 1024 * 3072 * 2, SZ_WF1 = (size_t)DEPTH * 5632 * 1024 * 2,
                 SZ_WF2 = (size_t)DEPTH * 1024 * 2816 * 2, SZ_XB = (size_t)T_ALL * 1024 * 2, SZ_PA = (size_t)TC * 1536 * 2, SZ_PD = SZ_PA,
                 SZ_MC = (size_t)TC * 768 * 2, SZ_GT = (size_t)TC * 3072 * 2, SZ_MQ = (size_t)TC * 768 * 2, SZ_MKV = (size_t)TC * 1024 * 2,
                 SZ_SSQ = (size_t)TC * 24 * 4, SZ_TD = (size_t)SEQ * 8 * 4 * 2, SZ_TM = (size_t)SEQ * 16 * 4 * 2;
constexpr size_t OFF_WIN = 0, OFF_WQB = OFF_WIN + SZ_WIN, OFF_WKVB = OFF_WQB + SZ_WQB, OFF_WBR = OFF_WKVB + SZ_WKVB, OFF_WOUT = OFF_WBR + SZ_WBR,
                 OFF_WF1 = OFF_WOUT + SZ_WOUT, OFF_WF2 = OFF_WF1 + SZ_WF1, OFF_XB = OFF_WF2 + SZ_WF2, OFF_PA = OFF_XB + SZ_XB, OFF_PD = OFF_PA + SZ_PA,
                 OFF_MC = OFF_PD + SZ_PD, OFF_GT = OFF_MC + SZ_MC, OFF_MQ = OFF_GT + SZ_GT, OFF_MKV = OFF_MQ + SZ_MQ, OFF_SSQ = OFF_MKV + SZ_MKV,
                 OFF_TD = OFF_SSQ + SZ_SSQ, OFF_TM = OFF_TD + SZ_TD, OFF_ST = OFF_TM + SZ_TM, WS_END = OFF_ST + (size_t)T_ALL * 2 * 4;
constexpr int LDS_BYTES = 132 * 1024;
static_assert((size_t)T_ALL * DFF * 2 <= SZ_PA + SZ_PD + SZ_MC + SZ_GT, "SwiGLU hidden of all tokens aliases projA|projD|mla_c|gates");
constexpr float DN_ALPHA = 1.681792830507429f;

struct Params { const float* in[20]; float* out; unsigned char* ws; float lam_init[4]; };

typedef __bf16 bf2_t __attribute__((ext_vector_type(2)));
typedef float f32x2 __attribute__((ext_vector_type(2)));
__device__ __forceinline__ unsigned cvtpk(float lo, float hi) { f32x2 v = {lo, hi}; bf2_t b = __builtin_convertvector(v, bf2_t); return __builtin_bit_cast(unsigned, b); }
__device__ __forceinline__ int otid() { int t = threadIdx.x; asm volatile("" : "+v"(t)); return t; }
__device__ __forceinline__ float bf2f(unsigned short b) { return __uint_as_float(((unsigned)b) << 16); }
__device__ __forceinline__ void st_bf4(bf16_t* p, f32x4 v) { u32x2 w; w.x = cvtpk(v[0], v[1]); w.y = cvtpk(v[2], v[3]); *(GAS u32x2*)p = w; }

constexpr int BM = 256, BK = 64, HALF = 128, HTB = HALF * BK * 2, NXCD = 8, WGM = 8;
__device__ __forceinline__ int lds_byte(int r, int c) { const int st = (r >> 4) * 2 + (c >> 5), rr = r & 15, cc = c & 31, ob = rr * 64 + cc * 2; return st * 1024 + (ob ^ (((ob >> 9) & 1) << 5)); }
__device__ __forceinline__ void stage_rc(int b, int& R, int& C) { const int st = b / 1024, sb = b % 1024, swz = sb ^ (((sb >> 9) & 1) << 5); R = (st >> 1) * 16 + swz / 64; C = (st & 1) * 32 + (swz % 64) / 2; }
struct Unit { int pm, pn; };
struct StaticOrder {
    int nM, nN, nwg, G, c;
    __device__ void init(int M, int N, int G_, int c_) { nM = M / BM; nN = N / BM; nwg = nM * nN; G = G_; c = c_; }
    __device__ bool next(int i, Unit& u) const {
        const long L = (long)i * G + c; if (L >= nwg) return false;
        int wgid = (int)L; { const int q = nwg / NXCD, r = nwg % NXCD, xcd = wgid % NXCD, off = wgid / NXCD; wgid = (xcd < r ? xcd * (q + 1) : r * (q + 1) + (xcd - r) * q) + off; }
        const int nig = WGM * nN, gid = wgid / nig, fm = gid * WGM, gsz = (nM - fm) < WGM ? (nM - fm) : WGM;
        u.pm = __builtin_amdgcn_readfirstlane(fm + ((wgid % nig) % gsz)); u.pn = __builtin_amdgcn_readfirstlane((wgid % nig) / gsz); return true;
    }
};

template <class Epi>
__device__ __forceinline__ void gemm_phase(LAS unsigned char* lds, const bf16_t* A, int lda, const bf16_t* Bt, int ldb, int M, int N, int K, const Epi& E) {
    const int tid = otid(), wid = __builtin_amdgcn_readfirstlane(tid >> 6), lane = tid & 63, wr = wid >> 2, wc = wid & 3, fr = lane & 15, fq = lane >> 4;
    int ntv_ = K / BK; asm volatile("" : "+v"(ntv_)); const int nt = __builtin_amdgcn_readfirstlane(ntv_);
    StaticOrder S; S.init(M, N, (int)gridDim.x, (int)blockIdx.x);
    unsigned voffA[2], voffB[2];
#pragma unroll
    for (int i = 0; i < 2; ++i) { int R, C; stage_rc(tid * 16 + i * 8192, R, C); voffA[i] = (unsigned)(R * lda + C) * 2u; voffB[i] = (unsigned)(R * ldb + C) * 2u; }
    const size_t kstep = (size_t)(BK * 2);
    const size_t hstepA = (size_t)HALF * lda * 2, tstepA = 2 * hstepA, hstepB = (size_t)HALF * ldb * 2, tstepB = 2 * hstepB;
    const unsigned ldsw = (unsigned)wid * 1024u;
    const int aoff = lds_byte(wr * 64 + fr, fq * 8), boff = lds_byte(wc * 32 + fr, fq * 8);
#define PG8_SA(b, h) (((b) * 2 + (h)) * HTB)
#define PG8_SB(b, h) ((4 + (b) * 2 + (h)) * HTB)
#define PG8_STAGE(bufoff, gbase, voff) do { _Pragma("unroll") for (int _i = 0; _i < 2; ++_i) \
        __builtin_amdgcn_global_load_lds((const unsigned*)((const char*)(gbase) + (voff)[_i]), (LAS unsigned*)(lds + (bufoff) + ldsw + _i * 8192), 16, 0, 0); } while (0)
#define PG8_LDA(dst, b, h) do { _Pragma("unroll") for (int m = 0; m < 4; ++m) _Pragma("unroll") for (int k = 0; k < 2; ++k) dst[m][k] = *(const LAS bf16x8*)(lds + PG8_SA(b, h) + aoff + m * 2048 + k * 1024); } while (0)
#define PG8_LDB(dst, b, h) do { _Pragma("unroll") for (int n = 0; n < 2; ++n) _Pragma("unroll") for (int k = 0; k < 2; ++k) dst[n][k] = *(const LAS bf16x8*)(lds + PG8_SB(b, h) + boff + n * 2048 + k * 1024); } while (0)
#define PG8_MMA(ai, bj, At, Bt_) do { __builtin_amdgcn_s_setprio(1); _Pragma("unroll") for (int m = 0; m < 4; ++m) _Pragma("unroll") for (int n = 0; n < 2; ++n) _Pragma("unroll") for (int k = 0; k < 2; ++k) \
        acc[ai][bj][m][n] = __builtin_amdgcn_mfma_f32_16x16x32_bf16(Bt_[n][k], At[m][k], acc[ai][bj][m][n], 0, 0, 0); __builtin_amdgcn_s_setprio(0); } while (0)
#define PG8_WAIT_V(n) asm volatile("s_waitcnt vmcnt(" #n ")" ::: "memory")
#define PG8_WAIT_L(n) asm volatile("s_waitcnt lgkmcnt(" #n ")" ::: "memory")
#define PG8_BAR __builtin_amdgcn_s_barrier()
#define PG8_SCHED __builtin_amdgcn_sched_barrier(0)
    Unit cur, nxt; int ui = 0;
    if (!S.next(0, cur)) return;
    f32x4 acc[2][2][4][2];
#pragma unroll
    for (int a = 0; a < 2; ++a)
#pragma unroll
        for (int b = 0; b < 2; ++b)
#pragma unroll
            for (int m = 0; m < 4; ++m)
#pragma unroll
                for (int n = 0; n < 2; ++n) acc[a][b][m][n] = (f32x4){0.f, 0.f, 0.f, 0.f};
    bf16x8 At[4][2], B0[2][2], B1[2][2];
    const char* cA = (const char*)A + (size_t)cur.pm * tstepA; const char* cB = (const char*)Bt + (size_t)cur.pn * tstepB;
    PG8_STAGE(PG8_SB(0, 0), cB, voffB); PG8_STAGE(PG8_SA(0, 0), cA, voffA); PG8_STAGE(PG8_SB(0, 1), cB + hstepB, voffB); PG8_STAGE(PG8_SA(0, 1), cA + hstepA, voffA);
    if (wr == 1) PG8_BAR;
    PG8_WAIT_V(4); PG8_BAR;
    PG8_STAGE(PG8_SB(1, 0), cB + kstep, voffB); PG8_STAGE(PG8_SA(1, 0), cA + kstep, voffA); PG8_STAGE(PG8_SB(1, 1), cB + hstepB + kstep, voffB);
    PG8_WAIT_V(6); PG8_BAR;
    for (;;) {
        const bool has_next = S.next(ui + 1, nxt);
        const char* nA = has_next ? (const char*)A + (size_t)nxt.pm * tstepA : cA; const char* nB = has_next ? (const char*)Bt + (size_t)nxt.pn * tstepB : cB;
#pragma unroll 1
        for (int t = 0; t < nt; t += 2) {
            const bool last = (t == nt - 2);
            const char* a1 = cA + (size_t)(t + 1) * kstep;
            const char* a2 = last ? nA : cA + (size_t)(t + 2) * kstep; const char* b2 = last ? nB : cB + (size_t)(t + 2) * kstep;
            const char* a3 = a2 + kstep; const char* b3 = b2 + kstep;
            PG8_LDB(B0, 0, 0); PG8_SCHED; PG8_LDA(At, 0, 0); PG8_STAGE(PG8_SA(1, 1), a1 + hstepA, voffA);
            PG8_WAIT_L(8); PG8_BAR; PG8_WAIT_L(0); PG8_MMA(0, 0, At, B0); PG8_BAR; PG8_SCHED;
            PG8_LDB(B1, 0, 1); PG8_STAGE(PG8_SB(0, 0), b2, voffB);
            PG8_BAR; PG8_WAIT_L(0); PG8_MMA(0, 1, At, B1); PG8_BAR;
            PG8_LDA(At, 0, 1); PG8_STAGE(PG8_SA(0, 0), a2, voffA);
            PG8_BAR; PG8_WAIT_L(0); PG8_MMA(1, 0, At, B0); PG8_BAR; PG8_SCHED;
            PG8_STAGE(PG8_SB(0, 1), b2 + hstepB, voffB);
            PG8_WAIT_V(6); PG8_BAR; PG8_MMA(1, 1, At, B1); PG8_BAR;
            PG8_LDB(B0, 1, 0); PG8_SCHED; PG8_LDA(At, 1, 0); PG8_STAGE(PG8_SA(0, 1), a2 + hstepA, voffA);
            PG8_WAIT_L(8); PG8_BAR; PG8_WAIT_L(0); PG8_MMA(0, 0, At, B0); PG8_BAR; PG8_SCHED;
            PG8_LDB(B1, 1, 1); PG8_STAGE(PG8_SB(1, 0), b3, voffB);
            PG8_BAR; PG8_WAIT_L(0); PG8_MMA(0, 1, At, B1); PG8_BAR;
            PG8_LDA(At, 1, 1); PG8_STAGE(PG8_SA(1, 0), a3, voffA);
            PG8_BAR; PG8_WAIT_L(0); PG8_MMA(1, 0, At, B0); PG8_BAR; PG8_SCHED;
            PG8_STAGE(PG8_SB(1, 1), b3 + hstepB, voffB);
            PG8_WAIT_V(6); PG8_BAR; PG8_MMA(1, 1, At, B1); PG8_BAR;
        }
        E(acc, cur, wr, wc, fr, fq);
        if (!has_next) break;
#pragma unroll
        for (int a = 0; a < 2; ++a)
#pragma unroll
            for (int b = 0; b < 2; ++b)
#pragma unroll
                for (int m = 0; m < 4; ++m)
#pragma unroll
                    for (int n = 0; n < 2; ++n) acc[a][b][m][n] = (f32x4){0.f, 0.f, 0.f, 0.f};
        cur = nxt; cA = nA; cB = nB; ++ui;
    }
    PG8_WAIT_V(0);
    if (wr == 0) PG8_BAR;
    PG8_BAR;
#undef PG8_SA
#undef PG8_SB
#undef PG8_STAGE
#undef PG8_LDA
#undef PG8_LDB
#undef PG8_MMA
#undef PG8_WAIT_V
#undef PG8_WAIT_L
#undef PG8_BAR
#undef PG8_SCHED
}

struct EpiIn {
    bf16_t *pa, *pd, *mc, *gt; float* ssq; const float* bg; const float *cd, *sd, *cm, *sm;
    __device__ __forceinline__ void operator()(const f32x4 (&acc)[2][2][4][2], const Unit& u, int wr, int wc, int fr, int fq) const {
        int row0 = u.pm * BM + wr * 64 + fr; asm volatile("" : "+v"(row0) :: "memory"); const int pn = u.pn, cw = wc * 32 + 4 * fq;
        if (pn < 6) {
#pragma unroll
            for (int ai = 0; ai < 2; ++ai)
#pragma unroll
                for (int m = 0; m < 4; ++m) { __builtin_amdgcn_sched_barrier(0); bf16_t* rp = pa + (size_t)(row0 + ai * HALF + m * 16) * 1536 + pn * 256 + cw;
#pragma unroll
                    for (int bj = 0; bj < 2; ++bj)
#pragma unroll
                        for (int n = 0; n < 2; ++n) st_bf4(rp + bj * HALF + n * 16, acc[ai][bj][m][n]); }
        } else if (pn < 12) {
            const bool rope = (pn < 10) && !(wc & 1);
#pragma unroll
            for (int ai = 0; ai < 2; ++ai)
#pragma unroll
                for (int m = 0; m < 4; ++m) { __builtin_amdgcn_sched_barrier(0); const int row = row0 + ai * HALF + m * 16; bf16_t* rp = pd + (size_t)row * 1536 + (pn - 6) * 256 + cw;
                    f32x4 c4 = {1.f, 1.f, 1.f, 1.f}, s4 = {0.f, 0.f, 0.f, 0.f};
                    if (rope) { const int pos = row & (SEQ - 1); c4 = *(const GAS f32x4*)(cd + pos * 8 + (fq & 1) * 4); s4 = *(const GAS f32x4*)(sd + pos * 8 + (fq & 1) * 4); }
#pragma unroll
                    for (int bj = 0; bj < 2; ++bj) { f32x4 v0 = acc[ai][bj][m][0];
                        if (rope) { f32x4 pr;
#pragma unroll
                            for (int j = 0; j < 4; ++j) pr[j] = __shfl_xor(v0[j], 32);
                            v0 = (fq < 2) ? (v0 * c4 - pr * s4) : (v0 * c4 + pr * s4); }
                        st_bf4(rp + bj * HALF, v0); st_bf4(rp + bj * HALF + 16, acc[ai][bj][m][1]); } }
        } else if (pn < 15) {
            const int t = pn - 12;
#pragma unroll
            for (int ai = 0; ai < 2; ++ai)
#pragma unroll
                for (int m = 0; m < 4; ++m) { __builtin_amdgcn_sched_barrier(0); const int row = row0 + ai * HALF + m * 16; bf16_t* rp = mc + (size_t)row * 768 + t * 256 + cw;
#pragma unroll
                    for (int bj = 0; bj < 2; ++bj) { f32x4 v0 = acc[ai][bj][m][0], v1 = acc[ai][bj][m][1];
                        float s = (v0[0] * v0[0] + v0[1] * v0[1]) + (v0[2] * v0[2] + v0[3] * v0[3]) + (v1[0] * v1[0] + v1[1] * v1[1]) + (v1[2] * v1[2] + v1[3] * v1[3]);
                        s += __shfl_xor(s, 16); s += __shfl_xor(s, 32);
                        if (fq == 0) *(GAS float*)(ssq + (size_t)row * 24 + t * 8 + bj * 4 + wc) = s;
                        if (t == 2 && bj == 1 && wc == 0) { const int pos = row & (SEQ - 1); const f32x4 c4 = *(const GAS f32x4*)(cm + pos * 16 + fq * 4), s4 = *(const GAS f32x4*)(sm + pos * 16 + fq * 4);
                            const f32x4 n0 = v0 * c4 - v1 * s4, n1 = v1 * c4 + v0 * s4; v0 = n0; v1 = n1; }
                        st_bf4(rp + bj * HALF, v0); st_bf4(rp + bj * HALF + 16, v1); } }
        } else {
            const int t = pn - 15;
            f32x4 bv[2][2];
#pragma unroll
            for (int bj = 0; bj < 2; ++bj)
#pragma unroll
                for (int n = 0; n < 2; ++n) bv[bj][n] = *(const GAS f32x4*)(bg + t * 256 + bj * HALF + n * 16 + cw);
#pragma unroll
            for (int ai = 0; ai < 2; ++ai)
#pragma unroll
                for (int m = 0; m < 4; ++m) { __builtin_amdgcn_sched_barrier(0); bf16_t* rp = gt + (size_t)(row0 + ai * HALF + m * 16) * 3072 + t * 256 + cw;
#pragma unroll
                    for (int bj = 0; bj < 2; ++bj)
#pragma unroll
                        for (int n = 0; n < 2; ++n) { f32x4 v = acc[ai][bj][m][n] + bv[bj][n];
#pragma unroll
                            for (int j = 0; j < 4; ++j) v[j] = __builtin_amdgcn_rcpf(1.0f + __expf(-v[j]));
                            st_bf4(rp + bj * HALF + n * 16, v); } }
        }
    }
};
struct EpiQ {
    bf16_t* mq; const float* ssq; const float *cm, *sm;
    __device__ __forceinline__ void operator()(const f32x4 (&acc)[2][2][4][2], const Unit& u, int wr, int wc, int fr, int fq) const {
        int row0 = u.pm * BM + wr * 64 + fr; asm volatile("" : "+v"(row0) :: "memory"); const int cw = wc * 32 + 4 * fq;
        float rr8[8];
#pragma unroll
        for (int i = 0; i < 8; ++i) { const float* sp = ssq + (size_t)(row0 + (i >> 2) * HALF + (i & 3) * 16) * 24 + fq * 4;
            const f32x4 a = *(const GAS f32x4*)sp;
            float ss = fq < 3 ? ((a[0] + a[1]) + (a[2] + a[3])) : 0.f;
            ss += __shfl_xor(ss, 16); ss += __shfl_xor(ss, 32);
            rr8[i] = rsqrtf(ss * (1.0f / 384.0f) + 1e-6f); }
#pragma unroll
        for (int ai = 0; ai < 2; ++ai)
#pragma unroll
            for (int m = 0; m < 4; ++m) { __builtin_amdgcn_sched_barrier(0); const int row = row0 + ai * HALF + m * 16; const float r = rr8[ai * 4 + m];
                bf16_t* rp = mq + (size_t)row * 768 + u.pn * 256 + cw;
#pragma unroll
                for (int bj = 0; bj < 2; ++bj) { const int G = u.pn * 8 + bj * 4 + wc; f32x4 v0 = acc[ai][bj][m][0] * r, v1 = acc[ai][bj][m][1] * r;
                    if (G % 3 == 2) { const int pos = row & (SEQ - 1); const f32x4 c4 = *(const GAS f32x4*)(cm + pos * 16 + fq * 4), s4 = *(const GAS f32x4*)(sm + pos * 16 + fq * 4);
                        const f32x4 n0 = v0 * c4 - v1 * s4, n1 = v1 * c4 + v0 * s4; v0 = n0; v1 = n1; }
                    st_bf4(rp + bj * HALF, v0); st_bf4(rp + bj * HALF + 16, v1); } }
    }
};
struct EpiKV {
    bf16_t* mkv; const float* ssq;
    __device__ __forceinline__ void operator()(const f32x4 (&acc)[2][2][4][2], const Unit& u, int wr, int wc, int fr, int fq) const {
        int row0 = u.pm * BM + wr * 64 + fr; asm volatile("" : "+v"(row0) :: "memory"); const int cw = wc * 32 + 4 * fq;
        float rr8[8];
#pragma unroll
        for (int i = 0; i < 8; ++i) { const float* sp = ssq + (size_t)(row0 + (i >> 2) * HALF + (i & 3) * 16) * 24 + 12 + (fq & 1) * 4;
            const f32x4 a = *(const GAS f32x4*)sp;
            float ss = fq < 2 ? ((a[0] + a[1]) + (a[2] + a[3])) : 0.f;
            ss += __shfl_xor(ss, 16); ss += __shfl_xor(ss, 32);
            rr8[i] = rsqrtf(ss * (1.0f / 256.0f) + 1e-6f); }
#pragma unroll
        for (int ai = 0; ai < 2; ++ai)
#pragma unroll
            for (int m = 0; m < 4; ++m) { __builtin_amdgcn_sched_barrier(0); const int row = row0 + ai * HALF + m * 16; const float r = rr8[ai * 4 + m];
                bf16_t* rp = mkv + (size_t)row * 1024 + u.pn * 256 + cw;
#pragma unroll
                for (int bj = 0; bj < 2; ++bj)
#pragma unroll
                    for (int n = 0; n < 2; ++n) st_bf4(rp + bj * HALF + n * 16, acc[ai][bj][m][n] * r); }
    }
};
struct EpiBr {
    const bf16_t* gt; bf16_t* mg;
    int br;
    __device__ __forceinline__ void operator()(const f32x4 (&acc)[2][2][4][2], const Unit& u, int wr, int wc, int fr, int fq) const {
        int row0 = u.pm * BM + wr * 64 + fr; asm volatile("" : "+v"(row0) :: "memory"); const int cw = wc * 32 + 4 * fq;
#pragma unroll
        for (int ai = 0; ai < 2; ++ai)
#pragma unroll
            for (int m = 0; m < 4; ++m) { __builtin_amdgcn_sched_barrier(0); const size_t rr_ = (size_t)(row0 + ai * HALF + m * 16); const bf16_t* gp = gt + rr_ * 3072 + br * 1024 + u.pn * 256 + cw; bf16_t* rp = mg + rr_ * 1024 + u.pn * 256 + cw;
#pragma unroll
                for (int bj = 0; bj < 2; ++bj)
#pragma unroll
                    for (int n = 0; n < 2; ++n) { bf16_t* p = rp + bj * HALF + n * 16; const u32x2 g = *(const GAS u32x2*)(gp + bj * HALF + n * 16); const f32x4 a = acc[ai][bj][m][n];
                        f32x4 v; v[0] = a[0] * __uint_as_float(g.x << 16); v[1] = a[1] * __uint_as_float(g.x & 0xffff0000u); v[2] = a[2] * __uint_as_float(g.y << 16); v[3] = a[3] * __uint_as_float(g.y & 0xffff0000u);
                        if (br > 0) { const unsigned long long pv = __hip_atomic_load((const GAS unsigned long long*)p, __ATOMIC_RELAXED, __HIP_MEMORY_SCOPE_AGENT); const unsigned lo = (unsigned)pv, hi = (unsigned)(pv >> 32);
                            v[0] += __uint_as_float(lo << 16); v[1] += __uint_as_float(lo & 0xffff0000u); v[2] += __uint_as_float(hi << 16); v[3] += __uint_as_float(hi & 0xffff0000u); }
                        st_bf4(p, v); } }
    }
};
struct EpiRes {
    const float* xs; float* xd; const float* st; const float* g; const float* b;
    __device__ __forceinline__ void operator()(const f32x4 (&acc)[2][2][4][2], const Unit& u, int wr, int wc, int fr, int fq) const {
        int row0 = u.pm * BM + wr * 64 + fr; asm volatile("" : "+v"(row0) :: "memory"); const int cw = wc * 32 + 4 * fq;
#pragma unroll
        for (int bj = 0; bj < 2; ++bj) {
            f32x4 gv[2], bv[2];
#pragma unroll
            for (int n = 0; n < 2; ++n) { gv[n] = *(const GAS f32x4*)(g + u.pn * 256 + cw + bj * HALF + n * 16); bv[n] = *(const GAS f32x4*)(b + u.pn * 256 + cw + bj * HALF + n * 16); }
#pragma unroll
            for (int ai = 0; ai < 2; ++ai)
#pragma unroll
                for (int m = 0; m < 4; ++m) { __builtin_amdgcn_sched_barrier(0); const size_t row = (size_t)(row0 + ai * HALF + m * 16); const size_t ro = row * 1024 + u.pn * 256 + cw + bj * HALF;
                    const f32x2 ms = *(const GAS f32x2*)(st + row * 2);
#pragma unroll
                    for (int n = 0; n < 2; ++n) { const size_t o = ro + n * 16; const f32x4 xv = *(const GAS f32x4*)(xs + o);
                        const f32x4 xn = (xv - ms[0]) * ms[1] * gv[n] + bv[n]; *(GAS f32x4*)(xd + o) = xn * DN_ALPHA + acc[ai][bj][m][n]; } }
        }
    }
};
struct EpiF1 {
    bf16_t* hd;
    __device__ __forceinline__ void operator()(const f32x4 (&acc)[2][2][4][2], const Unit& u, int wr, int wc, int fr, int fq) const {
        int row0 = u.pm * BM + wr * 64 + fr; asm volatile("" : "+v"(row0) :: "memory"); const int cw = wc * 32 + 4 * fq;
#pragma unroll
        for (int ai = 0; ai < 2; ++ai)
#pragma unroll
            for (int m = 0; m < 4; ++m) { __builtin_amdgcn_sched_barrier(0); bf16_t* rp = hd + (size_t)(row0 + ai * HALF + m * 16) * DFF + u.pn * 128 + cw;
#pragma unroll
                for (int n = 0; n < 2; ++n) { const f32x4 g = acc[ai][0][m][n], uu = acc[ai][1][m][n]; f32x4 v;
#pragma unroll
                    for (int j = 0; j < 4; ++j) v[j] = g[j] * __builtin_amdgcn_rcpf(1.0f + __expf(-g[j])) * uu[j];
                    st_bf4(rp + n * 16, v); } }
    }
};

constexpr int SHM_V = 64 * 128 * 2, SHM_K = 64 * 128 * 2;
#define KSWZ(row, colB) ((row) * 256 + ((colB) ^ (((row) & 7) << 4)))
#define SBAR() __builtin_amdgcn_sched_barrier(0)
__device__ __forceinline__ int crow(int r, int hi) { return (r & 3) + 8 * (r >> 2) + 4 * hi; }
struct NaCtx { int vlo, vhi, wstart, qc, drow0; const LAS float* tab; };

template <int MODE>
__device__ __forceinline__ void partialSM(f32x16& p0, f32x16& p1, float& m_reg, float& mn, float& alpha, const NaCtx& na, int t, int hi) {
    constexpr float SCALE = MODE == 2 ? 0.10206207261596575f : 0.125f;
    constexpr float C = SCALE * 1.4426950408889634f;
    constexpr float THRS = 8.f / SCALE;
    if (MODE == 0) {
        const float NINF = -__builtin_inff();
        if (t < na.vlo || t >= na.vhi) {
#pragma unroll
            for (int r = 0; r < 16; ++r) { p0[r] = NINF; p1[r] = NINF; }
        } else {
            const LAS float* trow = na.tab + (na.drow0 + t) * 31 + (15 - na.qc);
#pragma unroll
            for (int q4 = 0; q4 < 4; ++q4) {
#pragma unroll
                for (int r = q4 * 4; r < q4 * 4 + 4; ++r) { const int kc = crow(r, hi); const bool ok0 = (unsigned)(kc - na.wstart) < 16u, ok1 = (unsigned)(kc + 32 - na.wstart) < 16u;
                    const float b0 = trow[ok0 ? kc : na.wstart], b1 = trow[ok1 ? kc + 32 : na.wstart];
                    p0[r] = ok0 ? p0[r] + b0 : NINF; p1[r] = ok1 ? p1[r] + b1 : NINF; }
                __builtin_amdgcn_sched_barrier(0); }
        }
    }
    float pmax = p0[0];
#pragma unroll
    for (int r = 1; r < 16; ++r) pmax = fmaxf(pmax, p0[r]);
#pragma unroll
    for (int r = 0; r < 16; ++r) pmax = fmaxf(pmax, p1[r]);
    { auto rr = __builtin_amdgcn_permlane32_swap(__float_as_uint(pmax), __float_as_uint(pmax), false, false);
      pmax = fmaxf(__uint_as_float(rr[0]), __uint_as_float(rr[1])); }
    if (__builtin_expect(__all(pmax - m_reg <= THRS), 1)) { mn = m_reg; alpha = 1.f; }
    else { mn = fmaxf(m_reg, pmax); alpha = __builtin_amdgcn_exp2f((m_reg - mn) * C); m_reg = mn; }
    const float mnC = -mn * C;
#pragma unroll
    for (int r = 0; r < 16; ++r) p0[r] = fmaf(p0[r], C, mnC);
#pragma unroll
    for (int r = 0; r < 16; ++r) p1[r] = fmaf(p1[r], C, mnC);
#pragma unroll
    for (int r = 0; r < 16; ++r) p0[r] = __builtin_amdgcn_exp2f(p0[r]);
}
__device__ __forceinline__ void finishSM(f32x16& p0, f32x16& p1, float alpha, float& l_reg, bf16x8& pa0, bf16x8& pa1, bf16x8& pa2, bf16x8& pa3) {
#pragma unroll
    for (int r = 0; r < 16; ++r) p1[r] = __builtin_amdgcn_exp2f(p1[r]);
    float ps = 0;
#pragma unroll
    for (int r = 0; r < 16; ++r) ps += p0[r];
#pragma unroll
    for (int r = 0; r < 16; ++r) ps += p1[r];
    { auto rr = __builtin_amdgcn_permlane32_swap(__float_as_uint(ps), __float_as_uint(ps), false, false);
      ps = __uint_as_float(rr[0]) + __uint_as_float(rr[1]); }
    l_reg = l_reg * alpha + ps;
#define PK4(P, BASE, OUT) do { unsigned a0 = cvtpk(P[BASE + 0], P[BASE + 1]), a1 = cvtpk(P[BASE + 2], P[BASE + 3]);   \
    unsigned b0 = cvtpk(P[BASE + 4], P[BASE + 5]), b1 = cvtpk(P[BASE + 6], P[BASE + 7]);                              \
    auto r0 = __builtin_amdgcn_permlane32_swap(a0, b0, false, false); auto r1 = __builtin_amdgcn_permlane32_swap(a1, b1, false, false); \
    u32x4 w = {r0[0], r1[0], r0[1], r1[1]}; OUT = *reinterpret_cast<bf16x8*>(&w); } while (0)
    PK4(p0, 0, pa0); PK4(p0, 8, pa1); PK4(p1, 0, pa2); PK4(p1, 8, pa3);
#undef PK4
}
template <int ND>
__device__ __forceinline__ void qkt(f32x16& p0, f32x16& p1, const char* Ks, const bf16x8* qr, int r32, int hi) {
    p0 = f32x16{}; p1 = f32x16{};
#pragma unroll
    for (int d0 = 0; d0 < ND; ++d0) { const int cb = (d0 * 16 + hi * 8) * 2;
        const bf16x8 b0 = *reinterpret_cast<const bf16x8*>(Ks + KSWZ(r32, cb));
        const bf16x8 b1 = *reinterpret_cast<const bf16x8*>(Ks + KSWZ(32 + r32, cb));
        p0 = __builtin_amdgcn_mfma_f32_32x32x16_bf16(b0, qr[d0], p0, 0, 0, 0);
        p1 = __builtin_amdgcn_mfma_f32_32x32x16_bf16(b1, qr[d0], p1, 0, 0, 0); }
}
__device__ __forceinline__ int v_st(int k, int c) { const int kk = (k & ~0xC) | ((k & 4) << 1) | ((k & 8) >> 1); return ((kk >> 3) * 4 + (c >> 5)) * 512 + ((kk & 7) * 32 + (c & 31)) * 2; }
__device__ __forceinline__ int v_rd_base(int lane) { return ((lane & 3) << 3) | (((lane >> 2) & 3) << 6) | (((lane >> 4) & 1) << 5) | (((lane >> 5) & 1) << 8); }
constexpr int v_rd_off(int d0, int ks, int half) { return d0 * 512 + ks * 4096 + half * 2048; }
template <int OFF> __device__ __forceinline__ s16x4 tr_read(int vb) {
    s16x4 r; asm volatile("ds_read_b64_tr_b16 %0, %1 offset:%2" : "=&v"(r) : "v"(vb), "i"(OFF) : "memory"); return r;
}
template <int D0> __device__ __forceinline__ void pv_one(f32x16& od, int vb, bf16x8 pa0, bf16x8 pa1, bf16x8 pa2, bf16x8 pa3) {
    const s16x4 l0 = tr_read<v_rd_off(D0, 0, 0)>(vb), h0 = tr_read<v_rd_off(D0, 0, 1)>(vb), l1 = tr_read<v_rd_off(D0, 1, 0)>(vb), h1 = tr_read<v_rd_off(D0, 1, 1)>(vb);
    const s16x4 l2 = tr_read<v_rd_off(D0, 2, 0)>(vb), h2 = tr_read<v_rd_off(D0, 2, 1)>(vb), l3 = tr_read<v_rd_off(D0, 3, 0)>(vb), h3 = tr_read<v_rd_off(D0, 3, 1)>(vb);
    asm volatile("s_waitcnt lgkmcnt(0)" ::: "memory"); SBAR();
#define PKV(L, H) (bf16x8){L[0], L[1], L[2], L[3], H[0], H[1], H[2], H[3]}
    od = __builtin_amdgcn_mfma_f32_32x32x16_bf16(pa0, PKV(l0, h0), od, 0, 0, 0);
    od = __builtin_amdgcn_mfma_f32_32x32x16_bf16(pa1, PKV(l1, h1), od, 0, 0, 0);
    od = __builtin_amdgcn_mfma_f32_32x32x16_bf16(pa2, PKV(l2, h2), od, 0, 0, 0);
    od = __builtin_amdgcn_mfma_f32_32x32x16_bf16(pa3, PKV(l3, h3), od, 0, 0, 0);
#undef PKV
}
template <int NO> __device__ __forceinline__ void pv_d0(f32x16* o, int vb, bf16x8 pa0, bf16x8 pa1, bf16x8 pa2, bf16x8 pa3) {
    pv_one<0>(o[0], vb, pa0, pa1, pa2, pa3); pv_one<1>(o[1], vb, pa0, pa1, pa2, pa3);
    if constexpr (NO == 4) { pv_one<2>(o[2], vb, pa0, pa1, pa2, pa3); pv_one<3>(o[3], vb, pa0, pa1, pa2, pa3); }
}

template <int DQ, int DV, int MODE, int ldq, int ldk, int ldk2, int ldv, int SD>
__device__ __forceinline__ void attn_core(const bf16_t* __restrict__ Qb, const bf16_t* __restrict__ K1, const bf16_t* __restrict__ K2,
                                          const bf16_t* __restrict__ Vh, int NT, char* lds, f32x16 (&o)[DV / 32], float (&rli)[16], const NaCtx& na) {
    constexpr int ND = DQ / 16, NO = DV / 32;
    const int tid = otid(), wid = tid >> 6, lane = tid & 63, r32 = lane & 31, hi = lane >> 5;
    char* V_lds = lds; char* K_lds = lds + 2 * SHM_V;
    float* ws = (float*)(lds + 2 * SHM_V + 2 * SHM_K) + wid * 64; float* li_l = ws; float* al_l = ws + 32;
    float m_reg = -1e30f, l_reg = 0;
#pragma unroll
    for (int d = 0; d < NO; ++d) o[d] = f32x16{};
    bf16x8 qr[ND];
    const bf16_t* Qw = Qb + (long)(wid * 32 + r32) * ldq + hi * 8;
#pragma unroll
    for (int d0 = 0; d0 < ND; ++d0) qr[d0] = *(const GAS bf16x8*)(Qw + d0 * 16);
    const int sr = tid >> 4, sc = (tid & 15) * 8, vst0 = v_st(sr, sc), vst1 = v_st(32 + sr, sc);
    const int vb0 = (int)(uintptr_t)V_lds + v_rd_base(lane);
    const bool ldV = sc < DV, ldK = sc < DQ;
    const bf16_t* kp; long kld;
    if (DQ > 64 && sc >= 64) { kp = K2 + (sc - 64); kld = ldk2; } else { kp = K1 + sc; kld = ldk; }
    const bf16_t* vp = Vh + sc;
    struct Slot { bf16x8 vs0, vs1, ks0, ks1; };
    Slot sA, sB; sA.vs0 = sA.vs1 = sA.ks0 = sA.ks1 = bf16x8{}; sB = sA;
    Slot& sO = (SD == 2) ? sB : sA;
#define SLOAD(S_, k0) do { if (ldV) { S_.vs0 = *(const GAS bf16x8*)(vp + (long)((k0) + sr) * ldv); S_.vs1 = *(const GAS bf16x8*)(vp + (long)((k0) + 32 + sr) * ldv); } \
    if (ldK) { S_.ks0 = *(const GAS bf16x8*)(kp + (long)((k0) + sr) * kld); S_.ks1 = *(const GAS bf16x8*)(kp + (long)((k0) + 32 + sr) * kld); } } while (0)
#define SWRITE(b, S_) do { if (ldV) { *(bf16x8*)(V_lds + (b) * SHM_V + vst0) = S_.vs0; *(bf16x8*)(V_lds + (b) * SHM_V + vst1) = S_.vs1; } \
    if (ldK) { const int kc = sc * 2; *(bf16x8*)(K_lds + (b) * SHM_K + KSWZ(sr, kc)) = S_.ks0; *(bf16x8*)(K_lds + (b) * SHM_K + KSWZ(32 + sr, kc)) = S_.ks1; } } while (0)
#define SWAIT() do { if (SD == 2) asm volatile("s_waitcnt vmcnt(4)" ::: "memory"); else asm volatile("s_waitcnt vmcnt(0)" ::: "memory"); } while (0)
#define RESC(a) do { if (__any((a) < 1.f)) { if (hi == 0) al_l[r32] = (a); asm volatile("s_waitcnt lgkmcnt(0)" ::: "memory"); \
    _Pragma("unroll") for (int d = 0; d < NO; ++d) _Pragma("unroll") for (int r = 0; r < 16; ++r) o[d][r] *= al_l[crow(r, hi)]; } } while (0)
    f32x16 pA0, pA1, pB0, pB1; float mnA, mnB, alA, alB; bf16x8 pa0, pa1, pa2, pa3;
    SLOAD(sA, 0); asm volatile("s_waitcnt vmcnt(0)" ::: "memory"); SWRITE(0, sA); __syncthreads();
    qkt<ND>(pA0, pA1, K_lds, qr, r32, hi); partialSM<MODE>(pA0, pA1, m_reg, mnA, alA, na, 0, hi);
    SLOAD(sO, 64); if (SD == 2 && 2 < NT) SLOAD(sA, 128);
    SWAIT(); SWRITE(1, sO); __syncthreads();
    for (int j = 1; j + 1 < NT; j += 2) {
        SBAR(); qkt<ND>(pB0, pB1, K_lds + SHM_K, qr, r32, hi);
        finishSM(pA0, pA1, alA, l_reg, pa0, pa1, pa2, pa3); SBAR();
        SLOAD(sO, (j + SD) * 64); SBAR();
        pv_d0<NO>(o, vb0, pa0, pa1, pa2, pa3); partialSM<MODE>(pB0, pB1, m_reg, mnB, alB, na, j, hi);
        __syncthreads(); SWAIT(); SWRITE(0, sA);
        RESC(alB); __syncthreads();
        SBAR(); qkt<ND>(pA0, pA1, K_lds, qr, r32, hi);
        finishSM(pB0, pB1, alB, l_reg, pa0, pa1, pa2, pa3); SBAR();
        if (SD == 1 || j + 3 < NT) SLOAD(sA, (j + 1 + SD) * 64); SBAR();
        pv_d0<NO>(o, vb0 + SHM_V, pa0, pa1, pa2, pa3); partialSM<MODE>(pA0, pA1, m_reg, mnA, alA, na, j + 1, hi);
        __syncthreads(); SWAIT(); SWRITE(1, sO);
        RESC(alA); __syncthreads();
    }
    SBAR(); qkt<ND>(pB0, pB1, K_lds + SHM_K, qr, r32, hi);
    finishSM(pA0, pA1, alA, l_reg, pa0, pa1, pa2, pa3); SBAR();
    pv_d0<NO>(o, vb0, pa0, pa1, pa2, pa3); partialSM<MODE>(pB0, pB1, m_reg, mnB, alB, na, NT - 1, hi);
    __syncthreads(); RESC(alB);
    finishSM(pB0, pB1, alB, l_reg, pa0, pa1, pa2, pa3); SBAR();
    pv_d0<NO>(o, vb0 + SHM_V, pa0, pa1, pa2, pa3);
    if (hi == 0) li_l[r32] = l_reg;
    asm volatile("s_waitcnt lgkmcnt(0)" ::: "memory");
#pragma unroll
    for (int r = 0; r < 16; ++r) rli[r] = __builtin_amdgcn_rcpf(li_l[crow(r, hi)]);
#undef SLOAD
#undef SWRITE
#undef SWAIT
#undef RESC
}

__device__ __forceinline__ void na_item(const Params& p, int l, int item, char* lds) {
    const int xcd = item & 7, slot = item >> 3;
    const int pair = xcd * 4 + (slot >> 4), rb = slot & 15, b = pair >> 3, h = pair & 7;
    bf16_t* pa = (bf16_t*)(p.ws + OFF_PA);
    const int r0 = rb * 4, lo = min(max(r0 - 4, 0), 52);
    const int tid = otid(), wid = tid >> 6, lane = tid & 63, r32 = lane & 31, hi = lane >> 5;
    LAS float* tab = (LAS float*)((LAS unsigned char*)(uintptr_t)(unsigned)(uintptr_t)lds + 130 * 1024);
    const float* rpb = p.in[5] + ((size_t)l * 8 + h) * 465;
    if (tid < 465) tab[tid] = ((const GAS float*)rpb)[tid] * 8.0f;
    NaCtx na; const int wu = __builtin_amdgcn_readfirstlane(wid); const int r = r0 + (wu >> 1), qc = 32 * (wu & 1) + r32, rs = min(max(r - 4, 0), 56);
    na.vlo = rs - lo; na.vhi = na.vlo + 8; na.wstart = min(max(qc - 8, 0), 48); na.qc = qc; na.drow0 = lo - r + 7; na.tab = tab;
    const size_t tb = (size_t)b * SEQ;
    bf16_t* Q = pa + (tb + (size_t)r0 * 64) * 1536 + h * 64;
    const bf16_t* K = pa + (tb + (size_t)lo * 64) * 1536 + 512 + h * 64;
    const bf16_t* V = K + 512;
    f32x16 o[2]; float rli[16];
    attn_core<64, 64, 0, 1536, 1536, 1536, 1536, 1>(Q, K, K, V, 12, lds, o, rli, na);
    bf16_t* Ow = Q + (size_t)(wid * 32) * 1536;
#pragma unroll
    for (int rr = 0; rr < 16; ++rr) { const int orow = crow(rr, hi);
#pragma unroll
        for (int d = 0; d < 2; ++d) { const float v = o[d][rr] * rli[rr]; ((GAS bf16_t*)Ow)[(size_t)orow * 1536 + d * 32 + r32] = (bf16_t)(cvtpk(v, v) & 0xffffu); } }
    __syncthreads();
}
__device__ __forceinline__ void diff_item(const Params& p, int l, int item, char* lds) {
    const int xcd = item & 7, slot = item >> 3;
    const int pair = xcd * 2 + (slot >> 4), qb = slot & 15, b = pair >> 2, h = pair & 3;
    bf16_t* pd = (bf16_t*)(p.ws + OFF_PD);
    const int tid = otid(), wid = tid >> 6, lane = tid & 63, r32 = lane & 31, hi = lane >> 5;
    const float* lv = p.in[6] + (size_t)l * 256;
    float s1 = 0.f, s2 = 0.f;
    for (int i = 0; i < 64; ++i) { s1 += ((const GAS float*)lv)[i] * ((const GAS float*)lv)[64 + i]; s2 += ((const GAS float*)lv)[128 + i] * ((const GAS float*)lv)[192 + i]; }
    const float lam_init = p.lam_init[l], lam = __expf(s1) - __expf(s2) + lam_init;
    const size_t tb = (size_t)b * SEQ;
    bf16_t* Q = pd + (tb + (size_t)qb * 256) * 1536 + h * 128;
    const bf16_t* K = pd + tb * 1536 + 512 + h * 128;
    const bf16_t* V = pd + tb * 1536 + 1024 + h * 128;
    NaCtx na{};
    unsigned short* stash = (unsigned short*)(lds + 66 * 1024) + (size_t)wid * 64 * 64 + lane;
    f32x16 o[4]; float rli[16];
    attn_core<64, 128, 1, 1536, 1536, 1536, 1536, 2>(Q, K, K, V, 64, lds, o, rli, na);
#pragma unroll
    for (int d = 0; d < 4; ++d)
#pragma unroll
        for (int rr = 0; rr < 16; ++rr) { const float v = o[d][rr] * rli[rr]; stash[(d * 16 + rr) * 64] = (unsigned short)(cvtpk(v, v) & 0xffffu); }
    __syncthreads();
    attn_core<64, 128, 1, 1536, 1536, 1536, 1536, 2>(Q + 64, K + 64, K, V, 64, lds, o, rli, na);
    const float* sg = p.in[7] + (size_t)l * 128;
    float gcol[4];
#pragma unroll
    for (int d = 0; d < 4; ++d) gcol[d] = ((const GAS float*)sg)[d * 32 + r32] * (1.0f - lam_init);
    bf16_t* Ow = Q + (size_t)(wid * 32) * 1536;
#pragma unroll
    for (int rr = 0; rr < 16; ++rr) {
        float v[4]; float ss = 0.f;
#pragma unroll
        for (int d = 0; d < 4; ++d) { v[d] = bf2f(stash[(d * 16 + rr) * 64]) - lam * (o[d][rr] * rli[rr]); ss += v[d] * v[d]; }
        ss += __shfl_xor(ss, 1); ss += __shfl_xor(ss, 2); ss += __shfl_xor(ss, 4); ss += __shfl_xor(ss, 8); ss += __shfl_xor(ss, 16);
        const float rn = rsqrtf(ss * (1.0f / 128.0f) + 1e-6f);
        const int orow = crow(rr, hi);
#pragma unroll
        for (int d = 0; d < 4; ++d) { const float y = v[d] * rn * gcol[d]; ((GAS bf16_t*)Ow)[(size_t)orow * 1536 + d * 32 + r32] = (bf16_t)(cvtpk(y, y) & 0xffffu); }
    }
    __syncthreads();
}
__device__ __forceinline__ void mla_item(const Params& p, int item, char* lds) {
    const int xcd = item & 7, slot = item >> 3;
    const int pair = xcd * 4 + (slot >> 4), qb = slot & 15, b = pair >> 3, h = pair & 7;
    const int tid = otid(), wid = tid >> 6, lane = tid & 63, r32 = lane & 31, hi = lane >> 5;
    bf16_t* mc = (bf16_t*)(p.ws + OFF_MC); const bf16_t* mq = (const bf16_t*)(p.ws + OFF_MQ); const bf16_t* mkv = (const bf16_t*)(p.ws + OFF_MKV);
    const size_t tb = (size_t)b * SEQ;
    const bf16_t* Q = mq + (tb + (size_t)qb * 256) * 768 + h * 96;
    const bf16_t* K1 = mkv + tb * 1024 + h * 128;
    const bf16_t* K2 = mc + tb * 768 + 640;
    const bf16_t* V = K1 + 64;
    NaCtx na{};
    f32x16 o[2]; float rli[16];
    attn_core<96, 64, 2, 768, 1024, 768, 1024, 2>(Q, K1, K2, V, 64, lds, o, rli, na);
    bf16_t* Ow = mc + (tb + (size_t)qb * 256 + wid * 32) * 768 + h * 64;
#pragma unroll
    for (int rr = 0; rr < 16; ++rr) { const int orow = crow(rr, hi);
#pragma unroll
        for (int d = 0; d < 2; ++d) { const float v = o[d][rr] * rli[rr]; ((GAS bf16_t*)Ow)[(size_t)orow * 768 + d * 32 + r32] = (bf16_t)(cvtpk(v, v) & 0xffffu); } }
    __syncthreads();
}

struct MapId { __device__ __forceinline__ int operator()(int n) const { return n; } };
struct MapIn { __device__ __forceinline__ int operator()(int n) const { return n < 3744 ? n : (n < 3840 ? -1 : n - 96); } };
struct MapF1 { __device__ __forceinline__ int operator()(int n) const { const int pt = n >> 8, r = n & 255; return r < 128 ? pt * 128 + r : DFF + pt * 128 + (r - 128); } };
template <class Map>
__device__ __forceinline__ void prep_w(const float* __restrict__ src, int Ks, int Ns, bf16_t* __restrict__ dst, int Nd, int Kd, const float* __restrict__ kscale, Map map, float* tile) {
    const int tid = otid(), tx = tid & 63, ty = tid >> 6, nk = Kd / 64, ntile = (Nd / 64) * nk;
    for (int t = blockIdx.x; t < ntile; t += gridDim.x) {
        const int n0 = (t / nk) * 64, k0 = (t % nk) * 64;
        const int ns = map(n0 + tx);
#pragma unroll
        for (int j = 0; j < 8; ++j) { const int kl = ty + 8 * j, ks = (k0 + kl) % Ks; float v = 0.f;
            if (ns >= 0) { v = ((const GAS float*)src)[(size_t)ks * Ns + ns]; if (kscale) v *= ((const GAS float*)kscale)[ks]; }
            tile[kl * 65 + tx] = v; }
        __syncthreads();
        const int kx = (tid & 31) * 2, ny = tid >> 5;
#pragma unroll
        for (int j = 0; j < 4; ++j) { const int nl = ny + 16 * j;
            *(GAS unsigned*)(dst + (size_t)(n0 + nl) * Kd + k0 + kx) = cvtpk(tile[kx * 65 + nl], tile[(kx + 1) * 65 + nl]); }
        __syncthreads();
    }
}
__device__ __forceinline__ void ln_rows(const float* src, float* dstf, bf16_t* dstb, float* stats, const float* __restrict__ g, const float* __restrict__ bta, int row0, int nrows) {
    const int tid_ = otid(); const int lane = tid_ & 63, wv = blockIdx.x * 8 + (tid_ >> 6), nw = gridDim.x * 8;
    f32x4 gv[4], bv[4];
#pragma unroll
    for (int i = 0; i < 4; ++i) { gv[i] = *(const GAS f32x4*)(g + i * 256 + lane * 4); bv[i] = *(const GAS f32x4*)(bta + i * 256 + lane * 4); }
    for (int r = wv; r < nrows; r += nw) {
        const size_t ro = (size_t)(row0 + r) * 1024;
        f32x4 v[4]; float s = 0.f;
#pragma unroll
        for (int i = 0; i < 4; ++i) { v[i] = *(const GAS f32x4*)(src + ro + i * 256 + lane * 4); s += (v[i][0] + v[i][1]) + (v[i][2] + v[i][3]); }
#pragma unroll
        for (int k = 1; k < 64; k <<= 1) s += __shfl_xor(s, k);
        const float mu = s * (1.0f / 1024.0f); float q = 0.f;
#pragma unroll
        for (int i = 0; i < 4; ++i) { v[i] = v[i] - mu; q += (v[i][0] * v[i][0] + v[i][1] * v[i][1]) + (v[i][2] * v[i][2] + v[i][3] * v[i][3]); }
#pragma unroll
        for (int k = 1; k < 64; k <<= 1) q += __shfl_xor(q, k);
        const float rstd = rsqrtf(q * (1.0f / 1024.0f) + 1e-5f);
#pragma unroll
        for (int i = 0; i < 4; ++i) { const f32x4 y = v[i] * rstd * gv[i] + bv[i]; if (dstf) *(GAS f32x4*)(dstf + ro + i * 256 + lane * 4) = y;
            if (dstb) st_bf4(dstb + ro + i * 256 + lane * 4, y); }
        if (stats && lane == 0) { f32x2 ms; ms[0] = mu; ms[1] = rstd; *(GAS f32x2*)(stats + (size_t)(row0 + r) * 2) = ms; }
    }
}

#ifndef PHMASK
#define PHMASK 0xffff
#endif
#define WSP(T_, off) ((T_*)(wsb + (off)))
__device__ __forceinline__ void gsync(cg::grid_group& g) { asm volatile("s_waitcnt vmcnt(0)" ::: "memory"); g.sync(); __builtin_amdgcn_fence(__ATOMIC_ACQUIRE, "agent"); }
__global__ __launch_bounds__(512, 2) void fwd_megakernel(Params p) {
    extern __shared__ __attribute__((aligned(16))) unsigned char shm[];
    cg::grid_group grid = cg::this_grid();
    LAS unsigned char* ldsg = (LAS unsigned char*)shm;
    char* lds = (char*)shm;
    if (PHMASK & 512) {
        unsigned char* wsb = p.ws;
        float* tile = (float*)shm;
        for (int l = 0; l < DEPTH; ++l) {
            prep_w(p.in[3] + (size_t)l * 1024 * 6816, 1024, 6816, WSP(bf16_t, OFF_WIN) + (size_t)l * NIN * 1024, NIN, 1024, nullptr, MapIn(), tile);
            prep_w(p.in[10] + (size_t)l * 384 * 768, 384, 768, WSP(bf16_t, OFF_WQB) + (size_t)l * 768 * 384, 768, 384, p.in[8] + l * 384, MapId(), tile);
            prep_w(p.in[11] + (size_t)l * 256 * 1024, 256, 1024, WSP(bf16_t, OFF_WKVB) + (size_t)l * 1024 * 256, 1024, 256, p.in[9] + l * 256, MapId(), tile);
            for (int i = 0; i < 3; ++i)
                prep_w(p.in[12] + ((size_t)l * 3 + i) * 512 * 1024, 512, 1024, WSP(bf16_t, OFF_WBR) + ((size_t)l * 3 + i) * 1024 * 512, 1024, 512, nullptr, MapId(), tile);
            prep_w(p.in[13] + (size_t)l * 1024 * 1024, 1024, 1024, WSP(bf16_t, OFF_WOUT) + (size_t)l * 1024 * 3072, 1024, 3072, nullptr, MapId(), tile);
            prep_w(p.in[16] + (size_t)l * 1024 * 5632, 1024, 5632, WSP(bf16_t, OFF_WF1) + (size_t)l * 5632 * 1024, 5632, 1024, nullptr, MapF1(), tile);
            prep_w(p.in[17] + (size_t)l * 2816 * 1024, 2816, 1024, WSP(bf16_t, OFF_WF2) + (size_t)l * 1024 * 2816, 1024, 2816, nullptr, MapId(), tile);
        }
        const int gtid = blockIdx.x * 512 + otid(), gn = gridDim.x * 512;
        const float nlt = -13.122363377404328f;
        float* cd = WSP(float, OFF_TD); float* sd = cd + SEQ * 8; float* cm = WSP(float, OFF_TM); float* sm = cm + SEQ * 16;
        for (int i = gtid; i < SEQ * 8; i += gn) { const int pos = i >> 3, f = i & 7; const float inv = expf(nlt * (float)f / 8.0f), ang = (float)pos * inv; ((GAS float*)cd)[i] = cosf(ang); ((GAS float*)sd)[i] = sinf(ang); }
        for (int i = gtid; i < SEQ * 16; i += gn) { const int pos = i >> 4, f = i & 15; const float inv = expf(nlt * (float)f / 16.0f), ang = (float)pos * inv; ((GAS float*)cm)[i] = cosf(ang); ((GAS float*)sm)[i] = sinf(ang); }
        ln_rows(p.in[0], nullptr, WSP(bf16_t, OFF_XB), WSP(float, OFF_ST), p.in[1], p.in[2], 0, T_ALL);
    }
    gsync(grid);
    for (int step = 0; step < DEPTH * 13; ++step) {
      const int l = step / 13, ls = step % 13, nsub = ls == 4 ? 2 : 1;
      int zv_ = 0; asm volatile("" : "+v"(zv_)); const int zop = __builtin_amdgcn_readfirstlane(zv_);
      for (int sub = 0; sub < nsub; ++sub) {
        int ck, ph;
        if (ls < 4) { ck = 0; ph = ls; } else if (ls == 4) { ck = sub; ph = sub == 0 ? 4 : 0; } else if (ls < 9) { ck = 1; ph = ls - 4; } else { ck = 0; ph = ls - 4; }
        const size_t tok0 = ls < 9 ? (size_t)ck * TC : 0;
        const int mrows = ls < 9 ? TC : T_ALL;
        unsigned wlo_ = (unsigned)(uintptr_t)p.ws, whi_ = (unsigned)((uintptr_t)p.ws >> 32); asm volatile("" : "+v"(wlo_), "+v"(whi_));
        unsigned char* wsb = (unsigned char*)(((uintptr_t)(unsigned)__builtin_amdgcn_readfirstlane((int)whi_) << 32) | (uintptr_t)(unsigned)__builtin_amdgcn_readfirstlane((int)wlo_));
        switch (ph) {
        case 0: if (PHMASK & 1) {
            float* cd = WSP(float, OFF_TD); float* cm = WSP(float, OFF_TM);
            EpiIn E{WSP(bf16_t, OFF_PA), WSP(bf16_t, OFF_PD), WSP(bf16_t, OFF_MC), WSP(bf16_t, OFF_GT), WSP(float, OFF_SSQ), p.in[4 + zop] + (size_t)l * 3072, cd, cd + SEQ * 8, cm, cm + SEQ * 16};
            gemm_phase(ldsg, WSP(bf16_t, OFF_XB) + tok0 * 1024, 1024, WSP(bf16_t, OFF_WIN) + (size_t)l * NIN * 1024, 1024, TC, NIN, 1024, E);
        } break;
        case 1: if (PHMASK & 2) {
            if (PHMASK & 1024) { EpiKV E{WSP(bf16_t, OFF_MKV), WSP(float, OFF_SSQ)}; gemm_phase(ldsg, WSP(bf16_t, OFF_MC) + 384, 768, WSP(bf16_t, OFF_WKVB) + (size_t)l * 1024 * 256, 256, TC, 1024, 256, E); }
            if (PHMASK & 2048) { float* cm = WSP(float, OFF_TM); EpiQ E{WSP(bf16_t, OFF_MQ), WSP(float, OFF_SSQ), cm, cm + SEQ * 16}; gemm_phase(ldsg, WSP(bf16_t, OFF_MC), 768, WSP(bf16_t, OFF_WQB) + (size_t)l * 768 * 384, 384, TC, 768, 384, E); }
            __syncthreads();
            if (PHMASK & 4096) for (int it = blockIdx.x; it < 512; it += gridDim.x) na_item(p, l, it, lds);
        } break;
        case 2: if (PHMASK & 4) {
            if (PHMASK & 8192) for (int it = blockIdx.x; it < 256; it += gridDim.x) diff_item(p, l, it, lds);
            if (PHMASK & 16384) for (int it = blockIdx.x; it < 512; it += gridDim.x) mla_item(p, it, lds);
        } break;
        case 3: if (PHMASK & 8) {
            for (int i = 0; i < 3; ++i) {
                const bf16_t* A = i == 0 ? WSP(bf16_t, OFF_PA) : (i == 1 ? WSP(bf16_t, OFF_PD) : WSP(bf16_t, OFF_MC)); const int lda = i == 2 ? 768 : 1536;
                EpiBr E{WSP(bf16_t, OFF_GT), WSP(bf16_t, OFF_MKV), i};
                gemm_phase(ldsg, A, lda, WSP(bf16_t, OFF_WBR) + ((size_t)l * 3 + i) * 1024 * 512, 512, TC, 1024, 512, E);
            }
        } break;
        case 4: case 7: if (PHMASK & 16) {
            const float* lg = ph == 7 ? p.in[14 + zop] + l * 1024 : (l == 0 ? p.in[1 + zop] : p.in[18 + zop] + (l - 1) * 1024); const float* lb = ph == 7 ? p.in[15 + zop] + l * 1024 : (l == 0 ? p.in[2 + zop] : p.in[19 + zop] + (l - 1) * 1024);
            EpiRes E{((ph == 4 && l == 0) ? p.in[0 + zop] : (const float*)p.out) + tok0 * 1024, p.out + tok0 * 1024, WSP(float, OFF_ST) + tok0 * 2, lg, lb};
            const bf16_t* A = ph == 4 ? WSP(bf16_t, OFF_MKV) : WSP(bf16_t, OFF_PA); const int ld = ph == 4 ? 1024 : DFF, ldb_ = ph == 4 ? 3072 : DFF, kk = ph == 4 ? 1024 : DFF;
            const bf16_t* B = ph == 4 ? WSP(bf16_t, OFF_WOUT) + (size_t)l * 1024 * 3072 : WSP(bf16_t, OFF_WF2) + (size_t)l * 1024 * DFF;
            gemm_phase(ldsg, A, ld, B, ldb_, mrows, 1024, kk, E);
        } break;
        case 5: case 8: if (PHMASK & 32) {
            const float* g = ph == 5 ? p.in[14 + zop] : p.in[18 + zop]; const float* bb = ph == 5 ? p.in[15 + zop] : p.in[19 + zop];
            const bool fin = (ph == 8 && l == DEPTH - 1);
            ln_rows(p.out, fin ? p.out : nullptr, fin ? nullptr : WSP(bf16_t, OFF_XB), fin ? nullptr : WSP(float, OFF_ST), g + l * 1024, bb + l * 1024, (int)tok0, mrows);
        } break;
        case 6: if (PHMASK & 64) {
            EpiF1 E{WSP(bf16_t, OFF_PA)};
            gemm_phase(ldsg, WSP(bf16_t, OFF_XB) + tok0 * 1024, 1024, WSP(bf16_t, OFF_WF1) + (size_t)l * 5632 * 1024, 1024, mrows, 5632, 1024, E);
        } break;
        }
      }
      gsync(grid);
    }
}

extern "C" void kernel_launch(void* const* d_in, const int* in_sizes, int n_in, void* d_out, int out_size, void* d_ws, size_t ws_size, hipStream_t stream) {
    static int grid = 0;
    if (grid == 0) {
        if (n_in != 20 || in_sizes[0] != T_ALL * DM || out_size != T_ALL * DM || ws_size < WS_END) {
            fprintf(stderr, "kernel_launch: unexpected shapes / workspace (n_in %d, ws %zu, need %zu)\n", n_in, ws_size, (size_t)WS_END); grid = -1; return; }
        int dev = 0, cus = 0, per_cu = 0;
        hipGetDevice(&dev); hipDeviceGetAttribute(&cus, hipDeviceAttributeMultiprocessorCount, dev);
        if (hipFuncSetAttribute((const void*)fwd_megakernel, hipFuncAttributeMaxDynamicSharedMemorySize, LDS_BYTES) != hipSuccess) { fprintf(stderr, "kernel_launch: hipFuncSetAttribute failed\n"); grid = -1; return; }
        if (hipOccupancyMaxActiveBlocksPerMultiprocessor(&per_cu, (const void*)fwd_megakernel, 512, LDS_BYTES) != hipSuccess || per_cu < 1) { fprintf(stderr, "kernel_launch: occupancy query gave %d\n", per_cu); per_cu = 1; }
        (void)hipGetLastError();
        grid = cus;
    }
    if (grid < 0) return;
    Params p{};
    for (int i = 0; i < 20; ++i) p.in[i] = (const float*)d_in[i];
    p.out = (float*)d_out; p.ws = (unsigned char*)d_ws;
    for (int l = 0; l < 4; ++l) p.lam_init[l] = (float)(0.8 - 0.6 * exp(-0.3 * (double)l));
    void* args[] = {&p};
    hipError_t e = hipLaunchCooperativeKernel((const void*)fwd_megakernel, dim3(grid), dim3(512), args, LDS_BYTES, stream);
    if (e != hipSuccess) fprintf(stderr, "kernel_launch: cooperative launch failed: %s (grid %d)\n", hipGetErrorString(e), grid);
}
```

```cpp
#include <hip/hip_runtime.h>
#include <hip/hip_cooperative_groups.h>
#include <cstdio>
#include <cstdint>
namespace cg = cooperative_groups;

#define LAS __attribute__((address_space(3)))
#define GAS __attribute__((address_space(1)))
typedef unsigned short bf16_t;
typedef short bf16x8 __attribute__((ext_vector_type(8)));
typedef short s16x4 __attribute__((ext_vector_type(4)));
typedef float f32x4 __attribute__((ext_vector_type(4)));
typedef float f32x16 __attribute__((ext_vector_type(16)));
typedef unsigned u32x4 __attribute__((ext_vector_type(4)));
typedef unsigned u32x2 __attribute__((ext_vector_type(2)));

constexpr int T_ALL = 32768, TC = 16384, DM = 1024, SEQ = 4096, NIN = 6912, DFF = 2816, DEPTH = 4, NCHUNK = 2;
constexpr size_t SZ_WIN = (size_t)DEPTH * NIN * 1024 * 2, SZ_WQB = (size_t)DEPTH * 768 * 384 * 2, SZ_WKVB = (size_t)DEPTH * 1024 * 256 * 2,
                 SZ_WBR = (size_t)DEPTH * 3 * 1024 * 512 * 2, SZ_WOUT = (size_t)DEPTH * 1024 * 3072 * 2, SZ_WF1 = (size_t)DEPTH * 5632 * 1024 * 2,
                 SZ_WF2 = (size_t)DEPTH * 1024 * 2816 * 2, SZ_XB = (size_t)T_ALL * 1024 * 2, SZ_PA = (size_t)TC * 1536 * 2, SZ_PD = SZ_PA,
                 SZ_MC = (size_t)TC * 768 * 2, SZ_GT = (size_t)TC * 3072 * 2, SZ_MQ = (size_t)TC * 768 * 2, SZ_MKV = (size_t)TC * 1024 * 2,
                 SZ_SSQ = (size_t)TC * 24 * 4, SZ_TD = (size_t)SEQ * 8 * 4 * 2, SZ_TM = (size_t)SEQ * 16 * 4 * 2;
constexpr size_t OFF_WIN = 0, OFF_WQB = OFF_WIN + SZ_WIN, OFF_WKVB = OFF_WQB + SZ_WQB, OFF_WBR = OFF_WKVB + SZ_WKVB, OFF_WOUT = OFF_WBR + SZ_WBR,
                 OFF_WF1 = OFF_WOUT + SZ_WOUT, OFF_WF2 = OFF_WF1 + SZ_WF1, OFF_XB = OFF_WF2 + SZ_WF2, OFF_PA = OFF_XB + SZ_XB, OFF_PD = OFF_PA + SZ_PA,
                 OFF_MC = OFF_PD + SZ_PD, OFF_GT = OFF_MC + SZ_MC, OFF_MQ = OFF_GT + SZ_GT, OFF_MKV = OFF_MQ + SZ_MQ, OFF_SSQ = OFF_MKV + SZ_MKV,
                 OFF_TD = OFF_SSQ + SZ_SSQ, OFF_TM = OFF_TD + SZ_TD, OFF_ST = OFF_TM + SZ_TM, WS_END = OFF_ST + (size_t)T_ALL * 2 * 4;
constexpr int LDS_BYTES = 132 * 1024;
static_assert((size_t)T_ALL * DFF * 2 <= SZ_PA + SZ_PD + SZ_MC + SZ_GT, "SwiGLU hidden of all tokens aliases projA|projD|mla_c|gates");
constexpr float DN_ALPHA = 1.681792830507429f;

struct Params { const float* in[20]; float* out; unsigned char* ws; float lam_init[4]; };

typedef __bf16 bf2_t __attribute__((ext_vector_type(2)));
typedef float f32x2 __attribute__((ext_vector_type(2)));
__device__ __forceinline__ unsigned cvtpk(float lo, float hi) { f32x2 v = {lo, hi}; bf2_t b = __builtin_convertvector(v, bf2_t); return __builtin_bit_cast(unsigned, b); }
__device__ __forceinline__ int otid() { int t = threadIdx.x; asm volatile("" : "+v"(t)); return t; }
__device__ __forceinline__ float bf2f(unsigned short b) { return __uint_as_float(((unsigned)b) << 16); }
__device__ __forceinline__ void st_bf4(bf16_t* p, f32x4 v) { u32x2 w; w.x = cvtpk(v[0], v[1]); w.y = cvtpk(v[2], v[3]); *(GAS u32x2*)p = w; }

constexpr int BM = 256, BK = 64, HALF = 128, HTB = HALF * BK * 2, NXCD = 8, WGM = 8;
__device__ __forceinline__ int lds_byte(int r, int c) { const int st = (r >> 4) * 2 + (c >> 5), rr = r & 15, cc = c & 31, ob = rr * 64 + cc * 2; return st * 1024 + (ob ^ (((ob >> 9) & 1) << 5)); }
__device__ __forceinline__ void stage_rc(int b, int& R, int& C) { const int st = b / 1024, sb = b % 1024, swz = sb ^ (((sb >> 9) & 1) << 5); R = (st >> 1) * 16 + swz / 64; C = (st & 1) * 32 + (swz % 64) / 2; }
struct Unit { int pm, pn; };
struct StaticOrder {
    int nM, nN, nwg, G, c;
    __device__ void init(int M, int N, int G_, int c_) { nM = M / BM; nN = N / BM; nwg = nM * nN; G = G_; c = c_; }
    __device__ bool next(int i, Unit& u) const {
        const long L = (long)i * G + c; if (L >= nwg) return false;
        int wgid = (int)L; { const int q = nwg / NXCD, r = nwg % NXCD, xcd = wgid % NXCD, off = wgid / NXCD; wgid = (xcd < r ? xcd * (q + 1) : r * (q + 1) + (xcd - r) * q) + off; }
        const int nig = WGM * nN, gid = wgid / nig, fm = gid * WGM, gsz = (nM - fm) < WGM ? (nM - fm) : WGM;
        u.pm = __builtin_amdgcn_readfirstlane(fm + ((wgid % nig) % gsz)); u.pn = __builtin_amdgcn_readfirstlane((wgid % nig) / gsz); return true;
    }
};

template <class Epi>
__device__ __forceinline__ void gemm_phase(LAS unsigned char* lds, const bf16_t* A, int lda, const bf16_t* Bt, int ldb, int M, int N, int K, const Epi& E) {
    const int tid = otid(), wid = __builtin_amdgcn_readfirstlane(tid >> 6), lane = tid & 63, wr = wid >> 2, wc = wid & 3, fr = lane & 15, fq = lane >> 4;
    int ntv_ = K / BK; asm volatile("" : "+v"(ntv_)); const int nt = __builtin_amdgcn_readfirstlane(ntv_);
    StaticOrder S; S.init(M, N, (int)gridDim.x, (int)blockIdx.x);
    unsigned voffA[2], voffB[2];
#pragma unroll
    for (int i = 0; i < 2; ++i) { int R, C; stage_rc(tid * 16 + i * 8192, R, C); voffA[i] = (unsigned)(R * lda + C) * 2u; voffB[i] = (unsigned)(R * ldb + C) * 2u; }
    const size_t kstep = (size_t)(BK * 2);
    const size_t hstepA = (size_t)HALF * lda * 2, tstepA = 2 * hstepA, hstepB = (size_t)HALF * ldb * 2, tstepB = 2 * hstepB;
    const unsigned ldsw = (unsigned)wid * 1024u;
    const int aoff = lds_byte(wr * 64 + fr, fq * 8), boff = lds_byte(wc * 32 + fr, fq * 8);
#define PG8_SA(b, h) (((b) * 2 + (h)) * HTB)
#define PG8_SB(b, h) ((4 + (b) * 2 + (h)) * HTB)
#define PG8_STAGE(bufoff, gbase, voff) do { _Pragma("unroll") for (int _i = 0; _i < 2; ++_i) \
        __builtin_amdgcn_global_load_lds((const unsigned*)((const char*)(gbase) + (voff)[_i]), (LAS unsigned*)(lds + (bufoff) + ldsw + _i * 8192), 16, 0, 0); } while (0)
#define PG8_LDA(dst, b, h) do { _Pragma("unroll") for (int m = 0; m < 4; ++m) _Pragma("unroll") for (int k = 0; k < 2; ++k) dst[m][k] = *(const LAS bf16x8*)(lds + PG8_SA(b, h) + aoff + m * 2048 + k * 1024); } while (0)
#define PG8_LDB(dst, b, h) do { _Pragma("unroll") for (int n = 0; n < 2; ++n) _Pragma("unroll") for (int k = 0; k < 2; ++k) dst[n][k] = *(const LAS bf16x8*)(lds + PG8_SB(b, h) + boff + n * 2048 + k * 1024); } while (0)
#define PG8_MMA(ai, bj, At, Bt_) do { __builtin_amdgcn_s_setprio(1); _Pragma("unroll") for (int m = 0; m < 4; ++m) _Pragma("unroll") for (int n = 0; n < 2; ++n) _Pragma("unroll") for (int k = 0; k < 2; ++k) \
        acc[ai][bj][m][n] = __builtin_amdgcn_mfma_f32_16x16x32_bf16(Bt_[n][k], At[m][k], acc[ai][bj][m][n], 0, 0, 0); __builtin_amdgcn_s_setprio(0); } while (0)
#define PG8_WAIT_V(n) asm volatile("s_waitcnt vmcnt(" #n ")" ::: "memory")
#define PG8_WAIT_L(n) asm volatile("s_waitcnt lgkmcnt(" #n ")" ::: "memory")
#define PG8_BAR __builtin_amdgcn_s_barrier()
#define PG8_SCHED __builtin_amdgcn_sched_barrier(0)
    Unit cur, nxt; int ui = 0;
    if (!S.next(0, cur)) return;
    f32x4 acc[2][2][4][2];
#pragma unroll
    for (int a = 0; a < 2; ++a)
#pragma unroll
        for (int b = 0; b < 2; ++b)
#pragma unroll
            for (int m = 0; m < 4; ++m)
#pragma unroll
                for (int n = 0; n < 2; ++n) acc[a][b][m][n] = (f32x4){0.f, 0.f, 0.f, 0.f};
    bf16x8 At[4][2], B0[2][2], B1[2][2];
    const char* cA = (const char*)A + (size_t)cur.pm * tstepA; const char* cB = (const char*)Bt + (size_t)cur.pn * tstepB;
    PG8_STAGE(PG8_SB(0, 0), cB, voffB); PG8_STAGE(PG8_SA(0, 0), cA, voffA); PG8_STAGE(PG8_SB(0, 1), cB + hstepB, voffB); PG8_STAGE(PG8_SA(0, 1), cA + hstepA, voffA);
    if (wr == 1) PG8_BAR;
    PG8_WAIT_V(4); PG8_BAR;
    PG8_STAGE(PG8_SB(1, 0), cB + kstep, voffB); PG8_STAGE(PG8_SA(1, 0), cA + kstep, voffA); PG8_STAGE(PG8_SB(1, 1), cB + hstepB + kstep, voffB);
    PG8_WAIT_V(6); PG8_BAR;
    for (;;) {
        const bool has_next = S.next(ui + 1, nxt);
        const char* nA = has_next ? (const char*)A + (size_t)nxt.pm * tstepA : cA; const char* nB = has_next ? (const char*)Bt + (size_t)nxt.pn * tstepB : cB;
#pragma unroll 1
        for (int t = 0; t < nt; t += 2) {
            const bool last = (t == nt - 2);
            const char* a1 = cA + (size_t)(t + 1) * kstep;
            const char* a2 = last ? nA : cA + (size_t)(t + 2) * kstep; const char* b2 = last ? nB : cB + (size_t)(t + 2) * kstep;
            const char* a3 = a2 + kstep; const char* b3 = b2 + kstep;
            PG8_LDB(B0, 0, 0); PG8_SCHED; PG8_LDA(At, 0, 0); PG8_STAGE(PG8_SA(1, 1), a1 + hstepA, voffA);
            PG8_WAIT_L(8); PG8_BAR; PG8_WAIT_L(0); PG8_MMA(0, 0, At, B0); PG8_BAR; PG8_SCHED;
            PG8_LDB(B1, 0, 1); PG8_STAGE(PG8_SB(0, 0), b2, voffB);
            PG8_BAR; PG8_WAIT_L(0); PG8_MMA(0, 1, At, B1); PG8_BAR;
            PG8_LDA(At, 0, 1); PG8_STAGE(PG8_SA(0, 0), a2, voffA);
            PG8_BAR; PG8_WAIT_L(0); PG8_MMA(1, 0, At, B0); PG8_BAR; PG8_SCHED;
            PG8_STAGE(PG8_SB(0, 1), b2 + hstepB, voffB);
            PG8_WAIT_V(6); PG8_BAR; PG8_MMA(1, 1, At, B1); PG8_BAR;
            PG8_LDB(B0, 1, 0); PG8_SCHED; PG8_LDA(At, 1, 0); PG8_STAGE(PG8_SA(0, 1), a2 + hstepA, voffA);
            PG8_WAIT_L(8); PG8_BAR; PG8_WAIT_L(0); PG8_MMA(0, 0, At, B0); PG8_BAR; PG8_SCHED;
            PG8_LDB(B1, 1, 1); PG8_STAGE(PG8_SB(1, 0), b3, voffB);
            PG8_BAR; PG8_WAIT_L(0); PG8_MMA(0, 1, At, B1); PG8_BAR;
            PG8_LDA(At, 1, 1); PG8_STAGE(PG8_SA(1, 0), a3, voffA);
            PG8_BAR; PG8_WAIT_L(0); PG8_MMA(1, 0, At, B0); PG8_BAR; PG8_SCHED;
            PG8_STAGE(PG8_SB(1, 1), b3 + hstepB, voffB);
            PG8_WAIT_V(6); PG8_BAR; PG8_MMA(1, 1, At, B1); PG8_BAR;
        }
        E(acc, cur, wr, wc, fr, fq);
        if (!has_next) break;
#pragma unroll
        for (int a = 0; a < 2; ++a)
#pragma unroll
            for (int b = 0; b < 2; ++b)
#pragma unroll
                for (int m = 0; m < 4; ++m)
#pragma unroll
                    for (int n = 0; n < 2; ++n) acc[a][b][m][n] = (f32x4){0.f, 0.f, 0.f, 0.f};
        cur = nxt; cA = nA; cB = nB; ++ui;
    }
    PG8_WAIT_V(0);
    if (wr == 0) PG8_BAR;
    PG8_BAR;
#undef PG8_SA
#undef PG8_SB
#undef PG8_STAGE
#undef PG8_LDA
#undef PG8_LDB
#undef PG8_MMA
#undef PG8_WAIT_V
#undef PG8_WAIT_L
#undef PG8_BAR
#undef PG8_SCHED
}

struct EpiIn {
    bf16_t *pa, *pd, *mc, *gt; float* ssq; const float* bg; const float *cd, *sd, *cm, *sm;
    __device__ __forceinline__ void operator()(const f32x4 (&acc)[2][2][4][2], const Unit& u, int wr, int wc, int fr, int fq) const {
        int row0 = u.pm * BM + wr * 64 + fr; asm volatile("" : "+v"(row0) :: "memory"); const int pn = u.pn, cw = wc * 32 + 4 * fq;
        if (pn < 6) {
#pragma unroll
            for (int ai = 0; ai < 2; ++ai)
#pragma unroll
                for (int m = 0; m < 4; ++m) { __builtin_amdgcn_sched_barrier(0); bf16_t* rp = pa + (size_t)(row0 + ai * HALF + m * 16) * 1536 + pn * 256 + cw;
#pragma unroll
                    for (int bj = 0; bj < 2; ++bj)
#pragma unroll
                        for (int n = 0; n < 2; ++n) st_bf4(rp + bj * HALF + n * 16, acc[ai][bj][m][n]); }
        } else if (pn < 12) {
            const bool rope = (pn < 10) && !(wc & 1);
#pragma unroll
            for (int ai = 0; ai < 2; ++ai)
#pragma unroll
                for (int m = 0; m < 4; ++m) { __builtin_amdgcn_sched_barrier(0); const int row = row0 + ai * HALF + m * 16; bf16_t* rp = pd + (size_t)row * 1536 + (pn - 6) * 256 + cw;
                    f32x4 c4 = {1.f, 1.f, 1.f, 1.f}, s4 = {0.f, 0.f, 0.f, 0.f};
                    if (rope) { const int pos = row & (SEQ - 1); c4 = *(const GAS f32x4*)(cd + pos * 8 + (fq & 1) * 4); s4 = *(const GAS f32x4*)(sd + pos * 8 + (fq & 1) * 4); }
#pragma unroll
                    for (int bj = 0; bj < 2; ++bj) { f32x4 v0 = acc[ai][bj][m][0];
                        if (rope) { f32x4 pr;
#pragma unroll
                            for (int j = 0; j < 4; ++j) pr[j] = __shfl_xor(v0[j], 32);
                            v0 = (fq < 2) ? (v0 * c4 - pr * s4) : (v0 * c4 + pr * s4); }
                        st_bf4(rp + bj * HALF, v0); st_bf4(rp + bj * HALF + 16, acc[ai][bj][m][1]); } }
        } else if (pn < 15) {
            const int t = pn - 12;
#pragma unroll
            for (int ai = 0; ai < 2; ++ai)
#pragma unroll
                for (int m = 0; m < 4; ++m) { __builtin_amdgcn_sched_barrier(0); const int row = row0 + ai * HALF + m * 16; bf16_t* rp = mc + (size_t)row * 768 + t * 256 + cw;
#pragma unroll
                    for (int bj = 0; bj < 2; ++bj) { f32x4 v0 = acc[ai][bj][m][0], v1 = acc[ai][bj][m][1];
                        float s = (v0[0] * v0[0] + v0[1] * v0[1]) + (v0[2] * v0[2] + v0[3] * v0[3]) + (v1[0] * v1[0] + v1[1] * v1[1]) + (v1[2] * v1[2] + v1[3] * v1[3]);
                        s += __shfl_xor(s, 16); s += __shfl_xor(s, 32);
                        if (fq == 0) *(GAS float*)(ssq + (size_t)row * 24 + t * 8 + bj * 4 + wc) = s;
                        if (t == 2 && bj == 1 && wc == 0) { const int pos = row & (SEQ - 1); const f32x4 c4 = *(const GAS f32x4*)(cm + pos * 16 + fq * 4), s4 = *(const GAS f32x4*)(sm + pos * 16 + fq * 4);
                            const f32x4 n0 = v0 * c4 - v1 * s4, n1 = v1 * c4 + v0 * s4; v0 = n0; v1 = n1; }
                        st_bf4(rp + bj * HALF, v0); st_bf4(rp + bj * HALF + 16, v1); } }
        } else {
            const int t = pn - 15;
            f32x4 bv[2][2];
#pragma unroll
            for (int bj = 0; bj < 2; ++bj)
#pragma unroll
                for (int n = 0; n < 2; ++n) bv[bj][n] = *(const GAS f32x4*)(bg + t * 256 + bj * HALF + n * 16 + cw);
#pragma unroll
            for (int ai = 0; ai < 2; ++ai)
#pragma unroll
                for (int m = 0; m < 4; ++m) { __builtin_amdgcn_sched_barrier(0); bf16_t* rp = gt + (size_t)(row0 + ai * HALF + m * 16) * 3072 + t * 256 + cw;
#pragma unroll
                    for (int bj = 0; bj < 2; ++bj)
#pragma unroll
                        for (int n = 0; n < 2; ++n) { f32x4 v = acc[ai][bj][m][n] + bv[bj][n];
#pragma unroll
                            for (int j = 0; j < 4; ++j) v[j] = __builtin_amdgcn_rcpf(1.0f + __expf(-v[j]));
                            st_bf4(rp + bj * HALF + n * 16, v); } }
        }
    }
};
struct EpiQ {
    bf16_t* mq; const float* ssq; const float *cm, *sm;
    __device__ __forceinline__ void operator()(const f32x4 (&acc)[2][2][4][2], const Unit& u, int wr, int wc, int fr, int fq) const {
        int row0 = u.pm * BM + wr * 64 + fr; asm volatile("" : "+v"(row0) :: "memory"); const int cw = wc * 32 + 4 * fq;
        float rr8[8];
#pragma unroll
        for (int i = 0; i < 8; ++i) { const float* sp = ssq + (size_t)(row0 + (i >> 2) * HALF + (i & 3) * 16) * 24 + fq * 4;
            const f32x4 a = *(const GAS f32x4*)sp;
            float ss = fq < 3 ? ((a[0] + a[1]) + (a[2] + a[3])) : 0.f;
            ss += __shfl_xor(ss, 16); ss += __shfl_xor(ss, 32);
            rr8[i] = rsqrtf(ss * (1.0f / 384.0f) + 1e-6f); }
#pragma unroll
        for (int ai = 0; ai < 2; ++ai)
#pragma unroll
            for (int m = 0; m < 4; ++m) { __builtin_amdgcn_sched_barrier(0); const int row = row0 + ai * HALF + m * 16; const float r = rr8[ai * 4 + m];
                bf16_t* rp = mq + (size_t)row * 768 + u.pn * 256 + cw;
#pragma unroll
                for (int bj = 0; bj < 2; ++bj) { const int G = u.pn * 8 + bj * 4 + wc; f32x4 v0 = acc[ai][bj][m][0] * r, v1 = acc[ai][bj][m][1] * r;
                    if (G % 3 == 2) { const int pos = row & (SEQ - 1); const f32x4 c4 = *(const GAS f32x4*)(cm + pos * 16 + fq * 4), s4 = *(const GAS f32x4*)(sm + pos * 16 + fq * 4);
                        const f32x4 n0 = v0 * c4 - v1 * s4, n1 = v1 * c4 + v0 * s4; v0 = n0; v1 = n1; }
                    st_bf4(rp + bj * HALF, v0); st_bf4(rp + bj * HALF + 16, v1); } }
    }
};
struct EpiKV {
    bf16_t* mkv; const float* ssq;
    __device__ __forceinline__ void operator()(const f32x4 (&acc)[2][2][4][2], const Unit& u, int wr, int wc, int fr, int fq) const {
        int row0 = u.pm * BM + wr * 64 + fr; asm volatile("" : "+v"(row0) :: "memory"); const int cw = wc * 32 + 4 * fq;
        float rr8[8];
#pragma unroll
        for (int i = 0; i < 8; ++i) { const float* sp = ssq + (size_t)(row0 + (i >> 2) * HALF + (i & 3) * 16) * 24 + 12 + (fq & 1) * 4;
            const f32x4 a = *(const GAS f32x4*)sp;
            float ss = fq < 2 ? ((a[0] + a[1]) + (a[2] + a[3])) : 0.f;
            ss += __shfl_xor(ss, 16); ss += __shfl_xor(ss, 32);
            rr8[i] = rsqrtf(ss * (1.0f / 256.0f) + 1e-6f); }
#pragma unroll
        for (int ai = 0; ai < 2; ++ai)
#pragma unroll
            for (int m = 0; m < 4; ++m) { __builtin_amdgcn_sched_barrier(0); const int row = row0 + ai * HALF + m * 16; const float r = rr8[ai * 4 + m];
                bf16_t* rp = mkv + (size_t)row * 1024 + u.pn * 256 + cw;
#pragma unroll
                for (int bj = 0; bj < 2; ++bj)
#pragma unroll
                    for (int n = 0; n < 2; ++n) st_bf4(rp + bj * HALF + n * 16, acc[ai][bj][m][n] * r); }
    }
};
struct EpiBr {
    const bf16_t* gt; bf16_t* mg;
    int br;
    __device__ __forceinline__ void operator()(const f32x4 (&acc)[2][2][4][2], const Unit& u, int wr, int wc, int fr, int fq) const {
        int row0 = u.pm * BM + wr * 64 + fr; asm volatile("" : "+v"(row0) :: "memory"); const int cw = wc * 32 + 4 * fq;
#pragma unroll
        for (int ai = 0; ai < 2; ++ai)
#pragma unroll
            for (int m = 0; m < 4; ++m) { __builtin_amdgcn_sched_barrier(0); const size_t rr_ = (size_t)(row0 + ai * HALF + m * 16); const bf16_t* gp = gt + rr_ * 3072 + br * 1024 + u.pn * 256 + cw; bf16_t* rp = mg + rr_ * 1024 + u.pn * 256 + cw;
#pragma unroll
                for (int bj = 0; bj < 2; ++bj)
#pragma unroll
                    for (int n = 0; n < 2; ++n) { bf16_t* p = rp + bj * HALF + n * 16; const u32x2 g = *(const GAS u32x2*)(gp + bj * HALF + n * 16); const f32x4 a = acc[ai][bj][m][n];
                        f32x4 v; v[0] = a[0] * __uint_as_float(g.x << 16); v[1] = a[1] * __uint_as_float(g.x & 0xffff0000u); v[2] = a[2] * __uint_as_float(g.y << 16); v[3] = a[3] * __uint_as_float(g.y & 0xffff0000u);
                        if (br > 0) { const unsigned long long pv = __hip_atomic_load((const GAS unsigned long long*)p, __ATOMIC_RELAXED, __HIP_MEMORY_SCOPE_AGENT); const unsigned lo = (unsigned)pv, hi = (unsigned)(pv >> 32);
                            v[0] += __uint_as_float(lo << 16); v[1] += __uint_as_float(lo & 0xffff0000u); v[2] += __uint_as_float(hi << 16); v[3] += __uint_as_float(hi & 0xffff0000u); }
                        st_bf4(p, v); } }
    }
};
struct EpiRes {
    const float* xs; float* xd; const float* st; const float* g; const float* b;
    __device__ __forceinline__ void operator()(const f32x4 (&acc)[2][2][4][2], const Unit& u, int wr, int wc, int fr, int fq) const {
        int row0 = u.pm * BM + wr * 64 + fr; asm volatile("" : "+v"(row0) :: "memory"); const int cw = wc * 32 + 4 * fq;
#pragma unroll
        for (int bj = 0; bj < 2; ++bj) {
            f32x4 gv[2], bv[2];
#pragma unroll
            for (int n = 0; n < 2; ++n) { gv[n] = *(const GAS f32x4*)(g + u.pn * 256 + cw + bj * HALF + n * 16); bv[n] = *(const GAS f32x4*)(b + u.pn * 256 + cw + bj * HALF + n * 16); }
#pragma unroll
            for (int ai = 0; ai < 2; ++ai)
#pragma unroll
                for (int m = 0; m < 4; ++m) { __builtin_amdgcn_sched_barrier(0); const size_t row = (size_t)(row0 + ai * HALF + m * 16); const size_t ro = row * 1024 + u.pn * 256 + cw + bj * HALF;
                    const f32x2 ms = *(const GAS f32x2*)(st + row * 2);
#pragma unroll
                    for (int n = 0; n < 2; ++n) { const size_t o = ro + n * 16; const f32x4 xv = *(const GAS f32x4*)(xs + o);
                        const f32x4 xn = (xv - ms[0]) * ms[1] * gv[n] + bv[n]; *(GAS f32x4*)(xd + o) = xn * DN_ALPHA + acc[ai][bj][m][n]; } }
        }
    }
};
struct EpiF1 {
    bf16_t* hd;
    __device__ __forceinline__ void operator()(const f32x4 (&acc)[2][2][4][2], const Unit& u, int wr, int wc, int fr, int fq) const {
        int row0 = u.pm * BM + wr * 64 + fr; asm volatile("" : "+v"(row0) :: "memory"); const int cw = wc * 32 + 4 * fq;
#pragma unroll
        for (int ai = 0; ai < 2; ++ai)
#pragma unroll
            for (int m = 0; m < 4; ++m) { __builtin_amdgcn_sched_barrier(0); bf16_t* rp = hd + (size_t)(row0 + ai * HALF + m * 16) * DFF + u.pn * 128 + cw;
#pragma unroll
                for (int n = 0; n < 2; ++n) { const f32x4 g = acc[ai][0][m][n], uu = acc[ai][1][m][n]; f32x4 v;
#pragma unroll
                    for (int j = 0; j < 4; ++j) v[j] = g[j] * __builtin_amdgcn_rcpf(1.0f + __expf(-g[j])) * uu[j];
                    st_bf4(rp + n * 16, v); } }
    }
};

constexpr int SHM_V = 64 * 128 * 2, SHM_K = 64 * 128 * 2;
#define KSWZ(row, colB) ((row) * 256 + ((colB) ^ (((row) & 7) << 4)))
#define SBAR() __builtin_amdgcn_sched_barrier(0)
__device__ __forceinline__ int crow(int r, int hi) { return (r & 3) + 8 * (r >> 2) + 4 * hi; }
struct NaCtx { int vlo, vhi, wstart, qc, drow0; const LAS float* tab; };

template <int MODE>
__device__ __forceinline__ void partialSM(f32x16& p0, f32x16& p1, float& m_reg, float& mn, float& alpha, const NaCtx& na, int t, int hi) {
    constexpr float SCALE = MODE == 2 ? 0.10206207261596575f : 0.125f;
    constexpr float C = SCALE * 1.4426950408889634f;
    constexpr float THRS = 8.f / SCALE;
    if (MODE == 0) {
        const float NINF = -__builtin_inff();
        if (t < na.vlo || t >= na.vhi) {
#pragma unroll
            for (int r = 0; r < 16; ++r) { p0[r] = NINF; p1[r] = NINF; }
        } else {
            const LAS float* trow = na.tab + (na.drow0 + t) * 31 + (15 - na.qc);
#pragma unroll
            for (int q4 = 0; q4 < 4; ++q4) {
#pragma unroll
                for (int r = q4 * 4; r < q4 * 4 + 4; ++r) { const int kc = crow(r, hi); const bool ok0 = (unsigned)(kc - na.wstart) < 16u, ok1 = (unsigned)(kc + 32 - na.wstart) < 16u;
                    const float b0 = trow[ok0 ? kc : na.wstart], b1 = trow[ok1 ? kc + 32 : na.wstart];
                    p0[r] = ok0 ? p0[r] + b0 : NINF; p1[r] = ok1 ? p1[r] + b1 : NINF; }
                __builtin_amdgcn_sched_barrier(0); }
        }
    }
    float pmax = p0[0];
#pragma unroll
    for (int r = 1; r < 16; ++r) pmax = fmaxf(pmax, p0[r]);
#pragma unroll
    for (int r = 0; r < 16; ++r) pmax = fmaxf(pmax, p1[r]);
    { auto rr = __builtin_amdgcn_permlane32_swap(__float_as_uint(pmax), __float_as_uint(pmax), false, false);
      pmax = fmaxf(__uint_as_float(rr[0]), __uint_as_float(rr[1])); }
    if (__builtin_expect(__all(pmax - m_reg <= THRS), 1)) { mn = m_reg; alpha = 1.f; }
    else { mn = fmaxf(m_reg, pmax); alpha = __builtin_amdgcn_exp2f((m_reg - mn) * C); m_reg = mn; }
    const float mnC = -mn * C;
#pragma unroll
    for (int r = 0; r < 16; ++r) p0[r] = fmaf(p0[r], C, mnC);
#pragma unroll
    for (int r = 0; r < 16; ++r) p1[r] = fmaf(p1[r], C, mnC);
#pragma unroll
    for (int r = 0; r < 16; ++r) p0[r] = __builtin_amdgcn_exp2f(p0[r]);
}
__device__ __forceinline__ void finishSM(f32x16& p0, f32x16& p1, float alpha, float& l_reg, bf16x8& pa0, bf16x8& pa1, bf16x8& pa2, bf16x8& pa3) {
#pragma unroll
    for (int r = 0; r < 16; ++r) p1[r] = __builtin_amdgcn_exp2f(p1[r]);
    float ps = 0;
#pragma unroll
    for (int r = 0; r < 16; ++r) ps += p0[r];
#pragma unroll
    for (int r = 0; r < 16; ++r) ps += p1[r];
    { auto rr = __builtin_amdgcn_permlane32_swap(__float_as_uint(ps), __float_as_uint(ps), false, false);
      ps = __uint_as_float(rr[0]) + __uint_as_float(rr[1]); }
    l_reg = l_reg * alpha + ps;
#define PK4(P, BASE, OUT) do { unsigned a0 = cvtpk(P[BASE + 0], P[BASE + 1]), a1 = cvtpk(P[BASE + 2], P[BASE + 3]);   \
    unsigned b0 = cvtpk(P[BASE + 4], P[BASE + 5]), b1 = cvtpk(P[BASE + 6], P[BASE + 7]);                              \
    auto r0 = __builtin_amdgcn_permlane32_swap(a0, b0, false, false); auto r1 = __builtin_amdgcn_permlane32_swap(a1, b1, false, false); \
    u32x4 w = {r0[0], r1[0], r0[1], r1[1]}; OUT = *reinterpret_cast<bf16x8*>(&w); } while (0)
    PK4(p0, 0, pa0); PK4(p0, 8, pa1); PK4(p1, 0, pa2); PK4(p1, 8, pa3);
#undef PK4
}
template <int ND>
__device__ __forceinline__ void qkt(f32x16& p0, f32x16& p1, const char* Ks, const bf16x8* qr, int r32, int hi) {
    p0 = f32x16{}; p1 = f32x16{};
#pragma unroll
    for (int d0 = 0; d0 < ND; ++d0) { const int cb = (d0 * 16 + hi * 8) * 2;
        const bf16x8 b0 = *reinterpret_cast<const bf16x8*>(Ks + KSWZ(r32, cb));
        const bf16x8 b1 = *reinterpret_cast<const bf16x8*>(Ks + KSWZ(32 + r32, cb));
        p0 = __builtin_amdgcn_mfma_f32_32x32x16_bf16(b0, qr[d0], p0, 0, 0, 0);
        p1 = __builtin_amdgcn_mfma_f32_32x32x16_bf16(b1, qr[d0], p1, 0, 0, 0); }
}
__device__ __forceinline__ int v_st(int k, int c) { const int kk = (k & ~0xC) | ((k & 4) << 1) | ((k & 8) >> 1); return ((kk >> 3) * 4 + (c >> 5)) * 512 + ((kk & 7) * 32 + (c & 31)) * 2; }
__device__ __forceinline__ int v_rd_base(int lane) { return ((lane & 3) << 3) | (((lane >> 2) & 3) << 6) | (((lane >> 4) & 1) << 5) | (((lane >> 5) & 1) << 8); }
constexpr int v_rd_off(int d0, int ks, int half) { return d0 * 512 + ks * 4096 + half * 2048; }
template <int OFF> __device__ __forceinline__ s16x4 tr_read(int vb) {
    s16x4 r; asm volatile("ds_read_b64_tr_b16 %0, %1 offset:%2" : "=&v"(r) : "v"(vb), "i"(OFF) : "memory"); return r;
}
template <int D0> __device__ __forceinline__ void pv_one(f32x16& od, int vb, bf16x8 pa0, bf16x8 pa1, bf16x8 pa2, bf16x8 pa3) {
    const s16x4 l0 = tr_read<v_rd_off(D0, 0, 0)>(vb), h0 = tr_read<v_rd_off(D0, 0, 1)>(vb), l1 = tr_read<v_rd_off(D0, 1, 0)>(vb), h1 = tr_read<v_rd_off(D0, 1, 1)>(vb);
    const s16x4 l2 = tr_read<v_rd_off(D0, 2, 0)>(vb), h2 = tr_read<v_rd_off(D0, 2, 1)>(vb), l3 = tr_read<v_rd_off(D0, 3, 0)>(vb), h3 = tr_read<v_rd_off(D0, 3, 1)>(vb);
    asm volatile("s_waitcnt lgkmcnt(0)" ::: "memory"); SBAR();
#define PKV(L, H) (bf16x8){L[0], L[1], L[2], L[3], H[0], H[1], H[2], H[3]}
    od = __builtin_amdgcn_mfma_f32_32x32x16_bf16(pa0, PKV(l0, h0), od, 0, 0, 0);
    od = __builtin_amdgcn_mfma_f32_32x32x16_bf16(pa1, PKV(l1, h1), od, 0, 0, 0);
    od = __builtin_amdgcn_mfma_f32_32x32x16_bf16(pa2, PKV(l2, h2), od, 0, 0, 0);
    od = __builtin_amdgcn_mfma_f32_32x32x16_bf16(pa3, PKV(l3, h3), od, 0, 0, 0);
#undef PKV
}
template <int NO> __device__ __forceinline__ void pv_d0(f32x16* o, int vb, bf16x8 pa0, bf16x8 pa1, bf16x8 pa2, bf16x8 pa3) {
    pv_one<0>(o[0], vb, pa0, pa1, pa2, pa3); pv_one<1>(o[1], vb, pa0, pa1, pa2, pa3);
    if constexpr (NO == 4) { pv_one<2>(o[2], vb, pa0, pa1, pa2, pa3); pv_one<3>(o[3], vb, pa0, pa1, pa2, pa3); }
}

template <int DQ, int DV, int MODE, int ldq, int ldk, int ldk2, int ldv, int SD>
__device__ __forceinline__ void attn_core(const bf16_t* __restrict__ Qb, const bf16_t* __restrict__ K1, const bf16_t* __restrict__ K2,
                                          const bf16_t* __restrict__ Vh, int NT, char* lds, f32x16 (&o)[DV / 32], float (&rli)[16], const NaCtx& na) {
    constexpr int ND = DQ / 16, NO = DV / 32;
    const int tid = otid(), wid = tid >> 6, lane = tid & 63, r32 = lane & 31, hi = lane >> 5;
    char* V_lds = lds; char* K_lds = lds + 2 * SHM_V;
    float* ws = (float*)(lds + 2 * SHM_V + 2 * SHM_K) + wid * 64; float* li_l = ws; float* al_l = ws + 32;
    float m_reg = -1e30f, l_reg = 0;
#pragma unroll
    for (int d = 0; d < NO; ++d) o[d] = f32x16{};
    bf16x8 qr[ND];
    const bf16_t* Qw = Qb + (long)(wid * 32 + r32) * ldq + hi * 8;
#pragma unroll
    for (int d0 = 0; d0 < ND; ++d0) qr[d0] = *(const GAS bf16x8*)(Qw + d0 * 16);
    const int sr = tid >> 4, sc = (tid & 15) * 8, vst0 = v_st(sr, sc), vst1 = v_st(32 + sr, sc);
    const int vb0 = (int)(uintptr_t)V_lds + v_rd_base(lane);
    const bool ldV = sc < DV, ldK = sc < DQ;
    const bf16_t* kp; long kld;
    if (DQ > 64 && sc >= 64) { kp = K2 + (sc - 64); kld = ldk2; } else { kp = K1 + sc; kld = ldk; }
    const bf16_t* vp = Vh + sc;
    struct Slot { bf16x8 vs0, vs1, ks0, ks1; };
    Slot sA, sB; sA.vs0 = sA.vs1 = sA.ks0 = sA.ks1 = bf16x8{}; sB = sA;
    Slot& sO = (SD == 2) ? sB : sA;
#define SLOAD(S_, k0) do { if (ldV) { S_.vs0 = *(const GAS bf16x8*)(vp + (long)((k0) + sr) * ldv); S_.vs1 = *(const GAS bf16x8*)(vp + (long)((k0) + 32 + sr) * ldv); } \
    if (ldK) { S_.ks0 = *(const GAS bf16x8*)(kp + (long)((k0) + sr) * kld); S_.ks1 = *(const GAS bf16x8*)(kp + (long)((k0) + 32 + sr) * kld); } } while (0)
#define SWRITE(b, S_) do { if (ldV) { *(bf16x8*)(V_lds + (b) * SHM_V + vst0) = S_.vs0; *(bf16x8*)(V_lds + (b) * SHM_V + vst1) = S_.vs1; } \
    if (ldK) { const int kc = sc * 2; *(bf16x8*)(K_lds + (b) * SHM_K + KSWZ(sr, kc)) = S_.ks0; *(bf16x8*)(K_lds + (b) * SHM_K + KSWZ(32 + sr, kc)) = S_.ks1; } } while (0)
#define SWAIT() do { if (SD == 2) asm volatile("s_waitcnt vmcnt(4)" ::: "memory"); else asm volatile("s_waitcnt vmcnt(0)" ::: "memory"); } while (0)
#define RESC(a) do { if (__any((a) < 1.f)) { if (hi == 0) al_l[r32] = (a); asm volatile("s_waitcnt lgkmcnt(0)" ::: "memory"); \
    _Pragma("unroll") for (int d = 0; d < NO; ++d) _Pragma("unroll") for (int r = 0; r < 16; ++r) o[d][r] *= al_l[crow(r, hi)]; } } while (0)
    f32x16 pA0, pA1, pB0, pB1; float mnA, mnB, alA, alB; bf16x8 pa0, pa1, pa2, pa3;
    SLOAD(sA, 0); asm volatile("s_waitcnt vmcnt(0)" ::: "memory"); SWRITE(0, sA); __syncthreads();
    qkt<ND>(pA0, pA1, K_lds, qr, r32, hi); partialSM<MODE>(pA0, pA1, m_reg, mnA, alA, na, 0, hi);
    SLOAD(sO, 64); if (SD == 2 && 2 < NT) SLOAD(sA, 128);
    SWAIT(); SWRITE(1, sO); __syncthreads();
    for (int j = 1; j + 1 < NT; j += 2) {
        SBAR(); qkt<ND>(pB0, pB1, K_lds + SHM_K, qr, r32, hi);
        finishSM(pA0, pA1, alA, l_reg, pa0, pa1, pa2, pa3); SBAR();
        SLOAD(sO, (j + SD) * 64); SBAR();
        pv_d0<NO>(o, vb0, pa0, pa1, pa2, pa3); partialSM<MODE>(pB0, pB1, m_reg, mnB, alB, na, j, hi);
        __syncthreads(); SWAIT(); SWRITE(0, sA);
        RESC(alB); __syncthreads();
        SBAR(); qkt<ND>(pA0, pA1, K_lds, qr, r32, hi);
        finishSM(pB0, pB1, alB, l_reg, pa0, pa1, pa2, pa3); SBAR();
        if (SD == 1 || j + 3 < NT) SLOAD(sA, (j + 1 + SD) * 64); SBAR();
        pv_d0<NO>(o, vb0 + SHM_V, pa0, pa1, pa2, pa3); partialSM<MODE>(pA0, pA1, m_reg, mnA, alA, na, j + 1, hi);
        __syncthreads(); SWAIT(); SWRITE(1, sO);
        RESC(alA); __syncthreads();
    }
    SBAR(); qkt<ND>(pB0, pB1, K_lds + SHM_K, qr, r32, hi);
    finishSM(pA0, pA1, alA, l_reg, pa0, pa1, pa2, pa3); SBAR();
    pv_d0<NO>(o, vb0, pa0, pa1, pa2, pa3); partialSM<MODE>(pB0, pB1, m_reg, mnB, alB, na, NT - 1, hi);
    __syncthreads(); RESC(alB);
    finishSM(pB0, pB1, alB, l_reg, pa0, pa1, pa2, pa3); SBAR();
    pv_d0<NO>(o, vb0 + SHM_V, pa0, pa1, pa2, pa3);
    if (hi == 0) li_l[r32] = l_reg;
    asm volatile("s_waitcnt lgkmcnt(0)" ::: "memory");
#pragma unroll
    for (int r = 0; r < 16; ++r) rli[r] = __builtin_amdgcn_rcpf(li_l[crow(r, hi)]);
#undef SLOAD
#undef SWRITE
#undef SWAIT
#undef RESC
}

__device__ __forceinline__ void na_item(const Params& p, int l, int item, char* lds) {
    const int xcd = item & 7, slot = item >> 3;
    const int pair = xcd * 4 + (slot >> 4), rb = slot & 15, b = pair >> 3, h = pair & 7;
    bf16_t* pa = (bf16_t*)(p.ws + OFF_PA);
    const int r0 = rb * 4, lo = min(max(r0 - 4, 0), 52);
    const int tid = otid(), wid = tid >> 6, lane = tid & 63, r32 = lane & 31, hi = lane >> 5;
    LAS float* tab = (LAS float*)((LAS unsigned char*)(uintptr_t)(unsigned)(uintptr_t)lds + 130 * 1024);
    const float* rpb = p.in[5] + ((size_t)l * 8 + h) * 465;
    if (tid < 465) tab[tid] = ((const GAS float*)rpb)[tid] * 8.0f;
    NaCtx na; const int wu = __builtin_amdgcn_readfirstlane(wid); const int r = r0 + (wu >> 1), qc = 32 * (wu & 1) + r32, rs = min(max(r - 4, 0), 56);
    na.vlo = rs - lo; na.vhi = na.vlo + 8; na.wstart = min(max(qc - 8, 0), 48); na.qc = qc; na.drow0 = lo - r + 7; na.tab = tab;
    const size_t tb = (size_t)b * SEQ;
    bf16_t* Q = pa + (tb + (size_t)r0 * 64) * 1536 + h * 64;
    const bf16_t* K = pa + (tb + (size_t)lo * 64) * 1536 + 512 + h * 64;
    const bf16_t* V = K + 512;
    f32x16 o[2]; float rli[16];
    attn_core<64, 64, 0, 1536, 1536, 1536, 1536, 1>(Q, K, K, V, 12, lds, o, rli, na);
    bf16_t* Ow = Q + (size_t)(wid * 32) * 1536;
#pragma unroll
    for (int rr = 0; rr < 16; ++rr) { const int orow = crow(rr, hi);
#pragma unroll
        for (int d = 0; d < 2; ++d) { const float v = o[d][rr] * rli[rr]; ((GAS bf16_t*)Ow)[(size_t)orow * 1536 + d * 32 + r32] = (bf16_t)(cvtpk(v, v) & 0xffffu); } }
    __syncthreads();
}
__device__ __forceinline__ void diff_item(const Params& p, int l, int item, char* lds) {
    const int xcd = item & 7, slot = item >> 3;
    const int pair = xcd * 2 + (slot >> 4), qb = slot & 15, b = pair >> 2, h = pair & 3;
    bf16_t* pd = (bf16_t*)(p.ws + OFF_PD);
    const int tid = otid(), wid = tid >> 6, lane = tid & 63, r32 = lane & 31, hi = lane >> 5;
    const float* lv = p.in[6] + (size_t)l * 256;
    float s1 = 0.f, s2 = 0.f;
    for (int i = 0; i < 64; ++i) { s1 += ((const GAS float*)lv)[i] * ((const GAS float*)lv)[64 + i]; s2 += ((const GAS float*)lv)[128 + i] * ((const GAS float*)lv)[192 + i]; }
    const float lam_init = p.lam_init[l], lam = __expf(s1) - __expf(s2) + lam_init;
    const size_t tb = (size_t)b * SEQ;
    bf16_t* Q = pd + (tb + (size_t)qb * 256) * 1536 + h * 128;
    const bf16_t* K = pd + tb * 1536 + 512 + h * 128;
    const bf16_t* V = pd + tb * 1536 + 1024 + h * 128;
    NaCtx na{};
    unsigned short* stash = (unsigned short*)(lds + 66 * 1024) + (size_t)wid * 64 * 64 + lane;
    f32x16 o[4]; float rli[16];
    attn_core<64, 128, 1, 1536, 1536, 1536, 1536, 2>(Q, K, K, V, 64, lds, o, rli, na);
#pragma unroll
    for (int d = 0; d < 4; ++d)
#pragma unroll
        for (int rr = 0; rr < 16; ++rr) { const float v = o[d][rr] * rli[rr]; stash[(d * 16 + rr) * 64] = (unsigned short)(cvtpk(v, v) & 0xffffu); }
    __syncthreads();
    attn_core<64, 128, 1, 1536, 1536, 1536, 1536, 2>(Q + 64, K + 64, K, V, 64, lds, o, rli, na);
    const float* sg = p.in[7] + (size_t)l * 128;
    float gcol[4];
#pragma unroll
    for (int d = 0; d < 4; ++d) gcol[d] = ((const GAS float*)sg)[d * 32 + r32] * (1.0f - lam_init);
    bf16_t* Ow = Q + (size_t)(wid * 32) * 1536;
#pragma unroll
    for (int rr = 0; rr < 16; ++rr) {
        float v[4]; float ss = 0.f;
#pragma unroll
        for (int d = 0; d < 4; ++d) { v[d] = bf2f(stash[(d * 16 + rr) * 64]) - lam * (o[d][rr] * rli[rr]); ss += v[d] * v[d]; }
        ss += __shfl_xor(ss, 1); ss += __shfl_xor(ss, 2); ss += __shfl_xor(ss, 4); ss += __shfl_xor(ss, 8); ss += __shfl_xor(ss, 16);
        const float rn = rsqrtf(ss * (1.0f / 128.0f) + 1e-6f);
        const int orow = crow(rr, hi);
#pragma unroll
        for (int d = 0; d < 4; ++d) { const float y = v[d] * rn * gcol[d]; ((GAS bf16_t*)Ow)[(size_t)orow * 1536 + d * 32 + r32] = (bf16_t)(cvtpk(y, y) & 0xffffu); }
    }
    __syncthreads();
}
__device__ __forceinline__ void mla_item(const Params& p, int item, char* lds) {
    const int xcd = item & 7, slot = item >> 3;
    const int pair = xcd * 4 + (slot >> 4), qb = slot & 15, b = pair >> 3, h = pair & 7;
    const int tid = otid(), wid = tid >> 6, lane = tid & 63, r32 = lane & 31, hi = lane >> 5;
    bf16_t* mc = (bf16_t*)(p.ws + OFF_MC); const bf16_t* mq = (const bf16_t*)(p.ws + OFF_MQ); const bf16_t* mkv = (const bf16_t*)(p.ws + OFF_MKV);
    const size_t tb = (size_t)b * SEQ;
    const bf16_t* Q = mq + (tb + (size_t)qb * 256) * 768 + h * 96;
    const bf16_t* K1 = mkv + tb * 1024 + h * 128;
    const bf16_t* K2 = mc + tb * 768 + 640;
    const bf16_t* V = K1 + 64;
    NaCtx na{};
    f32x16 o[2]; float rli[16];
    attn_core<96, 64, 2, 768, 1024, 768, 1024, 2>(Q, K1, K2, V, 64, lds, o, rli, na);
    bf16_t* Ow = mc + (tb + (size_t)qb * 256 + wid * 32) * 768 + h * 64;
#pragma unroll
    for (int rr = 0; rr < 16; ++rr) { const int orow = crow(rr, hi);
#pragma unroll
        for (int d = 0; d < 2; ++d) { const float v = o[d][rr] * rli[rr]; ((GAS bf16_t*)Ow)[(size_t)orow * 768 + d * 32 + r32] = (bf16_t)(cvtpk(v, v) & 0xffffu); } }
    __syncthreads();
}

struct MapId { __device__ __forceinline__ int operator()(int n) const { return n; } };
struct MapIn { __device__ __forceinline__ int operator()(int n) const { return n < 3744 ? n : (n < 3840 ? -1 : n - 96); } };
struct MapF1 { __device__ __forceinline__ int operator()(int n) const { const int pt = n >> 8, r = n & 255; return r < 128 ? pt * 128 + r : DFF + pt * 128 + (r - 128); } };
template <class Map>
__device__ __forceinline__ void prep_w(const float* __restrict__ src, int Ks, int Ns, bf16_t* __restrict__ dst, int Nd, int Kd, const float* __restrict__ kscale, Map map, float* tile) {
    const int tid = otid(), nk = Kd / 64, ntile = (Nd / 64) * nk;
    const int lk = tid >> 4, ln = (tid & 15) * 4;
    const int sn = tid >> 3, sk = (tid & 7) * 8;
    for (int t = blockIdx.x; t < ntile; t += gridDim.x) {
        const int n0 = (t / nk) * 64, k0 = (t % nk) * 64;
        const int ns = map(n0 + ln);
#pragma unroll
        for (int j = 0; j < 2; ++j) { const int kl = lk + 32 * j, ks = (k0 + kl) % Ks; f32x4 v = {0.f, 0.f, 0.f, 0.f};
            if (ns >= 0) { v = *(const GAS f32x4*)(src + (size_t)ks * Ns + ns); if (kscale) v = v * ((const GAS float*)kscale)[ks]; }
            *(f32x4*)(tile + kl * 68 + ln) = v; }
        __syncthreads();
        u32x4 w;
        w.x = cvtpk(tile[(sk + 0) * 68 + sn], tile[(sk + 1) * 68 + sn]); w.y = cvtpk(tile[(sk + 2) * 68 + sn], tile[(sk + 3) * 68 + sn]);
        w.z = cvtpk(tile[(sk + 4) * 68 + sn], tile[(sk + 5) * 68 + sn]); w.w = cvtpk(tile[(sk + 6) * 68 + sn], tile[(sk + 7) * 68 + sn]);
        *(GAS u32x4*)(dst + (size_t)(n0 + sn) * Kd + k0 + sk) = w;
        __syncthreads();
    }
}
__device__ __forceinline__ void ln_rows(const float* src, float* dstf, bf16_t* dstb, float* stats, const float* __restrict__ g, const float* __restrict__ bta, int row0, int nrows) {
    const int tid_ = otid(); const int lane = tid_ & 63, wv = blockIdx.x * 8 + (tid_ >> 6), nw = gridDim.x * 8;
    f32x4 gv[4], bv[4];
#pragma unroll
    for (int i = 0; i < 4; ++i) { gv[i] = *(const GAS f32x4*)(g + i * 256 + lane * 4); bv[i] = *(const GAS f32x4*)(bta + i * 256 + lane * 4); }
    for (int r = wv; r < nrows; r += nw) {
        const size_t ro = (size_t)(row0 + r) * 1024;
        f32x4 v[4]; float s = 0.f;
#pragma unroll
        for (int i = 0; i < 4; ++i) { v[i] = *(const GAS f32x4*)(src + ro + i * 256 + lane * 4); s += (v[i][0] + v[i][1]) + (v[i][2] + v[i][3]); }
#pragma unroll
        for (int k = 1; k < 64; k <<= 1) s += __shfl_xor(s, k);
        const float mu = s * (1.0f / 1024.0f); float q = 0.f;
#pragma unroll
        for (int i = 0; i < 4; ++i) { v[i] = v[i] - mu; q += (v[i][0] * v[i][0] + v[i][1] * v[i][1]) + (v[i][2] * v[i][2] + v[i][3] * v[i][3]); }
#pragma unroll
        for (int k = 1; k < 64; k <<= 1) q += __shfl_xor(q, k);
        const float rstd = rsqrtf(q * (1.0f / 1024.0f) + 1e-5f);
#pragma unroll
        for (int i = 0; i < 4; ++i) { const f32x4 y = v[i] * rstd * gv[i] + bv[i]; if (dstf) *(GAS f32x4*)(dstf + ro + i * 256 + lane * 4) = y;
            if (dstb) st_bf4(dstb + ro + i * 256 + lane * 4, y); }
        if (stats && lane == 0) { f32x2 ms; ms[0] = mu; ms[1] = rstd; *(GAS f32x2*)(stats + (size_t)(row0 + r) * 2) = ms; }
    }
}

#ifndef PHMASK
#define PHMASK 0xffff
#endif
#define WSP(T_, off) ((T_*)(wsb + (off)))
__device__ __forceinline__ void gsync(cg::grid_group& g) { asm volatile("s_waitcnt vmcnt(0)" ::: "memory"); g.sync(); __builtin_amdgcn_fence(__ATOMIC_ACQUIRE, "agent"); }
__global__ __launch_bounds__(512, 2) void fwd_megakernel(Params p) {
    extern __shared__ __attribute__((aligned(16))) unsigned char shm[];
    cg::grid_group grid = cg::this_grid();
    LAS unsigned char* ldsg = (LAS unsigned char*)shm;
    char* lds = (char*)shm;
    if (PHMASK & 512) {
        unsigned char* wsb = p.ws;
        float* tile = (float*)shm;
        for (int l = 0; l < DEPTH; ++l) {
            prep_w(p.in[3] + (size_t)l * 1024 * 6816, 1024, 6816, WSP(bf16_t, OFF_WIN) + (size_t)l * NIN * 1024, NIN, 1024, nullptr, MapIn(), tile);
            prep_w(p.in[10] + (size_t)l * 384 * 768, 384, 768, WSP(bf16_t, OFF_WQB) + (size_t)l * 768 * 384, 768, 384, p.in[8] + l * 384, MapId(), tile);
            prep_w(p.in[11] + (size_t)l * 256 * 1024, 256, 1024, WSP(bf16_t, OFF_WKVB) + (size_t)l * 1024 * 256, 1024, 256, p.in[9] + l * 256, MapId(), tile);
            for (int i = 0; i < 3; ++i)
                prep_w(p.in[12] + ((size_t)l * 3 + i) * 512 * 1024, 512, 1024, WSP(bf16_t, OFF_WBR) + ((size_t)l * 3 + i) * 1024 * 512, 1024, 512, nullptr, MapId(), tile);
            prep_w(p.in[13] + (size_t)l * 1024 * 1024, 1024, 1024, WSP(bf16_t, OFF_WOUT) + (size_t)l * 1024 * 3072, 1024, 3072, nullptr, MapId(), tile);
            prep_w(p.in[16] + (size_t)l * 1024 * 5632, 1024, 5632, WSP(bf16_t, OFF_WF1) + (size_t)l * 5632 * 1024, 5632, 1024, nullptr, MapF1(), tile);
            prep_w(p.in[17] + (size_t)l * 2816 * 1024, 2816, 1024, WSP(bf16_t, OFF_WF2) + (size_t)l * 1024 * 2816, 1024, 2816, nullptr, MapId(), tile);
        }
        const int gtid = blockIdx.x * 512 + otid(), gn = gridDim.x * 512;
        const float nlt = -13.122363377404328f;
        float* cd = WSP(float, OFF_TD); float* sd = cd + SEQ * 8; float* cm = WSP(float, OFF_TM); float* sm = cm + SEQ * 16;
        for (int i = gtid; i < SEQ * 8; i += gn) { const int pos = i >> 3, f = i & 7; const float inv = expf(nlt * (float)f / 8.0f), ang = (float)pos * inv; ((GAS float*)cd)[i] = cosf(ang); ((GAS float*)sd)[i] = sinf(ang); }
        for (int i = gtid; i < SEQ * 16; i += gn) { const int pos = i >> 4, f = i & 15; const float inv = expf(nlt * (float)f / 16.0f), ang = (float)pos * inv; ((GAS float*)cm)[i] = cosf(ang); ((GAS float*)sm)[i] = sinf(ang); }
        ln_rows(p.in[0], nullptr, WSP(bf16_t, OFF_XB), WSP(float, OFF_ST), p.in[1], p.in[2], 0, T_ALL);
    }
    gsync(grid);
    for (int step = 0; step < DEPTH * 13; ++step) {
      const int l = step / 13, ls = step % 13, nsub = ls == 4 ? 2 : 1;
      int zv_ = 0; asm volatile("" : "+v"(zv_)); const int zop = __builtin_amdgcn_readfirstlane(zv_);
      for (int sub = 0; sub < nsub; ++sub) {
        int ck, ph;
        if (ls < 4) { ck = 0; ph = ls; } else if (ls == 4) { ck = sub; ph = sub == 0 ? 4 : 0; } else if (ls < 9) { ck = 1; ph = ls - 4; } else { ck = 0; ph = ls - 4; }
        const size_t tok0 = ls < 9 ? (size_t)ck * TC : 0;
        const int mrows = ls < 9 ? TC : T_ALL;
        unsigned wlo_ = (unsigned)(uintptr_t)p.ws, whi_ = (unsigned)((uintptr_t)p.ws >> 32); asm volatile("" : "+v"(wlo_), "+v"(whi_));
        unsigned char* wsb = (unsigned char*)(((uintptr_t)(unsigned)__builtin_amdgcn_readfirstlane((int)whi_) << 32) | (uintptr_t)(unsigned)__builtin_amdgcn_readfirstlane((int)wlo_));
        switch (ph) {
        case 0: if (PHMASK & 1) {
            float* cd = WSP(float, OFF_TD); float* cm = WSP(float, OFF_TM);
            EpiIn E{WSP(bf16_t, OFF_PA), WSP(bf16_t, OFF_PD), WSP(bf16_t, OFF_MC), WSP(bf16_t, OFF_GT), WSP(float, OFF_SSQ), p.in[4 + zop] + (size_t)l * 3072, cd, cd + SEQ * 8, cm, cm + SEQ * 16};
            gemm_phase(ldsg, WSP(bf16_t, OFF_XB) + tok0 * 1024, 1024, WSP(bf16_t, OFF_WIN) + (size_t)l * NIN * 1024, 1024, TC, NIN, 1024, E);
        } break;
        case 1: if (PHMASK & 2) {
            if (PHMASK & 1024) { EpiKV E{WSP(bf16_t, OFF_MKV), WSP(float, OFF_SSQ)}; gemm_phase(ldsg, WSP(bf16_t, OFF_MC) + 384, 768, WSP(bf16_t, OFF_WKVB) + (size_t)l * 1024 * 256, 256, TC, 1024, 256, E); }
            if (PHMASK & 2048) { float* cm = WSP(float, OFF_TM); EpiQ E{WSP(bf16_t, OFF_MQ), WSP(float, OFF_SSQ), cm, cm + SEQ * 16}; gemm_phase(ldsg, WSP(bf16_t, OFF_MC), 768, WSP(bf16_t, OFF_WQB) + (size_t)l * 768 * 384, 384, TC, 768, 384, E); }
            __syncthreads();
            if (PHMASK & 4096) for (int it = blockIdx.x; it < 512; it += gridDim.x) na_item(p, l, it, lds);
        } break;
        case 2: if (PHMASK & 4) {
            if (PHMASK & 8192) for (int it = blockIdx.x; it < 256; it += gridDim.x) diff_item(p, l, it, lds);
            if (PHMASK & 16384) for (int it = blockIdx.x; it < 512; it += gridDim.x) mla_item(p, it, lds);
        } break;
        case 3: if (PHMASK & 8) {
            for (int i = 0; i < 3; ++i) {
                const bf16_t* A = i == 0 ? WSP(bf16_t, OFF_PA) : (i == 1 ? WSP(bf16_t, OFF_PD) : WSP(bf16_t, OFF_MC)); const int lda = i == 2 ? 768 : 1536;
                EpiBr E{WSP(bf16_t, OFF_GT), WSP(bf16_t, OFF_MKV), i};
                gemm_phase(ldsg, A, lda, WSP(bf16_t, OFF_WBR) + ((size_t)l * 3 + i) * 1024 * 512, 512, TC, 1024, 512, E);
            }
        } break;
        case 4: case 7: if (PHMASK & 16) {
            const float* lg = ph == 7 ? p.in[14 + zop] + l * 1024 : (l == 0 ? p.in[1 + zop] : p.in[18 + zop] + (l - 1) * 1024); const float* lb = ph == 7 ? p.in[15 + zop] + l * 1024 : (l == 0 ? p.in[2 + zop] : p.in[19 + zop] + (l - 1) * 1024);
            EpiRes E{((ph == 4 && l == 0) ? p.in[0 + zop] : (const float*)p.out) + tok0 * 1024, p.out + tok0 * 1024, WSP(float, OFF_ST) + tok0 * 2, lg, lb};
            const bf16_t* A = ph == 4 ? WSP(bf16_t, OFF_MKV) : WSP(bf16_t, OFF_PA); const int ld = ph == 4 ? 1024 : DFF, ldb_ = ph == 4 ? 3072 : DFF, kk = ph == 4 ? 1024 : DFF;
            const bf16_t* B = ph == 4 ? WSP(bf16_t, OFF_WOUT) + (size_t)l * 1024 * 3072 : WSP(bf16_t, OFF_WF2) + (size_t)l * 1024 * DFF;
            gemm_phase(ldsg, A, ld, B, ldb_, mrows, 1024, kk, E);
        } break;
        case 5: case 8: if (PHMASK & 32) {
            const float* g = ph == 5 ? p.in[14 + zop] : p.in[18 + zop]; const float* bb = ph == 5 ? p.in[15 + zop] : p.in[19 + zop];
            const bool fin = (ph == 8 && l == DEPTH - 1);
            ln_rows(p.out, fin ? p.out : nullptr, fin ? nullptr : WSP(bf16_t, OFF_XB), fin ? nullptr : WSP(float, OFF_ST), g + l * 1024, bb + l * 1024, (int)tok0, mrows);
        } break;
        case 6: if (PHMASK & 64) {
            EpiF1 E{WSP(bf16_t, OFF_PA)};
            gemm_phase(ldsg, WSP(bf16_t, OFF_XB) + tok0 * 1024, 1024, WSP(bf16_t, OFF_WF1) + (size_t)l * 5632 * 1024, 1024, mrows, 5632, 1024, E);
        } break;
        }
      }
      gsync(grid);
    }
}

extern "C" void kernel_launch(void* const* d_in, const int* in_sizes, int n_in, void* d_out, int out_size, void* d_ws, size_t ws_size, hipStream_t stream) {
    static int grid = 0;
    if (grid == 0) {
        if (n_in != 20 || in_sizes[0] != T_ALL * DM || out_size != T_ALL * DM || ws_size < WS_END) {
            fprintf(stderr, "kernel_launch: unexpected shapes / workspace (n_in %d, ws %zu, need %zu)\n", n_in, ws_size, (size_t)WS_END); grid = -1; return; }
        int dev = 0, cus = 0, per_cu = 0;
        hipGetDevice(&dev); hipDeviceGetAttribute(&cus, hipDeviceAttributeMultiprocessorCount, dev);
        if (hipFuncSetAttribute((const void*)fwd_megakernel, hipFuncAttributeMaxDynamicSharedMemorySize, LDS_BYTES) != hipSuccess) { fprintf(stderr, "kernel_launch: hipFuncSetAttribute failed\n"); grid = -1; return; }
        if (hipOccupancyMaxActiveBlocksPerMultiprocessor(&per_cu, (const void*)fwd_megakernel, 512, LDS_BYTES) != hipSuccess || per_cu < 1) { fprintf(stderr, "kernel_launch: occupancy query gave %d\n", per_cu); per_cu = 1; }
        (void)hipGetLastError();
        grid = cus;
    }
    if (grid < 0) return;
    Params p{};
    for (int i = 0; i < 20; ++i) p.in[i] = (const float*)d_in[i];
    p.out = (float*)d_out; p.ws = (unsigned char*)d_ws;
    for (int l = 0; l < 4; ++l) p.lam_init[l] = (float)(0.8 - 0.6 * exp(-0.3 * (double)l));
    void* args[] = {&p};
    hipError_t e = hipLaunchCooperativeKernel((const void*)fwd_megakernel, dim3(grid), dim3(512), args, LDS_BYTES, stream);
    if (e != hipSuccess) fprintf(stderr, "kernel_launch: cooperative launch failed: %s (grid %d)\n", hipGetErrorString(e), grid);
}
```

```cpp
#include <hip/hip_runtime.h>
#include <hip/hip_cooperative_groups.h>
#include <cstdio>
#include <cstdint>
namespace cg = cooperative_groups;

#define LAS __attribute__((address_space(3)))
#define GAS __attribute__((address_space(1)))
typedef unsigned short bf16_t;
typedef short bf16x8 __attribute__((ext_vector_type(8)));
typedef short s16x4 __attribute__((ext_vector_type(4)));
typedef float f32x4 __attribute__((ext_vector_type(4)));
typedef float f32x16 __attribute__((ext_vector_type(16)));
typedef unsigned u32x4 __attribute__((ext_vector_type(4)));
typedef unsigned u32x2 __attribute__((ext_vector_type(2)));

constexpr int T_ALL = 32768, TC = 16384, DM = 1024, SEQ = 4096, NIN = 6912, DFF = 2816, DEPTH = 4, NCHUNK = 2;
constexpr size_t SZ_WIN = (size_t)DEPTH * NIN * 1024 * 2, SZ_WQB = (size_t)DEPTH * 768 * 384 * 2, SZ_WKVB = (size_t)DEPTH * 1024 * 256 * 2,
                 SZ_WBR = (size_t)DEPTH * 3 * 1024 * 512 * 2, SZ_WOUT = (size_t)DEPTH * 1024 * 3072 * 2, SZ_WF1 = (size_t)DEPTH * 5632 * 1024 * 2,
                 SZ_WF2 = (size_t)DEPTH * 1024 * 2816 * 2, SZ_XB = (size_t)T_ALL * 1024 * 2, SZ_PA = (size_t)TC * 1536 * 2, SZ_PD = SZ_PA,
                 SZ_MC = (size_t)TC * 768 * 2, SZ_GT = (size_t)TC * 3072 * 2, SZ_MQ = (size_t)TC * 768 * 2, SZ_MKV = (size_t)TC * 1024 * 2,
                 SZ_SSQ = (size_t)TC * 24 * 4, SZ_TD = (size_t)SEQ * 8 * 4 * 2, SZ_TM = (size_t)SEQ * 16 * 4 * 2;
constexpr size_t OFF_WIN = 0, OFF_WQB = OFF_WIN + SZ_WIN, OFF_WKVB = OFF_WQB + SZ_WQB, OFF_WBR = OFF_WKVB + SZ_WKVB, OFF_WOUT = OFF_WBR + SZ_WBR,
                 OFF_WF1 = OFF_WOUT + SZ_WOUT, OFF_WF2 = OFF_WF1 + SZ_WF1, OFF_XB = OFF_WF2 + SZ_WF2, OFF_PA = OFF_XB + SZ_XB, OFF_PD = OFF_PA + SZ_PA,
                 OFF_MC = OFF_PD + SZ_PD, OFF_GT = OFF_MC + SZ_MC, OFF_MQ = OFF_GT + SZ_GT, OFF_MKV = OFF_MQ + SZ_MQ, OFF_SSQ = OFF_MKV + SZ_MKV,
                 OFF_TD = OFF_SSQ + SZ_SSQ, OFF_TM = OFF_TD + SZ_TD, OFF_ST = OFF_TM + SZ_TM, WS_END = OFF_ST + (size_t)T_ALL * 2 * 4;
constexpr int LDS_BYTES = 132 * 1024;
static_assert((size_t)T_ALL * DFF * 2 <= SZ_PA + SZ_PD + SZ_MC + SZ_GT, "SwiGLU hidden of all tokens aliases projA|projD|mla_c|gates");
constexpr float DN_ALPHA = 1.681792830507429f;

struct Params { const float* in[20]; float* out; unsigned char* ws; float lam_init[4]; };

typedef __bf16 bf2_t __attribute__((ext_vector_type(2)));
typedef float f32x2 __attribute__((ext_vector_type(2)));
__device__ __forceinline__ unsigned cvtpk(float lo, float hi) { f32x2 v = {lo, hi}; bf2_t b = __builtin_convertvector(v, bf2_t); return __builtin_bit_cast(unsigned, b); }
__device__ __forceinline__ int otid() { int t = threadIdx.x; asm volatile("" : "+v"(t)); return t; }
__device__ __forceinline__ float bf2f(unsigned short b) { return __uint_as_float(((unsigned)b) << 16); }
__device__ __forceinline__ void st_bf4(bf16_t* p, f32x4 v) { u32x2 w; w.x = cvtpk(v[0], v[1]); w.y = cvtpk(v[2], v[3]); *(GAS u32x2*)p = w; }

constexpr int BM = 256, BK = 64, HALF = 128, HTB = HALF * BK * 2, NXCD = 8, WGM = 8;
__device__ __forceinline__ int lds_byte(int r, int c) { const int st = (r >> 4) * 2 + (c >> 5), rr = r & 15, cc = c & 31, ob = rr * 64 + cc * 2; return st * 1024 + (ob ^ (((ob >> 9) & 1) << 5)); }
__device__ __forceinline__ void stage_rc(int b, int& R, int& C) { const int st = b / 1024, sb = b % 1024, swz = sb ^ (((sb >> 9) & 1) << 5); R = (st >> 1) * 16 + swz / 64; C = (st & 1) * 32 + (swz % 64) / 2; }
struct Unit { int pm, pn; };
struct StaticOrder {
    int nM, nN, nwg, G, c;
    __device__ void init(int M, int N, int G_, int c_) { nM = M / BM; nN = N / BM; nwg = nM * nN; G = G_; c = c_; }
    __device__ bool next(int i, Unit& u) const {
        const long L = (long)i * G + c; if (L >= nwg) return false;
        int wgid = (int)L; { const int q = nwg / NXCD, r = nwg % NXCD, xcd = wgid % NXCD, off = wgid / NXCD; wgid = (xcd < r ? xcd * (q + 1) : r * (q + 1) + (xcd - r) * q) + off; }
        const int nig = WGM * nN, gid = wgid / nig, fm = gid * WGM, gsz = (nM - fm) < WGM ? (nM - fm) : WGM;
        u.pm = __builtin_amdgcn_readfirstlane(fm + ((wgid % nig) % gsz)); u.pn = __builtin_amdgcn_readfirstlane((wgid % nig) / gsz); return true;
    }
};

template <class Epi>
__device__ __forceinline__ void gemm_phase(LAS unsigned char* lds, const bf16_t* A, int lda, const bf16_t* Bt, int ldb, int M, int N, int K, const Epi& E) {
    const int tid = otid(), wid = __builtin_amdgcn_readfirstlane(tid >> 6), lane = tid & 63, wr = wid >> 2, wc = wid & 3, fr = lane & 15, fq = lane >> 4;
    int ntv_ = K / BK; asm volatile("" : "+v"(ntv_)); const int nt = __builtin_amdgcn_readfirstlane(ntv_);
    StaticOrder S; S.init(M, N, (int)gridDim.x, (int)blockIdx.x);
    unsigned voffA[2], voffB[2];
#pragma unroll
    for (int i = 0; i < 2; ++i) { int R, C; stage_rc(tid * 16 + i * 8192, R, C); voffA[i] = (unsigned)(R * lda + C) * 2u; voffB[i] = (unsigned)(R * ldb + C) * 2u; }
    const size_t kstep = (size_t)(BK * 2);
    const size_t hstepA = (size_t)HALF * lda * 2, tstepA = 2 * hstepA, hstepB = (size_t)HALF * ldb * 2, tstepB = 2 * hstepB;
    const unsigned ldsw = (unsigned)wid * 1024u;
    const int aoff = lds_byte(wr * 64 + fr, fq * 8), boff = lds_byte(wc * 32 + fr, fq * 8);
#define PG8_SA(b, h) (((b) * 2 + (h)) * HTB)
#define PG8_SB(b, h) ((4 + (b) * 2 + (h)) * HTB)
#define PG8_STAGE(bufoff, gbase, voff) do { _Pragma("unroll") for (int _i = 0; _i < 2; ++_i) \
        __builtin_amdgcn_global_load_lds((const unsigned*)((const char*)(gbase) + (voff)[_i]), (LAS unsigned*)(lds + (bufoff) + ldsw + _i * 8192), 16, 0, 0); } while (0)
#define PG8_LDA(dst, b, h) do { _Pragma("unroll") for (int m = 0; m < 4; ++m) _Pragma("unroll") for (int k = 0; k < 2; ++k) dst[m][k] = *(const LAS bf16x8*)(lds + PG8_SA(b, h) + aoff + m * 2048 + k * 1024); } while (0)
#define PG8_LDB(dst, b, h) do { _Pragma("unroll") for (int n = 0; n < 2; ++n) _Pragma("unroll") for (int k = 0; k < 2; ++k) dst[n][k] = *(const LAS bf16x8*)(lds + PG8_SB(b, h) + boff + n * 2048 + k * 1024); } while (0)
#define PG8_MMA(ai, bj, At, Bt_) do { __builtin_amdgcn_s_setprio(1); _Pragma("unroll") for (int m = 0; m < 4; ++m) _Pragma("unroll") for (int n = 0; n < 2; ++n) _Pragma("unroll") for (int k = 0; k < 2; ++k) \
        acc[ai][bj][m][n] = __builtin_amdgcn_mfma_f32_16x16x32_bf16(Bt_[n][k], At[m][k], acc[ai][bj][m][n], 0, 0, 0); __builtin_amdgcn_s_setprio(0); } while (0)
#define PG8_WAIT_V(n) asm volatile("s_waitcnt vmcnt(" #n ")" ::: "memory")
#define PG8_WAIT_L(n) asm volatile("s_waitcnt lgkmcnt(" #n ")" ::: "memory")
#define PG8_BAR __builtin_amdgcn_s_barrier()
#define PG8_SCHED __builtin_amdgcn_sched_barrier(0)
    Unit cur, nxt; int ui = 0;
    if (!S.next(0, cur)) return;
    f32x4 acc[2][2][4][2];
#pragma unroll
    for (int a = 0; a < 2; ++a)
#pragma unroll
        for (int b = 0; b < 2; ++b)
#pragma unroll
            for (int m = 0; m < 4; ++m)
#pragma unroll
                for (int n = 0; n < 2; ++n) acc[a][b][m][n] = (f32x4){0.f, 0.f, 0.f, 0.f};
    bf16x8 At[4][2], B0[2][2], B1[2][2];
    const char* cA = (const char*)A + (size_t)cur.pm * tstepA; const char* cB = (const char*)Bt + (size_t)cur.pn * tstepB;
    PG8_STAGE(PG8_SB(0, 0), cB, voffB); PG8_STAGE(PG8_SA(0, 0), cA, voffA); PG8_STAGE(PG8_SB(0, 1), cB + hstepB, voffB); PG8_STAGE(PG8_SA(0, 1), cA + hstepA, voffA);
    if (wr == 1) PG8_BAR;
    PG8_WAIT_V(4); PG8_BAR;
    PG8_STAGE(PG8_SB(1, 0), cB + kstep, voffB); PG8_STAGE(PG8_SA(1, 0), cA + kstep, voffA); PG8_STAGE(PG8_SB(1, 1), cB + hstepB + kstep, voffB);
    PG8_WAIT_V(6); PG8_BAR;
    for (;;) {
        const bool has_next = S.next(ui + 1, nxt);
        const char* nA = has_next ? (const char*)A + (size_t)nxt.pm * tstepA : cA; const char* nB = has_next ? (const char*)Bt + (size_t)nxt.pn * tstepB : cB;
#pragma unroll 1
        for (int t = 0; t < nt; t += 2) {
            const bool last = (t == nt - 2);
            const char* a1 = cA + (size_t)(t + 1) * kstep;
            const char* a2 = last ? nA : cA + (size_t)(t + 2) * kstep; const char* b2 = last ? nB : cB + (size_t)(t + 2) * kstep;
            const char* a3 = a2 + kstep; const char* b3 = b2 + kstep;
            PG8_LDB(B0, 0, 0); PG8_SCHED; PG8_LDA(At, 0, 0); PG8_STAGE(PG8_SA(1, 1), a1 + hstepA, voffA);
            PG8_WAIT_L(8); PG8_BAR; PG8_WAIT_L(0); PG8_MMA(0, 0, At, B0); PG8_BAR; PG8_SCHED;
            PG8_LDB(B1, 0, 1); PG8_STAGE(PG8_SB(0, 0), b2, voffB);
            PG8_BAR; PG8_WAIT_L(0); PG8_MMA(0, 1, At, B1); PG8_BAR;
            PG8_LDA(At, 0, 1); PG8_STAGE(PG8_SA(0, 0), a2, voffA);
            PG8_BAR; PG8_WAIT_L(0); PG8_MMA(1, 0, At, B0); PG8_BAR; PG8_SCHED;
            PG8_STAGE(PG8_SB(0, 1), b2 + hstepB, voffB);
            PG8_WAIT_V(6); PG8_BAR; PG8_MMA(1, 1, At, B1); PG8_BAR;
            PG8_LDB(B0, 1, 0); PG8_SCHED; PG8_LDA(At, 1, 0); PG8_STAGE(PG8_SA(0, 1), a2 + hstepA, voffA);
            PG8_WAIT_L(8); PG8_BAR; PG8_WAIT_L(0); PG8_MMA(0, 0, At, B0); PG8_BAR; PG8_SCHED;
            PG8_LDB(B1, 1, 1); PG8_STAGE(PG8_SB(1, 0), b3, voffB);
            PG8_BAR; PG8_WAIT_L(0); PG8_MMA(0, 1, At, B1); PG8_BAR;
            PG8_LDA(At, 1, 1); PG8_STAGE(PG8_SA(1, 0), a3, voffA);
            PG8_BAR; PG8_WAIT_L(0); PG8_MMA(1, 0, At, B0); PG8_BAR; PG8_SCHED;
            PG8_STAGE(PG8_SB(1, 1), b3 + hstepB, voffB);
            PG8_WAIT_V(6); PG8_BAR; PG8_MMA(1, 1, At, B1); PG8_BAR;
        }
        E(acc, cur, wr, wc, fr, fq);
        if (!has_next) break;
#pragma unroll
        for (int a = 0; a < 2; ++a)
#pragma unroll
            for (int b = 0; b < 2; ++b)
#pragma unroll
                for (int m = 0; m < 4; ++m)
#pragma unroll
                    for (int n = 0; n < 2; ++n) acc[a][b][m][n] = (f32x4){0.f, 0.f, 0.f, 0.f};
        cur = nxt; cA = nA; cB = nB; ++ui;
    }
    PG8_WAIT_V(0);
    if (wr == 0) PG8_BAR;
    PG8_BAR;
#undef PG8_SA
#undef PG8_SB
#undef PG8_STAGE
#undef PG8_LDA
#undef PG8_LDB
#undef PG8_MMA
#undef PG8_WAIT_V
#undef PG8_WAIT_L
#undef PG8_BAR
#undef PG8_SCHED
}

struct EpiIn {
    bf16_t *pa, *pd, *mc, *gt; float* ssq; const float* bg; const float *cd, *sd, *cm, *sm;
    __device__ __forceinline__ void operator()(const f32x4 (&acc)[2][2][4][2], const Unit& u, int wr, int wc, int fr, int fq) const {
        int row0 = u.pm * BM + wr * 64 + fr; asm volatile("" : "+v"(row0) :: "memory"); const int pn = u.pn, cw = wc * 32 + 4 * fq;
        if (pn < 6) {
#pragma unroll
            for (int ai = 0; ai < 2; ++ai)
#pragma unroll
                for (int m = 0; m < 4; ++m) { __builtin_amdgcn_sched_barrier(0); bf16_t* rp = pa + (size_t)(row0 + ai * HALF + m * 16) * 1536 + pn * 256 + cw;
#pragma unroll
                    for (int bj = 0; bj < 2; ++bj)
#pragma unroll
                        for (int n = 0; n < 2; ++n) st_bf4(rp + bj * HALF + n * 16, acc[ai][bj][m][n]); }
        } else if (pn < 12) {
            const bool rope = (pn < 10) && !(wc & 1);
#pragma unroll
            for (int ai = 0; ai < 2; ++ai)
#pragma unroll
                for (int m = 0; m < 4; ++m) { __builtin_amdgcn_sched_barrier(0); const int row = row0 + ai * HALF + m * 16; bf16_t* rp = pd + (size_t)row * 1536 + (pn - 6) * 256 + cw;
                    f32x4 c4 = {1.f, 1.f, 1.f, 1.f}, s4 = {0.f, 0.f, 0.f, 0.f};
                    if (rope) { const int pos = row & (SEQ - 1); c4 = *(const GAS f32x4*)(cd + pos * 8 + (fq & 1) * 4); s4 = *(const GAS f32x4*)(sd + pos * 8 + (fq & 1) * 4); }
#pragma unroll
                    for (int bj = 0; bj < 2; ++bj) { f32x4 v0 = acc[ai][bj][m][0];
                        if (rope) { f32x4 pr;
#pragma unroll
                            for (int j = 0; j < 4; ++j) pr[j] = __shfl_xor(v0[j], 32);
                            v0 = (fq < 2) ? (v0 * c4 - pr * s4) : (v0 * c4 + pr * s4); }
                        st_bf4(rp + bj * HALF, v0); st_bf4(rp + bj * HALF + 16, acc[ai][bj][m][1]); } }
        } else if (pn < 15) {
            const int t = pn - 12;
#pragma unroll
            for (int ai = 0; ai < 2; ++ai)
#pragma unroll
                for (int m = 0; m < 4; ++m) { __builtin_amdgcn_sched_barrier(0); const int row = row0 + ai * HALF + m * 16; bf16_t* rp = mc + (size_t)row * 768 + t * 256 + cw;
#pragma unroll
                    for (int bj = 0; bj < 2; ++bj) { f32x4 v0 = acc[ai][bj][m][0], v1 = acc[ai][bj][m][1];
                        float s = (v0[0] * v0[0] + v0[1] * v0[1]) + (v0[2] * v0[2] + v0[3] * v0[3]) + (v1[0] * v1[0] + v1[1] * v1[1]) + (v1[2] * v1[2] + v1[3] * v1[3]);
                        s += __shfl_xor(s, 16); s += __shfl_xor(s, 32);
                        if (fq == 0) *(GAS float*)(ssq + (size_t)row * 24 + t * 8 + bj * 4 + wc) = s;
                        if (t == 2 && bj == 1 && wc == 0) { const int pos = row & (SEQ - 1); const f32x4 c4 = *(const GAS f32x4*)(cm + pos * 16 + fq * 4), s4 = *(const GAS f32x4*)(sm + pos * 16 + fq * 4);
                            const f32x4 n0 = v0 * c4 - v1 * s4, n1 = v1 * c4 + v0 * s4; v0 = n0; v1 = n1; }
                        st_bf4(rp + bj * HALF, v0); st_bf4(rp + bj * HALF + 16, v1); } }
        } else {
            const int t = pn - 15;
            f32x4 bv[2][2];
#pragma unroll
            for (int bj = 0; bj < 2; ++bj)
#pragma unroll
                for (int n = 0; n < 2; ++n) bv[bj][n] = *(const GAS f32x4*)(bg + t * 256 + bj * HALF + n * 16 + cw);
#pragma unroll
            for (int ai = 0; ai < 2; ++ai)
#pragma unroll
                for (int m = 0; m < 4; ++m) { __builtin_amdgcn_sched_barrier(0); bf16_t* rp = gt + (size_t)(row0 + ai * HALF + m * 16) * 3072 + t * 256 + cw;
#pragma unroll
                    for (int bj = 0; bj < 2; ++bj)
#pragma unroll
                        for (int n = 0; n < 2; ++n) { f32x4 v = acc[ai][bj][m][n] + bv[bj][n];
#pragma unroll
                            for (int j = 0; j < 4; ++j) v[j] = __builtin_amdgcn_rcpf(1.0f + __expf(-v[j]));
                            st_bf4(rp + bj * HALF + n * 16, v); } }
        }
    }
};
struct EpiQ {
    bf16_t* mq; const float* ssq; const float *cm, *sm;
    __device__ __forceinline__ void operator()(const f32x4 (&acc)[2][2][4][2], const Unit& u, int wr, int wc, int fr, int fq) const {
        int row0 = u.pm * BM + wr * 64 + fr; asm volatile("" : "+v"(row0) :: "memory"); const int cw = wc * 32 + 4 * fq;
        float rr8[8];
#pragma unroll
        for (int i = 0; i < 8; ++i) { const float* sp = ssq + (size_t)(row0 + (i >> 2) * HALF + (i & 3) * 16) * 24 + fq * 4;
            const f32x4 a = *(const GAS f32x4*)sp;
            float ss = fq < 3 ? ((a[0] + a[1]) + (a[2] + a[3])) : 0.f;
            ss += __shfl_xor(ss, 16); ss += __shfl_xor(ss, 32);
            rr8[i] = rsqrtf(ss * (1.0f / 384.0f) + 1e-6f); }
#pragma unroll
        for (int ai = 0; ai < 2; ++ai)
#pragma unroll
            for (int m = 0; m < 4; ++m) { __builtin_amdgcn_sched_barrier(0); const int row = row0 + ai * HALF + m * 16; const float r = rr8[ai * 4 + m];
                bf16_t* rp = mq + (size_t)row * 768 + u.pn * 256 + cw;
#pragma unroll
                for (int bj = 0; bj < 2; ++bj) { const int G = u.pn * 8 + bj * 4 + wc; f32x4 v0 = acc[ai][bj][m][0] * r, v1 = acc[ai][bj][m][1] * r;
                    if (G % 3 == 2) { const int pos = row & (SEQ - 1); const f32x4 c4 = *(const GAS f32x4*)(cm + pos * 16 + fq * 4), s4 = *(const GAS f32x4*)(sm + pos * 16 + fq * 4);
                        const f32x4 n0 = v0 * c4 - v1 * s4, n1 = v1 * c4 + v0 * s4; v0 = n0; v1 = n1; }
                    st_bf4(rp + bj * HALF, v0); st_bf4(rp + bj * HALF + 16, v1); } }
    }
};
struct EpiKV {
    bf16_t* mkv; const float* ssq;
    __device__ __forceinline__ void operator()(const f32x4 (&acc)[2][2][4][2], const Unit& u, int wr, int wc, int fr, int fq) const {
        int row0 = u.pm * BM + wr * 64 + fr; asm volatile("" : "+v"(row0) :: "memory"); const int cw = wc * 32 + 4 * fq;
        float rr8[8];
#pragma unroll
        for (int i = 0; i < 8; ++i) { const float* sp = ssq + (size_t)(row0 + (i >> 2) * HALF + (i & 3) * 16) * 24 + 12 + (fq & 1) * 4;
            const f32x4 a = *(const GAS f32x4*)sp;
            float ss = fq < 2 ? ((a[0] + a[1]) + (a[2] + a[3])) : 0.f;
            ss += __shfl_xor(ss, 16); ss += __shfl_xor(ss, 32);
            rr8[i] = rsqrtf(ss * (1.0f / 256.0f) + 1e-6f); }
#pragma unroll
        for (int ai = 0; ai < 2; ++ai)
#pragma unroll
            for (int m = 0; m < 4; ++m) { __builtin_amdgcn_sched_barrier(0); const int row = row0 + ai * HALF + m * 16; const float r = rr8[ai * 4 + m];
                bf16_t* rp = mkv + (size_t)row * 1024 + u.pn * 256 + cw;
#pragma unroll
                for (int bj = 0; bj < 2; ++bj)
#pragma unroll
                    for (int n = 0; n < 2; ++n) st_bf4(rp + bj * HALF + n * 16, acc[ai][bj][m][n] * r); }
    }
};
struct EpiBr {
    const bf16_t* gt; bf16_t* mg;
    int br;
    __device__ __forceinline__ void operator()(const f32x4 (&acc)[2][2][4][2], const Unit& u, int wr, int wc, int fr, int fq) const {
        int row0 = u.pm * BM + wr * 64 + fr; asm volatile("" : "+v"(row0) :: "memory"); const int cw = wc * 32 + 4 * fq;
#pragma unroll
        for (int ai = 0; ai < 2; ++ai)
#pragma unroll
            for (int m = 0; m < 4; ++m) { __builtin_amdgcn_sched_barrier(0); const size_t rr_ = (size_t)(row0 + ai * HALF + m * 16); const bf16_t* gp = gt + rr_ * 3072 + br * 1024 + u.pn * 256 + cw; bf16_t* rp = mg + rr_ * 1024 + u.pn * 256 + cw;
#pragma unroll
                for (int bj = 0; bj < 2; ++bj)
#pragma unroll
                    for (int n = 0; n < 2; ++n) { bf16_t* p = rp + bj * HALF + n * 16; const u32x2 g = *(const GAS u32x2*)(gp + bj * HALF + n * 16); const f32x4 a = acc[ai][bj][m][n];
                        f32x4 v; v[0] = a[0] * __uint_as_float(g.x << 16); v[1] = a[1] * __uint_as_float(g.x & 0xffff0000u); v[2] = a[2] * __uint_as_float(g.y << 16); v[3] = a[3] * __uint_as_float(g.y & 0xffff0000u);
                        if (br > 0) { const unsigned long long pv = __hip_atomic_load((const GAS unsigned long long*)p, __ATOMIC_RELAXED, __HIP_MEMORY_SCOPE_AGENT); const unsigned lo = (unsigned)pv, hi = (unsigned)(pv >> 32);
                            v[0] += __uint_as_float(lo << 16); v[1] += __uint_as_float(lo & 0xffff0000u); v[2] += __uint_as_float(hi << 16); v[3] += __uint_as_float(hi & 0xffff0000u); }
                        st_bf4(p, v); } }
    }
};
struct EpiRes {
    const float* xs; float* xd; const float* st; const float* g; const float* b;
    __device__ __forceinline__ void operator()(const f32x4 (&acc)[2][2][4][2], const Unit& u, int wr, int wc, int fr, int fq) const {
        int row0 = u.pm * BM + wr * 64 + fr; asm volatile("" : "+v"(row0) :: "memory"); const int cw = wc * 32 + 4 * fq;
#pragma unroll
        for (int bj = 0; bj < 2; ++bj) {
            f32x4 gv[2], bv[2];
#pragma unroll
            for (int n = 0; n < 2; ++n) { gv[n] = *(const GAS f32x4*)(g + u.pn * 256 + cw + bj * HALF + n * 16); bv[n] = *(const GAS f32x4*)(b + u.pn * 256 + cw + bj * HALF + n * 16); }
#pragma unroll
            for (int ai = 0; ai < 2; ++ai)
#pragma unroll
                for (int m = 0; m < 4; ++m) { __builtin_amdgcn_sched_barrier(0); const size_t row = (size_t)(row0 + ai * HALF + m * 16); const size_t ro = row * 1024 + u.pn * 256 + cw + bj * HALF;
                    const f32x2 ms = *(const GAS f32x2*)(st + row * 2);
#pragma unroll
                    for (int n = 0; n < 2; ++n) { const size_t o = ro + n * 16; const f32x4 xv = *(const GAS f32x4*)(xs + o);
                        const f32x4 xn = (xv - ms[0]) * ms[1] * gv[n] + bv[n]; *(GAS f32x4*)(xd + o) = xn * DN_ALPHA + acc[ai][bj][m][n]; } }
        }
    }
};
struct EpiF1 {
    bf16_t* hd;
    __device__ __forceinline__ void operator()(const f32x4 (&acc)[2][2][4][2], const Unit& u, int wr, int wc, int fr, int fq) const {
        int row0 = u.pm * BM + wr * 64 + fr; asm volatile("" : "+v"(row0) :: "memory"); const int cw = wc * 32 + 4 * fq;
#pragma unroll
        for (int ai = 0; ai < 2; ++ai)
#pragma unroll
            for (int m = 0; m < 4; ++m) { __builtin_amdgcn_sched_barrier(0); bf16_t* rp = hd + (size_t)(row0 + ai * HALF + m * 16) * DFF + u.pn * 128 + cw;
#pragma unroll
                for (int n = 0; n < 2; ++n) { const f32x4 g = acc[ai][0][m][n], uu = acc[ai][1][m][n]; f32x4 v;
#pragma unroll
                    for (int j = 0; j < 4; ++j) v[j] = g[j] * __builtin_amdgcn_rcpf(1.0f + __expf(-g[j])) * uu[j];
                    st_bf4(rp + n * 16, v); } }
    }
};

constexpr int SHM_V = 64 * 128 * 2, SHM_K = 64 * 128 * 2;
#define KSWZ(row, colB) ((row) * 256 + ((colB) ^ (((row) & 7) << 4)))
#define SBAR() __builtin_amdgcn_sched_barrier(0)
__device__ __forceinline__ int crow(int r, int hi) { return (r & 3) + 8 * (r >> 2) + 4 * hi; }
struct NaCtx { int vlo, vhi, wstart, qc, drow0; const LAS float* tab; };

template <int MODE>
__device__ __forceinline__ void partialSM(f32x16& p0, f32x16& p1, float& m_reg, float& mn, float& alpha, const NaCtx& na, int t, int hi) {
    constexpr float SCALE = MODE == 2 ? 0.10206207261596575f : 0.125f;
    constexpr float C = SCALE * 1.4426950408889634f;
    constexpr float THRS = 8.f / SCALE;
    if (MODE == 0) {
        const float NINF = -__builtin_inff();
        if (t < na.vlo || t >= na.vhi) {
#pragma unroll
            for (int r = 0; r < 16; ++r) { p0[r] = 0.f; p1[r] = NINF; }
            mn = m_reg; alpha = 1.f; return;
        } else {
            const LAS float* trow = na.tab + (na.drow0 + t) * 31 + (15 - na.qc);
#pragma unroll
            for (int q4 = 0; q4 < 4; ++q4) {
#pragma unroll
                for (int r = q4 * 4; r < q4 * 4 + 4; ++r) { const int kc = crow(r, hi); const bool ok0 = (unsigned)(kc - na.wstart) < 16u, ok1 = (unsigned)(kc + 32 - na.wstart) < 16u;
                    const float b0 = trow[ok0 ? kc : na.wstart], b1 = trow[ok1 ? kc + 32 : na.wstart];
                    p0[r] = ok0 ? p0[r] + b0 : NINF; p1[r] = ok1 ? p1[r] + b1 : NINF; }
                __builtin_amdgcn_sched_barrier(0); }
        }
    }
    float pmax = p0[0];
#pragma unroll
    for (int r = 1; r < 16; ++r) pmax = fmaxf(pmax, p0[r]);
#pragma unroll
    for (int r = 0; r < 16; ++r) pmax = fmaxf(pmax, p1[r]);
    { auto rr = __builtin_amdgcn_permlane32_swap(__float_as_uint(pmax), __float_as_uint(pmax), false, false);
      pmax = fmaxf(__uint_as_float(rr[0]), __uint_as_float(rr[1])); }
    if (__builtin_expect(__all(pmax - m_reg <= THRS), 1)) { mn = m_reg; alpha = 1.f; }
    else { mn = fmaxf(m_reg, pmax); alpha = __builtin_amdgcn_exp2f((m_reg - mn) * C); m_reg = mn; }
    const float mnC = -mn * C;
#pragma unroll
    for (int r = 0; r < 16; ++r) p0[r] = fmaf(p0[r], C, mnC);
#pragma unroll
    for (int r = 0; r < 16; ++r) p1[r] = fmaf(p1[r], C, mnC);
#pragma unroll
    for (int r = 0; r < 16; ++r) p0[r] = __builtin_amdgcn_exp2f(p0[r]);
}
__device__ __forceinline__ void finishSM(f32x16& p0, f32x16& p1, float alpha, float& l_reg, bf16x8& pa0, bf16x8& pa1, bf16x8& pa2, bf16x8& pa3) {
#pragma unroll
    for (int r = 0; r < 16; ++r) p1[r] = __builtin_amdgcn_exp2f(p1[r]);
    float ps = 0;
#pragma unroll
    for (int r = 0; r < 16; ++r) ps += p0[r];
#pragma unroll
    for (int r = 0; r < 16; ++r) ps += p1[r];
    { auto rr = __builtin_amdgcn_permlane32_swap(__float_as_uint(ps), __float_as_uint(ps), false, false);
      ps = __uint_as_float(rr[0]) + __uint_as_float(rr[1]); }
    l_reg = l_reg * alpha + ps;
#define PK4(P, BASE, OUT) do { unsigned a0 = cvtpk(P[BASE + 0], P[BASE + 1]), a1 = cvtpk(P[BASE + 2], P[BASE + 3]);   \
    unsigned b0 = cvtpk(P[BASE + 4], P[BASE + 5]), b1 = cvtpk(P[BASE + 6], P[BASE + 7]);                              \
    auto r0 = __builtin_amdgcn_permlane32_swap(a0, b0, false, false); auto r1 = __builtin_amdgcn_permlane32_swap(a1, b1, false, false); \
    u32x4 w = {r0[0], r1[0], r0[1], r1[1]}; OUT = *reinterpret_cast<bf16x8*>(&w); } while (0)
    PK4(p0, 0, pa0); PK4(p0, 8, pa1); PK4(p1, 0, pa2); PK4(p1, 8, pa3);
#undef PK4
}
template <int ND>
__device__ __forceinline__ void qkt(f32x16& p0, f32x16& p1, const char* Ks, const bf16x8* qr, int r32, int hi) {
    p0 = f32x16{}; p1 = f32x16{};
#pragma unroll
    for (int d0 = 0; d0 < ND; ++d0) { const int cb = (d0 * 16 + hi * 8) * 2;
        const bf16x8 b0 = *reinterpret_cast<const bf16x8*>(Ks + KSWZ(r32, cb));
        const bf16x8 b1 = *reinterpret_cast<const bf16x8*>(Ks + KSWZ(32 + r32, cb));
        p0 = __builtin_amdgcn_mfma_f32_32x32x16_bf16(b0, qr[d0], p0, 0, 0, 0);
        p1 = __builtin_amdgcn_mfma_f32_32x32x16_bf16(b1, qr[d0], p1, 0, 0, 0); }
}
__device__ __forceinline__ int v_st(int k, int c) { const int kk = (k & ~0xC) | ((k & 4) << 1) | ((k & 8) >> 1); return ((kk >> 3) * 4 + (c >> 5)) * 512 + ((kk & 7) * 32 + (c & 31)) * 2; }
__device__ __forceinline__ int v_rd_base(int lane) { return ((lane & 3) << 3) | (((lane >> 2) & 3) << 6) | (((lane >> 4) & 1) << 5) | (((lane >> 5) & 1) << 8); }
constexpr int v_rd_off(int d0, int ks, int half) { return d0 * 512 + ks * 4096 + half * 2048; }
template <int OFF> __device__ __forceinline__ s16x4 tr_read(int vb) {
    s16x4 r; asm volatile("ds_read_b64_tr_b16 %0, %1 offset:%2" : "=&v"(r) : "v"(vb), "i"(OFF) : "memory"); return r;
}
template <int D0> __device__ __forceinline__ void pv_one(f32x16& od, int vb, bf16x8 pa0, bf16x8 pa1, bf16x8 pa2, bf16x8 pa3) {
    const s16x4 l0 = tr_read<v_rd_off(D0, 0, 0)>(vb), h0 = tr_read<v_rd_off(D0, 0, 1)>(vb), l1 = tr_read<v_rd_off(D0, 1, 0)>(vb), h1 = tr_read<v_rd_off(D0, 1, 1)>(vb);
    const s16x4 l2 = tr_read<v_rd_off(D0, 2, 0)>(vb), h2 = tr_read<v_rd_off(D0, 2, 1)>(vb), l3 = tr_read<v_rd_off(D0, 3, 0)>(vb), h3 = tr_read<v_rd_off(D0, 3, 1)>(vb);
    asm volatile("s_waitcnt lgkmcnt(0)" ::: "memory"); SBAR();
#define PKV(L, H) (bf16x8){L[0], L[1], L[2], L[3], H[0], H[1], H[2], H[3]}
    od = __builtin_amdgcn_mfma_f32_32x32x16_bf16(pa0, PKV(l0, h0), od, 0, 0, 0);
    od = __builtin_amdgcn_mfma_f32_32x32x16_bf16(pa1, PKV(l1, h1), od, 0, 0, 0);
    od = __builtin_amdgcn_mfma_f32_32x32x16_bf16(pa2, PKV(l2, h2), od, 0, 0, 0);
    od = __builtin_amdgcn_mfma_f32_32x32x16_bf16(pa3, PKV(l3, h3), od, 0, 0, 0);
#undef PKV
}
template <int NO> __device__ __forceinline__ void pv_d0(f32x16* o, int vb, bf16x8 pa0, bf16x8 pa1, bf16x8 pa2, bf16x8 pa3) {
    pv_one<0>(o[0], vb, pa0, pa1, pa2, pa3); pv_one<1>(o[1], vb, pa0, pa1, pa2, pa3);
    if constexpr (NO == 4) { pv_one<2>(o[2], vb, pa0, pa1, pa2, pa3); pv_one<3>(o[3], vb, pa0, pa1, pa2, pa3); }
}

template <int DQ, int DV, int MODE, int ldq, int ldk, int ldk2, int ldv, int SD>
__device__ __forceinline__ void attn_core(const bf16_t* __restrict__ Qb, const bf16_t* __restrict__ K1, const bf16_t* __restrict__ K2,
                                          const bf16_t* __restrict__ Vh, int NT, char* lds, f32x16 (&o)[DV / 32], float (&rli)[16], const NaCtx& na) {
    constexpr int ND = DQ / 16, NO = DV / 32;
    const int tid = otid(), wid = tid >> 6, lane = tid & 63, r32 = lane & 31, hi = lane >> 5;
    char* V_lds = lds; char* K_lds = lds + 2 * SHM_V;
    float* ws = (float*)(lds + 2 * SHM_V + 2 * SHM_K) + wid * 64; float* li_l = ws; float* al_l = ws + 32;
    float m_reg = -1e30f, l_reg = 0;
#pragma unroll
    for (int d = 0; d < NO; ++d) o[d] = f32x16{};
    bf16x8 qr[ND];
    const bf16_t* Qw = Qb + (long)(wid * 32 + r32) * ldq + hi * 8;
#pragma unroll
    for (int d0 = 0; d0 < ND; ++d0) qr[d0] = *(const GAS bf16x8*)(Qw + d0 * 16);
    const int sr = tid >> 4, sc = (tid & 15) * 8, vst0 = v_st(sr, sc), vst1 = v_st(32 + sr, sc);
    const int vb0 = (int)(uintptr_t)V_lds + v_rd_base(lane);
    const bool ldV = sc < DV, ldK = sc < DQ;
    const bf16_t* kp; long kld;
    if (DQ > 64 && sc >= 64) { kp = K2 + (sc - 64); kld = ldk2; } else { kp = K1 + sc; kld = ldk; }
    const bf16_t* vp = Vh + sc;
    struct Slot { bf16x8 vs0, vs1, ks0, ks1; };
    Slot sA, sB; sA.vs0 = sA.vs1 = sA.ks0 = sA.ks1 = bf16x8{}; sB = sA;
    Slot& sO = (SD == 2) ? sB : sA;
#define SLOAD(S_, k0) do { if (ldV) { S_.vs0 = *(const GAS bf16x8*)(vp + (long)((k0) + sr) * ldv); S_.vs1 = *(const GAS bf16x8*)(vp + (long)((k0) + 32 + sr) * ldv); } \
    if (ldK) { S_.ks0 = *(const GAS bf16x8*)(kp + (long)((k0) + sr) * kld); S_.ks1 = *(const GAS bf16x8*)(kp + (long)((k0) + 32 + sr) * kld); } } while (0)
#define SWRITE(b, S_) do { if (ldV) { *(bf16x8*)(V_lds + (b) * SHM_V + vst0) = S_.vs0; *(bf16x8*)(V_lds + (b) * SHM_V + vst1) = S_.vs1; } \
    if (ldK) { const int kc = sc * 2; *(bf16x8*)(K_lds + (b) * SHM_K + KSWZ(sr, kc)) = S_.ks0; *(bf16x8*)(K_lds + (b) * SHM_K + KSWZ(32 + sr, kc)) = S_.ks1; } } while (0)
#define SWAIT() do { if (SD == 2) asm volatile("s_waitcnt vmcnt(4)" ::: "memory"); else asm volatile("s_waitcnt vmcnt(0)" ::: "memory"); } while (0)
#define RESC(a) do { if (__any((a) < 1.f)) { if (hi == 0) al_l[r32] = (a); asm volatile("s_waitcnt lgkmcnt(0)" ::: "memory"); \
    _Pragma("unroll") for (int d = 0; d < NO; ++d) _Pragma("unroll") for (int r = 0; r < 16; ++r) o[d][r] *= al_l[crow(r, hi)]; } } while (0)
    f32x16 pA0, pA1, pB0, pB1; float mnA, mnB, alA, alB; bf16x8 pa0, pa1, pa2, pa3;
#define VAL(t_) (MODE != 0 || ((t_) >= na.vlo && (t_) < na.vhi))
#define QKT(P0_, P1_, KS_, t_) do { if (VAL(t_)) qkt<ND>(P0_, P1_, KS_, qr, r32, hi); else { P0_ = f32x16{}; P1_ = f32x16{}; } } while (0)
#define PV(VB_, t_) do { if (VAL(t_)) pv_d0<NO>(o, VB_, pa0, pa1, pa2, pa3); } while (0)
    SLOAD(sA, 0); asm volatile("s_waitcnt vmcnt(0)" ::: "memory"); SWRITE(0, sA); __syncthreads();
    QKT(pA0, pA1, K_lds, 0); partialSM<MODE>(pA0, pA1, m_reg, mnA, alA, na, 0, hi);
    SLOAD(sO, 64); if (SD == 2 && 2 < NT) SLOAD(sA, 128);
    SWAIT(); SWRITE(1, sO); __syncthreads();
    for (int j = 1; j + 1 < NT; j += 2) {
        SBAR(); QKT(pB0, pB1, K_lds + SHM_K, j);
        finishSM(pA0, pA1, alA, l_reg, pa0, pa1, pa2, pa3); SBAR();
        SLOAD(sO, (j + SD) * 64); SBAR();
        PV(vb0, j - 1); partialSM<MODE>(pB0, pB1, m_reg, mnB, alB, na, j, hi);
        __syncthreads(); SWAIT(); SWRITE(0, sA);
        RESC(alB); __syncthreads();
        SBAR(); QKT(pA0, pA1, K_lds, j + 1);
        finishSM(pB0, pB1, alB, l_reg, pa0, pa1, pa2, pa3); SBAR();
        if (SD == 1 || j + 3 < NT) SLOAD(sA, (j + 1 + SD) * 64); SBAR();
        PV(vb0 + SHM_V, j); partialSM<MODE>(pA0, pA1, m_reg, mnA, alA, na, j + 1, hi);
        __syncthreads(); SWAIT(); SWRITE(1, sO);
        RESC(alA); __syncthreads();
    }
    SBAR(); QKT(pB0, pB1, K_lds + SHM_K, NT - 1);
    finishSM(pA0, pA1, alA, l_reg, pa0, pa1, pa2, pa3); SBAR();
    PV(vb0, NT - 2); partialSM<MODE>(pB0, pB1, m_reg, mnB, alB, na, NT - 1, hi);
    __syncthreads(); RESC(alB);
    finishSM(pB0, pB1, alB, l_reg, pa0, pa1, pa2, pa3); SBAR();
    PV(vb0 + SHM_V, NT - 1);
    if (hi == 0) li_l[r32] = l_reg;
    asm volatile("s_waitcnt lgkmcnt(0)" ::: "memory");
#pragma unroll
    for (int r = 0; r < 16; ++r) rli[r] = __builtin_amdgcn_rcpf(li_l[crow(r, hi)]);
#undef VAL
#undef QKT
#undef PV
#undef SLOAD
#undef SWRITE
#undef SWAIT
#undef RESC
}

__device__ __forceinline__ void na_item(const Params& p, int l, int item, char* lds) {
    const int xcd = item & 7, slot = item >> 3;
    const int pair = xcd * 4 + (slot >> 4), rb = slot & 15, b = pair >> 3, h = pair & 7;
    bf16_t* pa = (bf16_t*)(p.ws + OFF_PA);
    const int r0 = rb * 4, lo = min(max(r0 - 4, 0), 52);
    const int tid = otid(), wid = tid >> 6, lane = tid & 63, r32 = lane & 31, hi = lane >> 5;
    LAS float* tab = (LAS float*)((LAS unsigned char*)(uintptr_t)(unsigned)(uintptr_t)lds + 130 * 1024);
    const float* rpb = p.in[5] + ((size_t)l * 8 + h) * 465;
    if (tid < 465) tab[tid] = ((const GAS float*)rpb)[tid] * 8.0f;
    NaCtx na; const int wu = __builtin_amdgcn_readfirstlane(wid); const int r = r0 + (wu >> 1), qc = 32 * (wu & 1) + r32, rs = min(max(r - 4, 0), 56);
    na.vlo = rs - lo; na.vhi = na.vlo + 8; na.wstart = min(max(qc - 8, 0), 48); na.qc = qc; na.drow0 = lo - r + 7; na.tab = tab;
    const size_t tb = (size_t)b * SEQ;
    bf16_t* Q = pa + (tb + (size_t)r0 * 64) * 1536 + h * 64;
    const bf16_t* K = pa + (tb + (size_t)lo * 64) * 1536 + 512 + h * 64;
    const bf16_t* V = K + 512;
    f32x16 o[2]; float rli[16];
    attn_core<64, 64, 0, 1536, 1536, 1536, 1536, 1>(Q, K, K, V, 12, lds, o, rli, na);
    bf16_t* Ow = Q + (size_t)(wid * 32) * 1536;
#pragma unroll
    for (int rr = 0; rr < 16; ++rr) { const int orow = crow(rr, hi);
#pragma unroll
        for (int d = 0; d < 2; ++d) { const float v = o[d][rr] * rli[rr]; ((GAS bf16_t*)Ow)[(size_t)orow * 1536 + d * 32 + r32] = (bf16_t)(cvtpk(v, v) & 0xffffu); } }
    __syncthreads();
}
__device__ __forceinline__ void diff_item(const Params& p, int l, int item, char* lds) {
    const int xcd = item & 7, slot = item >> 3;
    const int pair = xcd * 2 + (slot >> 4), qb = slot & 15, b = pair >> 2, h = pair & 3;
    bf16_t* pd = (bf16_t*)(p.ws + OFF_PD);
    const int tid = otid(), wid = tid >> 6, lane = tid & 63, r32 = lane & 31, hi = lane >> 5;
    const float* lv = p.in[6] + (size_t)l * 256;
    float s1 = 0.f, s2 = 0.f;
    for (int i = 0; i < 64; ++i) { s1 += ((const GAS float*)lv)[i] * ((const GAS float*)lv)[64 + i]; s2 += ((const GAS float*)lv)[128 + i] * ((const GAS float*)lv)[192 + i]; }
    const float lam_init = p.lam_init[l], lam = __expf(s1) - __expf(s2) + lam_init;
    const size_t tb = (size_t)b * SEQ;
    bf16_t* Q = pd + (tb + (size_t)qb * 256) * 1536 + h * 128;
    const bf16_t* K = pd + tb * 1536 + 512 + h * 128;
    const bf16_t* V = pd + tb * 1536 + 1024 + h * 128;
    NaCtx na{};
    unsigned short* stash = (unsigned short*)(lds + 66 * 1024) + (size_t)wid * 64 * 64 + lane;
    f32x16 o[4]; float rli[16];
    attn_core<64, 128, 1, 1536, 1536, 1536, 1536, 2>(Q, K, K, V, 64, lds, o, rli, na);
#pragma unroll
    for (int d = 0; d < 4; ++d)
#pragma unroll
        for (int rr = 0; rr < 16; ++rr) { const float v = o[d][rr] * rli[rr]; stash[(d * 16 + rr) * 64] = (unsigned short)(cvtpk(v, v) & 0xffffu); }
    __syncthreads();
    attn_core<64, 128, 1, 1536, 1536, 1536, 1536, 2>(Q + 64, K + 64, K, V, 64, lds, o, rli, na);
    const float* sg = p.in[7] + (size_t)l * 128;
    float gcol[4];
#pragma unroll
    for (int d = 0; d < 4; ++d) gcol[d] = ((const GAS float*)sg)[d * 32 + r32] * (1.0f - lam_init);
    bf16_t* Ow = Q + (size_t)(wid * 32) * 1536;
#pragma unroll
    for (int rr = 0; rr < 16; ++rr) {
        float v[4]; float ss = 0.f;
#pragma unroll
        for (int d = 0; d < 4; ++d) { v[d] = bf2f(stash[(d * 16 + rr) * 64]) - lam * (o[d][rr] * rli[rr]); ss += v[d] * v[d]; }
        ss += __shfl_xor(ss, 1); ss += __shfl_xor(ss, 2); ss += __shfl_xor(ss, 4); ss += __shfl_xor(ss, 8); ss += __shfl_xor(ss, 16);
        const float rn = rsqrtf(ss * (1.0f / 128.0f) + 1e-6f);
        const int orow = crow(rr, hi);
#pragma unroll
        for (int d = 0; d < 4; ++d) { const float y = v[d] * rn * gcol[d]; ((GAS bf16_t*)Ow)[(size_t)orow * 1536 + d * 32 + r32] = (bf16_t)(cvtpk(y, y) & 0xffffu); }
    }
    __syncthreads();
}
__device__ __forceinline__ void mla_item(const Params& p, int item, char* lds) {
    const int xcd = item & 7, slot = item >> 3;
    const int pair = xcd * 4 + (slot >> 4), qb = slot & 15, b = pair >> 3, h = pair & 7;
    const int tid = otid(), wid = tid >> 6, lane = tid & 63, r32 = lane & 31, hi = lane >> 5;
    bf16_t* mc = (bf16_t*)(p.ws + OFF_MC); const bf16_t* mq = (const bf16_t*)(p.ws + OFF_MQ); const bf16_t* mkv = (const bf16_t*)(p.ws + OFF_MKV);
    const size_t tb = (size_t)b * SEQ;
    const bf16_t* Q = mq + (tb + (size_t)qb * 256) * 768 + h * 96;
    const bf16_t* K1 = mkv + tb * 1024 + h * 128;
    const bf16_t* K2 = mc + tb * 768 + 640;
    const bf16_t* V = K1 + 64;
    NaCtx na{};
    f32x16 o[2]; float rli[16];
    attn_core<96, 64, 2, 768, 1024, 768, 1024, 2>(Q, K1, K2, V, 64, lds, o, rli, na);
    bf16_t* Ow = mc + (tb + (size_t)qb * 256 + wid * 32) * 768 + h * 64;
#pragma unroll
    for (int rr = 0; rr < 16; ++rr) { const int orow = crow(rr, hi);
#pragma unroll
        for (int d = 0; d < 2; ++d) { const float v = o[d][rr] * rli[rr]; ((GAS bf16_t*)Ow)[(size_t)orow * 768 + d * 32 + r32] = (bf16_t)(cvtpk(v, v) & 0xffffu); } }
    __syncthreads();
}

struct MapId { __device__ __forceinline__ int operator()(int n) const { return n; } };
struct MapIn { __device__ __forceinline__ int operator()(int n) const { return n < 3744 ? n : (n < 3840 ? -1 : n - 96); } };
struct MapF1 { __device__ __forceinline__ int operator()(int n) const { const int pt = n >> 8, r = n & 255; return r < 128 ? pt * 128 + r : DFF + pt * 128 + (r - 128); } };
template <class Map>
__device__ __forceinline__ void prep_w(const float* __restrict__ src, int Ks, int Ns, bf16_t* __restrict__ dst, int Nd, int Kd, const float* __restrict__ kscale, Map map, float* tile) {
    const int tid = otid(), nk = Kd / 64, ntile = (Nd / 64) * nk;
    const int lk = tid >> 4, ln = (tid & 15) * 4;
    const int sn = tid >> 3, sk = (tid & 7) * 8;
    for (int t = blockIdx.x; t < ntile; t += gridDim.x) {
        const int n0 = (t / nk) * 64, k0 = (t % nk) * 64;
        const int ns = map(n0 + ln);
#pragma unroll
        for (int j = 0; j < 2; ++j) { const int kl = lk + 32 * j, ks = (k0 + kl) % Ks; f32x4 v = {0.f, 0.f, 0.f, 0.f};
            if (ns >= 0) { v = *(const GAS f32x4*)(src + (size_t)ks * Ns + ns); if (kscale) v = v * ((const GAS float*)kscale)[ks]; }
            *(f32x4*)(tile + kl * 68 + ln) = v; }
        __syncthreads();
        u32x4 w;
        w.x = cvtpk(tile[(sk + 0) * 68 + sn], tile[(sk + 1) * 68 + sn]); w.y = cvtpk(tile[(sk + 2) * 68 + sn], tile[(sk + 3) * 68 + sn]);
        w.z = cvtpk(tile[(sk + 4) * 68 + sn], tile[(sk + 5) * 68 + sn]); w.w = cvtpk(tile[(sk + 6) * 68 + sn], tile[(sk + 7) * 68 + sn]);
        *(GAS u32x4*)(dst + (size_t)(n0 + sn) * Kd + k0 + sk) = w;
        __syncthreads();
    }
}
__device__ __forceinline__ void ln_rows(const float* src, float* dstf, bf16_t* dstb, float* stats, const float* __restrict__ g, const float* __restrict__ bta, int row0, int nrows) {
    const int tid_ = otid(); const int lane = tid_ & 63, wv = blockIdx.x * 8 + (tid_ >> 6), nw = gridDim.x * 8;
    f32x4 gv[4], bv[4];
#pragma unroll
    for (int i = 0; i < 4; ++i) { gv[i] = *(const GAS f32x4*)(g + i * 256 + lane * 4); bv[i] = *(const GAS f32x4*)(bta + i * 256 + lane * 4); }
    for (int r = wv; r < nrows; r += nw) {
        const size_t ro = (size_t)(row0 + r) * 1024;
        f32x4 v[4]; float s = 0.f;
#pragma unroll
        for (int i = 0; i < 4; ++i) { v[i] = *(const GAS f32x4*)(src + ro + i * 256 + lane * 4); s += (v[i][0] + v[i][1]) + (v[i][2] + v[i][3]); }
#pragma unroll
        for (int k = 1; k < 64; k <<= 1) s += __shfl_xor(s, k);
        const float mu = s * (1.0f / 1024.0f); float q = 0.f;
#pragma unroll
        for (int i = 0; i < 4; ++i) { v[i] = v[i] - mu; q += (v[i][0] * v[i][0] + v[i][1] * v[i][1]) + (v[i][2] * v[i][2] + v[i][3] * v[i][3]); }
#pragma unroll
        for (int k = 1; k < 64; k <<= 1) q += __shfl_xor(q, k);
        const float rstd = rsqrtf(q * (1.0f / 1024.0f) + 1e-5f);
#pragma unroll
        for (int i = 0; i < 4; ++i) { const f32x4 y = v[i] * rstd * gv[i] + bv[i]; if (dstf) *(GAS f32x4*)(dstf + ro + i * 256 + lane * 4) = y;
            if (dstb) st_bf4(dstb + ro + i * 256 + lane * 4, y); }
        if (stats && lane == 0) { f32x2 ms; ms[0] = mu; ms[1] = rstd; *(GAS f32x2*)(stats + (size_t)(row0 + r) * 2) = ms; }
    }
}

#ifndef PHMASK
#define PHMASK 0xffff
#endif
#define WSP(T_, off) ((T_*)(wsb + (off)))
__device__ __forceinline__ void gsync(cg::grid_group& g) { asm volatile("s_waitcnt vmcnt(0)" ::: "memory"); g.sync(); __builtin_amdgcn_fence(__ATOMIC_ACQUIRE, "agent"); }
__global__ __launch_bounds__(512, 2) void fwd_megakernel(Params p) {
    extern __shared__ __attribute__((aligned(16))) unsigned char shm[];
    cg::grid_group grid = cg::this_grid();
    LAS unsigned char* ldsg = (LAS unsigned char*)shm;
    char* lds = (char*)shm;
    if (PHMASK & 512) {
        unsigned char* wsb = p.ws;
        float* tile = (float*)shm;
        for (int l = 0; l < DEPTH; ++l) {
            prep_w(p.in[3] + (size_t)l * 1024 * 6816, 1024, 6816, WSP(bf16_t, OFF_WIN) + (size_t)l * NIN * 1024, NIN, 1024, nullptr, MapIn(), tile);
            prep_w(p.in[10] + (size_t)l * 384 * 768, 384, 768, WSP(bf16_t, OFF_WQB) + (size_t)l * 768 * 384, 768, 384, p.in[8] + l * 384, MapId(), tile);
            prep_w(p.in[11] + (size_t)l * 256 * 1024, 256, 1024, WSP(bf16_t, OFF_WKVB) + (size_t)l * 1024 * 256, 1024, 256, p.in[9] + l * 256, MapId(), tile);
            for (int i = 0; i < 3; ++i)
                prep_w(p.in[12] + ((size_t)l * 3 + i) * 512 * 1024, 512, 1024, WSP(bf16_t, OFF_WBR) + ((size_t)l * 3 + i) * 1024 * 512, 1024, 512, nullptr, MapId(), tile);
            prep_w(p.in[13] + (size_t)l * 1024 * 1024, 1024, 1024, WSP(bf16_t, OFF_WOUT) + (size_t)l * 1024 * 3072, 1024, 3072, nullptr, MapId(), tile);
            prep_w(p.in[16] + (size_t)l * 1024 * 5632, 1024, 5632, WSP(bf16_t, OFF_WF1) + (size_t)l * 5632 * 1024, 5632, 1024, nullptr, MapF1(), tile);
            prep_w(p.in[17] + (size_t)l * 2816 * 1024, 2816, 1024, WSP(bf16_t, OFF_WF2) + (size_t)l * 1024 * 2816, 1024, 2816, nullptr, MapId(), tile);
        }
        const int gtid = blockIdx.x * 512 + otid(), gn = gridDim.x * 512;
        const float nlt = -13.122363377404328f;
        float* cd = WSP(float, OFF_TD); float* sd = cd + SEQ * 8; float* cm = WSP(float, OFF_TM); float* sm = cm + SEQ * 16;
        for (int i = gtid; i < SEQ * 8; i += gn) { const int pos = i >> 3, f = i & 7; const float inv = expf(nlt * (float)f / 8.0f), ang = (float)pos * inv; ((GAS float*)cd)[i] = cosf(ang); ((GAS float*)sd)[i] = sinf(ang); }
        for (int i = gtid; i < SEQ * 16; i += gn) { const int pos = i >> 4, f = i & 15; const float inv = expf(nlt * (float)f / 16.0f), ang = (float)pos * inv; ((GAS float*)cm)[i] = cosf(ang); ((GAS float*)sm)[i] = sinf(ang); }
        ln_rows(p.in[0], nullptr, WSP(bf16_t, OFF_XB), WSP(float, OFF_ST), p.in[1], p.in[2], 0, T_ALL);
    }
    gsync(grid);
    for (int step = 0; step < DEPTH * 13; ++step) {
      const int l = step / 13, ls = step % 13, nsub = ls == 4 ? 2 : 1;
      int zv_ = 0; asm volatile("" : "+v"(zv_)); const int zop = __builtin_amdgcn_readfirstlane(zv_);
      for (int sub = 0; sub < nsub; ++sub) {
        int ck, ph;
        if (ls < 4) { ck = 0; ph = ls; } else if (ls == 4) { ck = sub; ph = sub == 0 ? 4 : 0; } else if (ls < 9) { ck = 1; ph = ls - 4; } else { ck = 0; ph = ls - 4; }
        const size_t tok0 = ls < 9 ? (size_t)ck * TC : 0;
        const int mrows = ls < 9 ? TC : T_ALL;
        unsigned wlo_ = (unsigned)(uintptr_t)p.ws, whi_ = (unsigned)((uintptr_t)p.ws >> 32); asm volatile("" : "+v"(wlo_), "+v"(whi_));
        unsigned char* wsb = (unsigned char*)(((uintptr_t)(unsigned)__builtin_amdgcn_readfirstlane((int)whi_) << 32) | (uintptr_t)(unsigned)__builtin_amdgcn_readfirstlane((int)wlo_));
        switch (ph) {
        case 0: if (PHMASK & 1) {
            float* cd = WSP(float, OFF_TD); float* cm = WSP(float, OFF_TM);
            EpiIn E{WSP(bf16_t, OFF_PA), WSP(bf16_t, OFF_PD), WSP(bf16_t, OFF_MC), WSP(bf16_t, OFF_GT), WSP(float, OFF_SSQ), p.in[4 + zop] + (size_t)l * 3072, cd, cd + SEQ * 8, cm, cm + SEQ * 16};
            gemm_phase(ldsg, WSP(bf16_t, OFF_XB) + tok0 * 1024, 1024, WSP(bf16_t, OFF_WIN) + (size_t)l * NIN * 1024, 1024, TC, NIN, 1024, E);
        } break;
        case 1: if (PHMASK & 2) {
            if (PHMASK & 1024) { EpiKV E{WSP(bf16_t, OFF_MKV), WSP(float, OFF_SSQ)}; gemm_phase(ldsg, WSP(bf16_t, OFF_MC) + 384, 768, WSP(bf16_t, OFF_WKVB) + (size_t)l * 1024 * 256, 256, TC, 1024, 256, E); }
            if (PHMASK & 2048) { float* cm = WSP(float, OFF_TM); EpiQ E{WSP(bf16_t, OFF_MQ), WSP(float, OFF_SSQ), cm, cm + SEQ * 16}; gemm_phase(ldsg, WSP(bf16_t, OFF_MC), 768, WSP(bf16_t, OFF_WQB) + (size_t)l * 768 * 384, 384, TC, 768, 384, E); }
            __syncthreads();
            if (PHMASK & 4096) for (int it = blockIdx.x; it < 512; it += gridDim.x) na_item(p, l, it, lds);
        } break;
        case 2: if (PHMASK & 4) {
            if (PHMASK & 8192) for (int it = blockIdx.x; it < 256; it += gridDim.x) diff_item(p, l, it, lds);
            if (PHMASK & 16384) for (int it = blockIdx.x; it < 512; it += gridDim.x) mla_item(p, it, lds);
        } break;
        case 3: if (PHMASK & 8) {
            for (int i = 0; i < 3; ++i) {
                const bf16_t* A = i == 0 ? WSP(bf16_t, OFF_PA) : (i == 1 ? WSP(bf16_t, OFF_PD) : WSP(bf16_t, OFF_MC)); const int lda = i == 2 ? 768 : 1536;
                EpiBr E{WSP(bf16_t, OFF_GT), WSP(bf16_t, OFF_MKV), i};
                gemm_phase(ldsg, A, lda, WSP(bf16_t, OFF_WBR) + ((size_t)l * 3 + i) * 1024 * 512, 512, TC, 1024, 512, E);
            }
        } break;
        case 4: case 7: if (PHMASK & 16) {
            const float* lg = ph == 7 ? p.in[14 + zop] + l * 1024 : (l == 0 ? p.in[1 + zop] : p.in[18 + zop] + (l - 1) * 1024); const float* lb = ph == 7 ? p.in[15 + zop] + l * 1024 : (l == 0 ? p.in[2 + zop] : p.in[19 + zop] + (l - 1) * 1024);
            EpiRes E{((ph == 4 && l == 0) ? p.in[0 + zop] : (const float*)p.out) + tok0 * 1024, p.out + tok0 * 1024, WSP(float, OFF_ST) + tok0 * 2, lg, lb};
            const bf16_t* A = ph == 4 ? WSP(bf16_t, OFF_MKV) : WSP(bf16_t, OFF_PA); const int ld = ph == 4 ? 1024 : DFF, ldb_ = ph == 4 ? 3072 : DFF, kk = ph == 4 ? 1024 : DFF;
            const bf16_t* B = ph == 4 ? WSP(bf16_t, OFF_WOUT) + (size_t)l * 1024 * 3072 : WSP(bf16_t, OFF_WF2) + (size_t)l * 1024 * DFF;
            gemm_phase(ldsg, A, ld, B, ldb_, mrows, 1024, kk, E);
        } break;
        case 5: case 8: if (PHMASK & 32) {
            const float* g = ph == 5 ? p.in[14 + zop] : p.in[18 + zop]; const float* bb = ph == 5 ? p.in[15 + zop] : p.in[19 + zop];
            const bool fin = (ph == 8 && l == DEPTH - 1);
            ln_rows(p.out, fin ? p.out : nullptr, fin ? nullptr : WSP(bf16_t, OFF_XB), fin ? nullptr : WSP(float, OFF_ST), g + l * 1024, bb + l * 1024, (int)tok0, mrows);
        } break;
        case 6: if (PHMASK & 64) {
            EpiF1 E{WSP(bf16_t, OFF_PA)};
            gemm_phase(ldsg, WSP(bf16_t, OFF_XB) + tok0 * 1024, 1024, WSP(bf16_t, OFF_WF1) + (size_t)l * 5632 * 1024, 1024, mrows, 5632, 1024, E);
        } break;
        }
      }
      gsync(grid);
    }
}

extern "C" void kernel_launch(void* const* d_in, const int* in_sizes, int n_in, void* d_out, int out_size, void* d_ws, size_t ws_size, hipStream_t stream) {
    static int grid = 0;
    if (grid == 0) {
        if (n_in != 20 || in_sizes[0] != T_ALL * DM || out_size != T_ALL * DM || ws_size < WS_END) {
            fprintf(stderr, "kernel_launch: unexpected shapes / workspace (n_in %d, ws %zu, need %zu)\n", n_in, ws_size, (size_t)WS_END); grid = -1; return; }
        int dev = 0, cus = 0, per_cu = 0;
        hipGetDevice(&dev); hipDeviceGetAttribute(&cus, hipDeviceAttributeMultiprocessorCount, dev);
        if (hipFuncSetAttribute((const void*)fwd_megakernel, hipFuncAttributeMaxDynamicSharedMemorySize, LDS_BYTES) != hipSuccess) { fprintf(stderr, "kernel_launch: hipFuncSetAttribute failed\n"); grid = -1; return; }
        if (hipOccupancyMaxActiveBlocksPerMultiprocessor(&per_cu, (const void*)fwd_megakernel, 512, LDS_BYTES) != hipSuccess || per_cu < 1) { fprintf(stderr, "kernel_launch: occupancy query gave %d\n", per_cu); per_cu = 1; }
        (void)hipGetLastError();
        grid = cus;
    }
    if (grid < 0) return;
    Params p{};
    for (int i = 0; i < 20; ++i) p.in[i] = (const float*)d_in[i];
    p.out = (float*)d_out; p.ws = (unsigned char*)d_ws;
    for (int l = 0; l < 4; ++l) p.lam_init[l] = (float)(0.8 - 0.6 * exp(-0.3 * (double)l));
    void* args[] = {&p};
    hipError_t e = hipLaunchCooperativeKernel((const void*)fwd_megakernel, dim3(grid), dim3(512), args, LDS_BYTES, stream);
    if (e != hipSuccess) fprintf(stderr, "kernel_launch: cooperative launch failed: %s (grid %d)\n", hipGetErrorString(e), grid);
}
```
